# Optimizing an MI355X kernel written in HIP

```python
import jax
import jax.numpy as jnp
from jax import lax
import numpy as np

D_MODEL = 1024
BATCH = 4
SEQ = 8192
DEPTH = 2

CTX_LEN = 256
GRID_W = 64
CHUNK = 64
D_FF = 4 * D_MODEL
NORM_EPS = 1e-6

GLA_HEADS = 4
GLA_W = 3 * D_MODEL // 8
GLA_DV = GLA_W // GLA_HEADS
GLA_DK = GLA_DV // 2
GLA_KW = GLA_HEADS * GLA_DK
GLA_GATE_RANK = 16
GLA_GATE_NORM = 16.0

RWKV_HD = 64
RWKV_W = 3 * D_MODEL // 8
RWKV_HEADS = RWKV_W // RWKV_HD
RWKV_DECAY_RANK = 32
RWKV_A_RANK = 32
RWKV_GATE_RANK = 64
RWKV_LN_EPS = 64e-5

RET_HEADS = 4
RET_W = D_MODEL - GLA_W - RWKV_W
RET_HD = RET_W // RET_HEADS
ROPE_BASE = 10000.0

GLA_SIZES = (GLA_KW, GLA_KW, GLA_W, GLA_W, GLA_GATE_RANK, GLA_GATE_RANK)
RWKV_SIZES = (RWKV_W, RWKV_W, RWKV_W, RWKV_DECAY_RANK, RWKV_DECAY_RANK, RWKV_A_RANK, RWKV_GATE_RANK)
RET_SIZES = (RET_W, RET_W, RET_W, RET_W)
GLA_COLS = sum(GLA_SIZES)
RWKV_COLS = sum(RWKV_SIZES)
RET_COLS = sum(RET_SIZES)
IN_COLS = GLA_COLS + RWKV_COLS + RET_COLS

kernel_name = "hybrid_gla_rwkv7_retnet_prefix_dit_block"

F32 = jnp.float32


def split_cols(z, sizes):
    idx = np.cumsum(sizes)[:-1].tolist()
    return jnp.split(z, idx, axis=-1)


def rev(t):
    return jnp.flip(t, axis=1)


def rms_norm(x, g, eps=NORM_EPS):
    xf = x.astype(F32)
    y = xf * lax.rsqrt(jnp.mean(xf * xf, axis=-1, keepdims=True) + eps)
    return (y * g.astype(F32)).astype(x.dtype)


def head_rms_norm(y, g, eps=NORM_EPS):
    B, T, H, N = y.shape
    yf = y.astype(F32)
    yf = yf * lax.rsqrt(jnp.mean(yf * yf, axis=-1, keepdims=True) + eps)
    return (yf.reshape(B, T, H * N) * g.astype(F32)).astype(y.dtype)


def head_group_norm(y, g, b, eps):
    B, T, H, N = y.shape
    yf = y.astype(F32)
    mu = jnp.mean(yf, axis=-1, keepdims=True)
    var = jnp.mean(jnp.square(yf - mu), axis=-1, keepdims=True)
    out = ((yf - mu) * lax.rsqrt(var + eps)).reshape(B, T, H * N)
    return (out * g.astype(F32) + b.astype(F32)).astype(y.dtype)


def axial_rotary(t):
    T, K = t.shape[1], t.shape[-1]
    nf = K // 4
    pos = jnp.arange(T)
    row = (pos // GRID_W).astype(F32)
    col = (pos % GRID_W).astype(F32)
    inv = ROPE_BASE ** (-jnp.arange(nf, dtype=F32) / nf)
    ang = jnp.concatenate([row[:, None] * inv, col[:, None] * inv], axis=-1)
    cos = jnp.cos(ang)[None, :, None, :].astype(t.dtype)
    sin = jnp.sin(ang)[None, :, None, :].astype(t.dtype)
    t1, t2 = t[..., : K // 2], t[..., K // 2:]
    return jnp.concatenate([t1 * cos - t2 * sin, t1 * sin + t2 * cos], axis=-1)


def to_blocks(t):
    B, T, H, X = t.shape
    return t.reshape(B, T // CHUNK, CHUNK, H, X).transpose(1, 0, 3, 2, 4)


def from_blocks(t):
    n, B, H, C, X = t.shape
    return t.transpose(1, 0, 3, 2, 4).reshape(B, n * C, H, X)


def gla_scan(q, k, v, log_g, s0, need_out):
    causal = jnp.tril(jnp.ones((CHUNK, CHUNK), dtype=bool))[None, None, :, :, None]
    xs = (to_blocks(k), to_blocks(v), to_blocks(log_g)) + ((to_blocks(q),) if need_out else ())

    def step(s, inp):
        kc, vc, gc, *rest = inp
        G = jnp.cumsum(gc.astype(F32), axis=2)
        G_end = G[:, :, -1:, :]
        s_new = (s * jnp.exp(G_end[:, :, 0, :, None]).astype(s.dtype)
                 + jnp.einsum("bhck,bhcv->bhkv", kc * jnp.exp(G_end - G).astype(kc.dtype), vc))
        if not need_out:
            return s_new, None
        qc = rest[0]
        y_inter = jnp.einsum("bhck,bhkv->bhcv", qc * jnp.exp(G).astype(qc.dtype), s)
        rel = jnp.where(causal, G[:, :, :, None, :] - G[:, :, None, :, :], -jnp.inf)
        A = jnp.einsum("bhik,bhjk,bhijk->bhij", qc, kc, jnp.exp(rel).astype(qc.dtype))
        return s_new, y_inter + jnp.einsum("bhij,bhjv->bhiv", A, vc)

    s_fin, ys = lax.scan(step, s0, xs)
    return (from_blocks(ys) if need_out else None), s_fin


def gla_mixer(z, p, states, need_out):
    B, T, _ = z.shape
    q, k, v, og, lr_f, lr_b = split_cols(z, GLA_SIZES)
    q = q.reshape(B, T, GLA_HEADS, GLA_DK) * (GLA_DK ** -0.5)
    k = k.reshape(B, T, GLA_HEADS, GLA_DK)
    v = v.reshape(B, T, GLA_HEADS, GLA_DV)

    def log_gate(lr, d):
        logit = lr @ p["gla_gate_w2"][d] + p["gla_gate_b"][d]
        return (jax.nn.log_sigmoid(logit) / GLA_GATE_NORM).reshape(B, T, GLA_HEADS, GLA_DK)

    if states is None:
        s0 = jnp.zeros((B, GLA_HEADS, GLA_DK, GLA_DV), z.dtype)
        states = (s0, s0)
    y_f, s_f = gla_scan(q, k, v, log_gate(lr_f, 0), states[0], need_out)
    y_b, s_b = gla_scan(rev(q), rev(k), rev(v), rev(log_gate(lr_b, 1)), states[1], need_out)
    if not need_out:
        return None, (s_f, s_b)
    o = head_rms_norm(y_f + rev(y_b), p["gla_norm_g"])
    return jax.nn.silu(og) * o, (s_f, s_b)


def grid_neighbour_mean(z, rows):
    B, T, C = z.shape
    g = jnp.pad(z.reshape(B, rows, GRID_W, C), ((0, 0), (1, 1), (1, 1), (0, 0)))
    nb = g[:, :-2, 1:-1] + g[:, 2:, 1:-1] + g[:, 1:-1, :-2] + g[:, 1:-1, 2:]
    return (0.25 * nb).reshape(B, T, C)


def seq_neighbour_mean(z):
    g = jnp.pad(z, ((0, 0), (1, 1), (0, 0)))
    return 0.5 * (g[:, :-2] + g[:, 2:])


def rwkv7_scan(r, w, k, v, kk, a, s0, need_out):
    tm = lambda t: jnp.moveaxis(t, 1, 0)
    xs = (tm(w), tm(k), tm(v), tm(kk), tm(kk * a)) + ((tm(r),) if need_out else ())

    def step(s, inp):
        w_t, k_t, v_t, kk_t, b_t, *rest = inp
        s_kk = jnp.einsum("bhvk,bhk->bhv", s, kk_t)
        s = s * w_t[:, :, None, :] - s_kk[..., None] * b_t[:, :, None, :] + v_t[..., None] * k_t[:, :, None, :]
        if not need_out:
            return s, None
        return s, jnp.einsum("bhvk,bhk->bhv", s, rest[0])

    s_fin, ys = lax.scan(step, s0, xs)
    return (jnp.moveaxis(ys, 0, 1) if need_out else None), s_fin


def rwkv7_mixer(z, p, states, need_out, rows):
    B, T, _ = z.shape
    nb = seq_neighbour_mean(z) if rows is None else grid_neighbour_mean(z, rows)
    z = z + p["rwkv_mu"] * (nb - z)
    r, k, v, lw_f, lw_b, la, lg = split_cols(z, RWKV_SIZES)
    heads = lambda t: t.reshape(B, T, RWKV_HEADS, RWKV_HD)

    def decay(lw, d):
        w = -jax.nn.softplus(-(p["rwkv_w0"][d] + jnp.tanh(lw) @ p["rwkv_w2"][d])) - 0.5
        return heads(jnp.exp(-jnp.exp(w)))

    a = jax.nn.sigmoid(p["rwkv_a0"] + la @ p["rwkv_a2"])
    kk = heads(k * p["rwkv_k_k"])
    kk = kk * lax.rsqrt(jnp.sum(jnp.square(kk.astype(F32)), axis=-1, keepdims=True) + 1e-12).astype(kk.dtype)
    k = heads(k * (1 + (a - 1) * p["rwkv_k_a"]))
    r, v, a = heads(r), heads(v), heads(a)
    if states is None:
        s0 = jnp.zeros((B, RWKV_HEADS, RWKV_HD, RWKV_HD), z.dtype)
        states = (s0, s0)
    y_f, s_f = rwkv7_scan(r, decay(lw_f, 0), k, v, kk, a, states[0], need_out)
    y_b, s_b = rwkv7_scan(rev(r), rev(decay(lw_b, 1)), rev(k), rev(v), rev(kk), rev(a), states[1], need_out)
    if not need_out:
        return None, (s_f, s_b)
    y = head_group_norm(y_f + rev(y_b), p["rwkv_ln_g"], p["rwkv_ln_b"], RWKV_LN_EPS)
    bonus = jnp.sum(r * k * p["rwkv_r_k"], axis=-1, keepdims=True) * v
    y = y + bonus.reshape(B, T, RWKV_W)
    return y * (jax.nn.sigmoid(lg) @ p["rwkv_g2"]), (s_f, s_b)


def retention_scan(q, k, v, log_gamma, s0, need_out):
    dt = q.dtype
    lg = log_gamma.astype(F32)
    idx = jnp.arange(CHUNK, dtype=F32)
    rel = idx[:, None] - idx[None, :]
    decay_mask = (jnp.exp(jnp.maximum(rel, 0.0)[None] * lg[:, None, None]) * (rel >= 0)[None]).astype(dt)
    decay_q = jnp.exp((idx + 1.0)[None, :] * lg[:, None]).astype(dt)
    decay_k = jnp.exp((CHUNK - 1.0 - idx)[None, :] * lg[:, None]).astype(dt)
    decay_chunk = jnp.exp(CHUNK * lg).astype(dt)
    xs = (to_blocks(k), to_blocks(v)) + ((to_blocks(q),) if need_out else ())

    def step(s, inp):
        kc, vc, *rest = inp
        s_new = (s * decay_chunk[None, :, None, None]
                 + jnp.einsum("bhck,bhcv->bhkv", kc * decay_k[None, :, :, None], vc))
        if not need_out:
            return s_new, None
        qc = rest[0]
        inner = jnp.einsum("bhik,bhjk->bhij", qc, kc) * decay_mask[None]
        y = (jnp.einsum("bhck,bhkv->bhcv", qc * decay_q[None, :, :, None], s)
             + jnp.einsum("bhij,bhjv->bhiv", inner, vc))
        return s_new, y

    s_fin, ys = lax.scan(step, s0, xs)
    return (from_blocks(ys) if need_out else None), s_fin


def retnet_mixer(z, p, states, need_out, latent):
    B, T, _ = z.shape
    q, k, v, g = split_cols(z, RET_SIZES)
    q = q.reshape(B, T, RET_HEADS, RET_HD)
    k = k.reshape(B, T, RET_HEADS, RET_HD) * (RET_HD ** -0.5)
    v = v.reshape(B, T, RET_HEADS, RET_HD)
    if latent:
        q, k = axial_rotary(q), axial_rotary(k)
    log_gamma = -jnp.exp(p["ret_log_rate"].astype(F32))
    if states is None:
        s0 = jnp.zeros((B, RET_HEADS, RET_HD, RET_HD), z.dtype)
        states = (s0, s0)
    y_f, s_f = retention_scan(q, k, v, log_gamma[0], states[0], need_out)
    y_b, s_b = retention_scan(rev(q), rev(k), rev(v), log_gamma[1], states[1], need_out)
    if not need_out:
        return None, (s_f, s_b)
    o = head_rms_norm(y_f + rev(y_b), p["ret_norm_g"])
    return jax.nn.silu(g) * o, (s_f, s_b)


def squared_relu_mlp(h, w1, w2):
    return jnp.square(jax.nn.relu(h @ w1)) @ w2


def modulate(h, shift, scale):
    return h * (1 + scale) + shift


def trunk_layer(xl, xc, c, c_ctx, p, rows, ctx_out):
    ml = jnp.split((jax.nn.silu(c) @ p["mod_w"] + p["mod_b"])[:, None, :], 6, axis=-1)
    mc = jnp.split(jax.nn.silu(c_ctx) @ p["mod_w"] + p["mod_b"], 6, axis=-1)

    zl = modulate(rms_norm(xl, p["norm1_g"]), ml[0], ml[1]) @ p["w_in"]
    zc = modulate(rms_norm(xc, p["norm1_g"]), mc[0], mc[1]) @ p["w_in"]
    zl_gla, zl_rwkv, zl_ret = split_cols(zl, (GLA_COLS, RWKV_COLS, RET_COLS))
    zc_gla, zc_rwkv, zc_ret = split_cols(zc, (GLA_COLS, RWKV_COLS, RET_COLS))

    yc_gla, st_gla = gla_mixer(zc_gla, p, None, ctx_out)
    yc_rwkv, st_rwkv = rwkv7_mixer(zc_rwkv, p, None, ctx_out, None)
    yc_ret, st_ret = retnet_mixer(zc_ret, p, None, ctx_out, False)

    yl_gla, _ = gla_mixer(zl_gla, p, st_gla, True)
    yl_rwkv, _ = rwkv7_mixer(zl_rwkv, p, st_rwkv, True, rows)
    yl_ret, _ = retnet_mixer(zl_ret, p, st_ret, True, True)

    xl = xl + ml[2] * (jnp.concatenate([yl_gla, yl_rwkv, yl_ret], axis=-1) @ p["w_out"])
    hl = modulate(rms_norm(xl, p["norm2_g"]), ml[3], ml[4])
    xl = xl + ml[5] * squared_relu_mlp(hl, p["mlp_w1"], p["mlp_w2"])
    if not ctx_out:
        return xl, xc
    xc = xc + mc[2] * (jnp.concatenate([yc_gla, yc_rwkv, yc_ret], axis=-1) @ p["w_out"])
    hc = modulate(rms_norm(xc, p["norm2_g"]), mc[3], mc[4])
    xc = xc + mc[5] * squared_relu_mlp(hc, p["mlp_w1"], p["mlp_w2"])
    return xl, xc


def setup_inputs(seed: int = 0) -> dict:
    key = jax.random.key(seed)
    ks = iter(jax.random.split(key, 32))
    nrm = lambda shape, scale: scale * jax.random.normal(next(ks), shape, F32)
    L, D = DEPTH, D_MODEL
    h_idx = jnp.arange(RET_HEADS, dtype=F32)
    ret_rate0 = jnp.log(-jnp.log(1.0 - 2.0 ** (-5.0 - h_idx)))
    return {
        "x": nrm((BATCH, SEQ, D), 1.0),
        "c": nrm((BATCH, D), 1.0),
        "ctx": nrm((BATCH, CTX_LEN, D), 1.0),
        "c_ctx": nrm((D,), 1.0),
        "final_norm_g": 1.0 + nrm((D,), 0.02),
        "mod_w": nrm((L, D, 6 * D), D ** -0.5),
        "mod_b": nrm((L, 6 * D), 0.02),
        "norm1_g": 1.0 + nrm((L, D), 0.02),
        "norm2_g": 1.0 + nrm((L, D), 0.02),
        "w_in": nrm((L, D, IN_COLS), D ** -0.5),
        "w_out": nrm((L, D, D), D ** -0.5),
        "mlp_w1": nrm((L, D, D_FF), D ** -0.5),
        "mlp_w2": nrm((L, D_FF, D), D_FF ** -0.5),
        "gla_gate_w2": nrm((L, 2, GLA_GATE_RANK, GLA_KW), GLA_GATE_RANK ** -0.5),
        "gla_gate_b": nrm((L, 2, GLA_KW), 0.5),
        "gla_norm_g": 1.0 + nrm((L, GLA_W), 0.02),
        "rwkv_mu": jax.random.uniform(next(ks), (L, RWKV_COLS), F32, 0.0, 1.0),
        "rwkv_w0": nrm((L, 2, RWKV_W), 0.5) - 0.5,
        "rwkv_w2": nrm((L, 2, RWKV_DECAY_RANK, RWKV_W), 0.5 * RWKV_DECAY_RANK ** -0.5),
        "rwkv_a0": nrm((L, RWKV_W), 0.5),
        "rwkv_a2": nrm((L, RWKV_A_RANK, RWKV_W), RWKV_A_RANK ** -0.5),
        "rwkv_g2": nrm((L, RWKV_GATE_RANK, RWKV_W), RWKV_GATE_RANK ** -0.5),
        "rwkv_k_k": 0.85 + nrm((L, RWKV_W), 0.05),
        "rwkv_k_a": 1.0 + nrm((L, RWKV_W), 0.05),
        "rwkv_r_k": nrm((L, RWKV_HEADS, RWKV_HD), 0.1),
        "rwkv_ln_g": 1.0 + nrm((L, RWKV_W), 0.02),
        "rwkv_ln_b": nrm((L, RWKV_W), 0.02),
        "ret_log_rate": ret_rate0 + nrm((L, 2, RET_HEADS), 0.05),
        "ret_norm_g": 1.0 + nrm((L, RET_W), 0.02),
    }


def reference(x, c, ctx, c_ctx, final_norm_g, mod_w, mod_b, norm1_g, norm2_g, w_in, w_out, mlp_w1, mlp_w2,
              gla_gate_w2, gla_gate_b, gla_norm_g, rwkv_mu, rwkv_w0, rwkv_w2, rwkv_a0, rwkv_a2, rwkv_g2,
              rwkv_k_k, rwkv_k_a, rwkv_r_k, rwkv_ln_g, rwkv_ln_b, ret_log_rate, ret_norm_g):
    rows = x.shape[1] // GRID_W
    stacked = {
        "mod_w": mod_w, "mod_b": mod_b, "norm1_g": norm1_g, "norm2_g": norm2_g,
        "w_in": w_in, "w_out": w_out, "mlp_w1": mlp_w1, "mlp_w2": mlp_w2,
        "gla_gate_w2": gla_gate_w2, "gla_gate_b": gla_gate_b, "gla_norm_g": gla_norm_g,
        "rwkv_mu": rwkv_mu, "rwkv_w0": rwkv_w0, "rwkv_w2": rwkv_w2, "rwkv_a0": rwkv_a0,
        "rwkv_a2": rwkv_a2, "rwkv_g2": rwkv_g2, "rwkv_k_k": rwkv_k_k, "rwkv_k_a": rwkv_k_a,
        "rwkv_r_k": rwkv_r_k, "rwkv_ln_g": rwkv_ln_g, "rwkv_ln_b": rwkv_ln_b,
        "ret_log_rate": ret_log_rate, "ret_norm_g": ret_norm_g,
    }
    xl, xc = x, ctx
    for layer in range(DEPTH):
        p = {name: arr[layer] for name, arr in stacked.items()}
        xl, xc = trunk_layer(xl, xc, c, c_ctx, p, rows, layer < DEPTH - 1)
    return rms_norm(xl, final_norm_g)
```

```cpp
#include <hip/hip_runtime.h>
#include <hip/hip_cooperative_groups.h>
#include <cstdio>
#include <cstdint>
namespace cg = cooperative_groups;

#ifndef MK_ONE_LAUNCH
#define MK_ONE_LAUNCH 0
#endif

#define LAS __attribute__((address_space(3)))
#define GAS __attribute__((address_space(1)))
typedef unsigned short bf16_t;
typedef float f32x4 __attribute__((ext_vector_type(4)));
typedef float f32x2 __attribute__((ext_vector_type(2)));
typedef unsigned u32x4 __attribute__((ext_vector_type(4)));
typedef unsigned u32x2 __attribute__((ext_vector_type(2)));

constexpr int DM = 1024, NB = 4, SEQ = 8192, CTXL = 256, DEPTH = 2, DFF = 4096;
constexpr int ML = NB * SEQ, MC = NB * CTXL, MT = ML + MC;
constexpr int INC = 3520, ZP = 3584;
constexpr int GLA_OFF = 0, RW_OFF = 1184, RET_OFF = 2496;
constexpr int YB_OFF = RW_OFF;
constexpr int SEQT = CTXL + SEQ;
constexpr int NTHR = 512, NWAVES = 8;

constexpr size_t MiB = 1u << 20;
constexpr size_t WS_CTL = 0, CTL_BYTES = 1 * MiB;
constexpr size_t WS_MOD = 1 * MiB;
constexpr size_t WS_WIN = 2 * MiB, WS_WOUT = 9 * MiB, WS_W1 = 11 * MiB, WS_W2 = 19 * MiB;
constexpr size_t WS_XC = 27 * MiB;
constexpr size_t WS_ABUF = 32 * MiB;
constexpr size_t WS_Z = 98 * MiB;
constexpr size_t WS_PREP = 329 * MiB;
constexpr size_t PREP_STRIDE = (size_t)MT * 384;
constexpr size_t WS_H = 98 * MiB;
constexpr size_t WS_END = WS_PREP + 7 * PREP_STRIDE * 2;
static_assert(WS_ABUF + (size_t)MT * DM * 2 <= WS_Z, "ws map");
static_assert(WS_Z + (size_t)MT * ZP * 2 <= WS_PREP, "ws map");
static_assert(WS_H + (size_t)MT * DFF * 2 <= WS_END, "ws map");
static_assert(WS_END <= 512 * MiB, "ws map");
enum { PR_R = 0, PR_WF = 1, PR_WB = 2, PR_K = 3, PR_V = 4, PR_KK = 5, PR_B = 6 };

constexpr int LDS_BYTES = 147456;

__device__ __forceinline__ float bf2f(bf16_t v) { return __uint_as_float(((unsigned)v) << 16); }
__device__ __forceinline__ unsigned f2bf_u(float f) { unsigned u = __float_as_uint(f); return (u + 0x7fffu + ((u >> 16) & 1u)) >> 16; }
__device__ __forceinline__ bf16_t f2bf(float f) { return (bf16_t)f2bf_u(f); }
__device__ __forceinline__ unsigned pk2(float lo, float hi) { return f2bf_u(lo) | (f2bf_u(hi) << 16); }
__device__ __forceinline__ float sigmoidf_(float x) { return 1.0f / (1.0f + __expf(-x)); }
__device__ __forceinline__ float siluf_(float x) { return x / (1.0f + __expf(-x)); }
__device__ __forceinline__ float softplusf_(float x) { return fmaxf(x, 0.f) + log1pf(__expf(-fabsf(x))); }
__device__ __forceinline__ float wave_sum(float v) {
#pragma unroll
    for (int o = 1; o < 64; o <<= 1) v += __shfl_xor(v, o);
    return v;
}
template <int CTRL> __device__ __forceinline__ float dpp_mov(float x) { return __int_as_float(__builtin_amdgcn_update_dpp(0, __float_as_int(x), CTRL, 0xF, 0xF, true)); }
__device__ __forceinline__ float reduce16(float x) {
    x += dpp_mov<0xB1>(x);
    x += dpp_mov<0x4E>(x);
    x += dpp_mov<0x141>(x);
    x += dpp_mov<0x140>(x);
    return x;
}
#define LDS_WAIT() asm volatile("s_waitcnt lgkmcnt(0)" ::: "memory")

namespace pg8 {
#define PG8_LAS __attribute__((address_space(3)))
typedef unsigned short bf16_t;
typedef short bf16x8 __attribute__((ext_vector_type(8)));
typedef float f32x4 __attribute__((ext_vector_type(4)));
typedef unsigned u32x4 __attribute__((ext_vector_type(4)));
constexpr int BM = 256, BK = 64, HALF = 128, HTB = HALF * BK * 2  , STAGE_BYTES = 8 * HTB, NXCD = 8, WGM = 8;

__host__ __device__ __forceinline__ int lds_byte(int r, int c) { const int st = (r >> 4) * 2 + (c >> 5), rr = r & 15, cc = c & 31, ob = rr * 64 + cc * 2; return st * 1024 + (ob ^ (((ob >> 9) & 1) << 5)); }
__host__ __device__ __forceinline__ void stage_rc(int b, int& R, int& C) { const int st = b / 1024, sb = b % 1024, swz = sb ^ (((sb >> 9) & 1) << 5); R = (st >> 1) * 16 + swz / 64; C = (st & 1) * 32 + (swz % 64) / 2; }
__host__ __device__ __forceinline__ int perm32(int rho) { const int n = rho >> 4, i = rho & 15; return 8 * (i >> 2) + 4 * n + (i & 3); }

struct Unit { int pm, pn; };
struct Gemm { const bf16_t* A; const bf16_t* Bt; int M, N, K; };

struct StaticOrder {
    int nM, nN, nwg, G, c;
    __host__ __device__ void init(int M, int N, int G_, int c_) { nM = M / BM; nN = N / BM; nwg = nM * nN; G = G_; c = c_; }
    __host__ __device__ bool next(int i, Unit& u) const {
        const long L = (long)i * G + c; if (L >= nwg) return false;
        int wgid = (int)L; { const int q = nwg / NXCD, r = nwg % NXCD, xcd = wgid % NXCD, off = wgid / NXCD; wgid = (xcd < r ? xcd * (q + 1) : r * (q + 1) + (xcd - r) * q) + off; }
        const int nig = WGM * nN, gid = wgid / nig, fm = gid * WGM, gsz = (nM - fm) < WGM ? (nM - fm) : WGM;
        u.pm = fm + ((wgid % nig) % gsz); u.pn = (wgid % nig) / gsz; return true;
    }
    __device__ __forceinline__ void a_ready(const Unit&) const {}
    __device__ __forceinline__ void done(const Unit&) const {}
};

template <class Epi, class Sched, bool ALIGN_EPI = false, bool SP2 = false>
__device__ __forceinline__ void gemm_phase(PG8_LAS unsigned char* lds, const Gemm g, const Sched& S, const Epi& E, const int tid) {
    const int wid = __builtin_amdgcn_readfirstlane(tid >> 6), lane = tid & 63, wr = wid >> 2, wc = wid & 3, fr = lane & 15, fq = lane >> 4;
    const int K = g.K, nt = K / BK;
    unsigned voffA[2], voffB[2];
#pragma unroll
    for (int i = 0; i < 2; ++i) { int R, C; stage_rc(tid * 16 + i * 8192, R, C); const int Rb = Epi::PERM ? ((R & ~31) + perm32(R & 31)) : R;
        voffA[i] = (unsigned)(R * K + C) * 2u; voffB[i] = (unsigned)(Rb * K + C) * 2u; }
    const size_t kstep = (size_t)(BK * 2);
    const size_t hstep = (size_t)HALF * K * 2;
    const size_t tstep = 2 * hstep;
    const unsigned ldsw = (unsigned)wid * 1024u;
    const int aoff = lds_byte(wr * 64 + fr, fq * 8), boff = lds_byte(wc * 32 + fr, fq * 8);
#define PG8_SA(b, h) (((b) * 2 + (h)) * HTB)
#define PG8_SB(b, h) ((4 + (b) * 2 + (h)) * HTB)
#define PG8_STAGE(bufoff, gbase, voff) do { _Pragma("unroll") for (int _i = 0; _i < 2; ++_i) \
        __builtin_amdgcn_global_load_lds((const unsigned*)((const char*)(gbase) + (voff)[_i]), (PG8_LAS unsigned*)(lds + (bufoff) + ldsw + _i * 8192), 16, 0, 0); } while (0)
#define PG8_LDA(dst, b, h) do { _Pragma("unroll") for (int m = 0; m < 4; ++m) _Pragma("unroll") for (int k = 0; k < 2; ++k) dst[m][k] = *(const PG8_LAS bf16x8*)(lds + PG8_SA(b, h) + aoff + m * 2048 + k * 1024); } while (0)
#define PG8_LDB(dst, b, h) do { _Pragma("unroll") for (int n = 0; n < 2; ++n) _Pragma("unroll") for (int k = 0; k < 2; ++k) dst[n][k] = *(const PG8_LAS bf16x8*)(lds + PG8_SB(b, h) + boff + n * 2048 + k * 1024); } while (0)
#define PG8_MMA(ai, bj, At, Bt) do { __builtin_amdgcn_s_setprio(1); _Pragma("unroll") for (int m = 0; m < 4; ++m) _Pragma("unroll") for (int n = 0; n < 2; ++n) _Pragma("unroll") for (int k = 0; k < 2; ++k) \
        acc[ai][bj][m][n] = __builtin_amdgcn_mfma_f32_16x16x32_bf16(Bt[n][k], At[m][k], acc[ai][bj][m][n], 0, 0, 0); __builtin_amdgcn_s_setprio(0); } while (0)
#define PG8_WAIT_V(n) asm volatile("s_waitcnt vmcnt(" #n ")" ::: "memory")
#define PG8_WAIT_L(n) asm volatile("s_waitcnt lgkmcnt(" #n ")" ::: "memory")
#define PG8_BAR __builtin_amdgcn_s_barrier()
#define PG8_SCHED __builtin_amdgcn_sched_barrier(0)
    Unit cur, nxt; int ui = 0;
    if (!S.next(0, cur)) return;
    f32x4 acc[2][2][4][2];
#pragma unroll
    for (int a = 0; a < 2; ++a)
#pragma unroll
        for (int b = 0; b < 2; ++b)
#pragma unroll
            for (int m = 0; m < 4; ++m)
#pragma unroll
                for (int n = 0; n < 2; ++n) acc[a][b][m][n] = (f32x4){0.f, 0.f, 0.f, 0.f};
    bf16x8 At[4][2], B0[2][2], B1[2][2];
    const char* cA = (const char*)g.A + (size_t)cur.pm * tstep; const char* cB = (const char*)g.Bt + (size_t)cur.pn * tstep;
    S.a_ready(cur);
    if constexpr (SP2) {
        PG8_STAGE(PG8_SB(0, 0), cB, voffB); PG8_STAGE(PG8_SB(0, 1), cB + hstep, voffB); PG8_STAGE(PG8_SA(0, 0), cA, voffA); PG8_STAGE(PG8_SA(0, 1), cA + hstep, voffA);
        if (wr == 1) PG8_BAR;
        PG8_WAIT_V(2); PG8_BAR;
        PG8_STAGE(PG8_SB(1, 0), cB + kstep, voffB); PG8_STAGE(PG8_SA(1, 0), cA + kstep, voffA); PG8_STAGE(PG8_SB(1, 1), cB + hstep + kstep, voffB);
        PG8_WAIT_V(6); PG8_BAR;
    } else {
        PG8_STAGE(PG8_SB(0, 0), cB, voffB); PG8_STAGE(PG8_SA(0, 0), cA, voffA); PG8_STAGE(PG8_SB(0, 1), cB + hstep, voffB); PG8_STAGE(PG8_SA(0, 1), cA + hstep, voffA);
        if (wr == 1) PG8_BAR;
        PG8_WAIT_V(4); PG8_BAR;
        PG8_STAGE(PG8_SB(1, 0), cB + kstep, voffB); PG8_STAGE(PG8_SA(1, 0), cA + kstep, voffA); PG8_STAGE(PG8_SB(1, 1), cB + hstep + kstep, voffB);
        PG8_WAIT_V(6); PG8_BAR;
    }
    for (;;) {
        const bool has_next = S.next(ui + 1, nxt);
        const char* nA = has_next ? (const char*)g.A + (size_t)nxt.pm * tstep : cA; const char* nB = has_next ? (const char*)g.Bt + (size_t)nxt.pn * tstep : cB;
        for (int t = 0; t < nt; t += 2) {
            const bool last = (t == nt - 2);
            const char* a1 = cA + (size_t)(t + 1) * kstep;
            const char* a2 = last ? nA : cA + (size_t)(t + 2) * kstep; const char* b2 = last ? nB : cB + (size_t)(t + 2) * kstep;
            const char* a3 = a2 + kstep; const char* b3 = b2 + kstep;
            if (last && has_next) S.a_ready(nxt);
            if constexpr (SP2) {
            PG8_LDB(B0, 0, 0); PG8_LDB(B1, 0, 1); PG8_SCHED; PG8_LDA(At, 0, 0); PG8_STAGE(PG8_SA(1, 1), a1 + hstep, voffA);
            PG8_WAIT_V(8); PG8_WAIT_L(0); PG8_BAR; PG8_MMA(0, 0, At, B0); PG8_MMA(0, 1, At, B1); PG8_BAR; PG8_SCHED;
            PG8_LDA(At, 0, 1); PG8_STAGE(PG8_SB(0, 0), b2, voffB); PG8_STAGE(PG8_SB(0, 1), b2 + hstep, voffB); PG8_STAGE(PG8_SA(0, 0), a2, voffA);
            PG8_WAIT_V(8); PG8_WAIT_L(0); PG8_BAR; PG8_MMA(1, 0, At, B0); PG8_MMA(1, 1, At, B1); PG8_BAR; PG8_SCHED;
            PG8_LDB(B0, 1, 0); PG8_LDB(B1, 1, 1); PG8_SCHED; PG8_LDA(At, 1, 0); PG8_STAGE(PG8_SA(0, 1), a2 + hstep, voffA);
            PG8_WAIT_V(8); PG8_WAIT_L(0); PG8_BAR; PG8_MMA(0, 0, At, B0); PG8_MMA(0, 1, At, B1); PG8_BAR; PG8_SCHED;
            PG8_LDA(At, 1, 1); PG8_STAGE(PG8_SB(1, 0), b3, voffB); PG8_STAGE(PG8_SB(1, 1), b3 + hstep, voffB); PG8_STAGE(PG8_SA(1, 0), a3, voffA);
            PG8_WAIT_V(8); PG8_WAIT_L(0); PG8_BAR; PG8_MMA(1, 0, At, B0); PG8_MMA(1, 1, At, B1); PG8_BAR; PG8_SCHED;
            } else {
            PG8_LDB(B0, 0, 0); PG8_SCHED; PG8_LDA(At, 0, 0); PG8_STAGE(PG8_SA(1, 1), a1 + hstep, voffA);
            PG8_WAIT_L(8); PG8_BAR; PG8_WAIT_L(0); PG8_MMA(0, 0, At, B0); PG8_BAR; PG8_SCHED;
            PG8_LDB(B1, 0, 1); PG8_STAGE(PG8_SB(0, 0), b2, voffB);
            PG8_BAR; PG8_WAIT_L(0); PG8_MMA(0, 1, At, B1); PG8_BAR;
            PG8_LDA(At, 0, 1); PG8_STAGE(PG8_SA(0, 0), a2, voffA);
            PG8_BAR; PG8_WAIT_L(0); PG8_MMA(1, 0, At, B0); PG8_BAR; PG8_SCHED;
            PG8_STAGE(PG8_SB(0, 1), b2 + hstep, voffB);
            PG8_WAIT_V(6); PG8_BAR; PG8_MMA(1, 1, At, B1); PG8_BAR;
            PG8_LDB(B0, 1, 0); PG8_SCHED; PG8_LDA(At, 1, 0); PG8_STAGE(PG8_SA(0, 1), a2 + hstep, voffA);
            PG8_WAIT_L(8); PG8_BAR; PG8_WAIT_L(0); PG8_MMA(0, 0, At, B0); PG8_BAR; PG8_SCHED;
            PG8_LDB(B1, 1, 1); PG8_STAGE(PG8_SB(1, 0), b3, voffB);
            PG8_BAR; PG8_WAIT_L(0); PG8_MMA(0, 1, At, B1); PG8_BAR;
            PG8_LDA(At, 1, 1); PG8_STAGE(PG8_SA(1, 0), a3, voffA);
            PG8_BAR; PG8_WAIT_L(0); PG8_MMA(1, 0, At, B0); PG8_BAR; PG8_SCHED;
            PG8_STAGE(PG8_SB(1, 1), b3 + hstep, voffB);
            PG8_WAIT_V(6); PG8_BAR; PG8_MMA(1, 1, At, B1); PG8_BAR;
            }
        }
        if constexpr (ALIGN_EPI) { if (wr == 0) PG8_BAR; }
        if constexpr (!Epi::AFTER_DRAIN) { E(acc, cur, wr, wc, fr, fq); S.done(cur); }
        if (!has_next) break;
#pragma unroll
        for (int a = 0; a < 2; ++a)
#pragma unroll
            for (int b = 0; b < 2; ++b)
#pragma unroll
                for (int m = 0; m < 4; ++m)
#pragma unroll
                    for (int n = 0; n < 2; ++n) acc[a][b][m][n] = (f32x4){0.f, 0.f, 0.f, 0.f};
        cur = nxt; cA = nA; cB = nB; ++ui;
        if constexpr (ALIGN_EPI) { if (wr == 1) PG8_BAR; }
    }
    PG8_WAIT_V(0);
    if constexpr (!ALIGN_EPI) { if (wr == 0) PG8_BAR; }
    PG8_BAR;
    if constexpr (Epi::AFTER_DRAIN) { E.fused(acc, cur, wr, wc, fr, fq, lds, wid, lane); S.done(cur); }
#undef PG8_SA
#undef PG8_SB
#undef PG8_STAGE
#undef PG8_LDA
#undef PG8_LDB
#undef PG8_MMA
#undef PG8_WAIT_V
#undef PG8_WAIT_L
#undef PG8_BAR
#undef PG8_SCHED
}
}

namespace pg8 {
template <int ACT> struct EpiBf16 {
    static constexpr bool PERM = true, AFTER_DRAIN = false;
    bf16_t* O; int ldc;
    __device__ __forceinline__ void operator()(const f32x4 (&acc)[2][2][4][2], const Unit& u, int wr, int wc, int fr, int fq) const {
        const int row0 = u.pm * BM + wr * 64 + fr; const int col0 = u.pn * BM + wc * 32 + 8 * fq;
#pragma unroll
        for (int ai = 0; ai < 2; ++ai)
#pragma unroll
            for (int m = 0; m < 4; ++m) { bf16_t* rowp = O + (size_t)(row0 + ai * HALF + m * 16) * ldc + col0;
#pragma unroll
                for (int bj = 0; bj < 2; ++bj) { f32x4 v0 = acc[ai][bj][m][0], v1 = acc[ai][bj][m][1];
                    if (ACT == 2) {
#pragma unroll
                        for (int e = 0; e < 4; ++e) { float a = fmaxf(v0[e], 0.f), b = fmaxf(v1[e], 0.f); v0[e] = a * a; v1[e] = b * b; } }
                    u32x4 w; w.x = ::pk2(v0[0], v0[1]); w.y = ::pk2(v0[2], v0[3]); w.z = ::pk2(v1[0], v1[1]); w.w = ::pk2(v1[2], v1[3]);
                    *(u32x4*)(rowp + bj * HALF) = w; } }
    }
};
struct EpiRes {
    static constexpr bool PERM = false, AFTER_DRAIN = false;
    const float* base_lat; const float* base_ctx; float* out_lat; float* out_ctx; const float* gate  ;
    __device__ __forceinline__ void operator()(const f32x4 (&acc)[2][2][4][2], const Unit& u, int wr, int wc, int fr, int fq) const {
        const bool lat = u.pm < (ML / BM); const int mi = lat ? (u.pm >> 5) : 4;
        const float* gv = gate + (size_t)mi * 6144;
        const size_t tile_off = lat ? (size_t)u.pm * BM * DM : (size_t)(u.pm - ML / BM) * BM * DM;
        const float* bp = (lat ? base_lat : base_ctx) + tile_off; float* op = (lat ? out_lat : out_ctx) + tile_off;
        const int col0 = u.pn * BM + wc * 32 + 4 * fq;
        f32x4 g4[2][2];
#pragma unroll
        for (int bj = 0; bj < 2; ++bj)
#pragma unroll
            for (int n = 0; n < 2; ++n) g4[bj][n] = *(const f32x4*)(gv + col0 + bj * HALF + n * 16);
#pragma unroll
        for (int ai = 0; ai < 2; ++ai)
#pragma unroll
            for (int m = 0; m < 4; ++m) { const size_t off = (size_t)(ai * HALF + wr * 64 + m * 16 + fr) * DM + col0;
#pragma unroll
                for (int bj = 0; bj < 2; ++bj)
#pragma unroll
                    for (int n = 0; n < 2; ++n) { const f32x4 bs = *(const f32x4*)(bp + off + bj * HALF + n * 16);
                        *(f32x4*)(op + off + bj * HALF + n * 16) = bs + g4[bj][n] * acc[ai][bj][m][n]; } }
    }
};
}

struct Args { const float* in[29]; float* out; unsigned char* ws; int ph_lo, ph_hi; };
enum { I_X = 0, I_C, I_CTX, I_CCTX, I_FNG, I_MODW, I_MODB, I_N1G, I_N2G, I_WIN, I_WOUT, I_W1, I_W2, I_GGW2, I_GGB, I_GNG, I_RMU, I_RW0, I_RW2, I_RA0, I_RA2, I_RG2,
       I_RKK, I_RKA, I_RRK, I_RLNG, I_RLNB, I_RETLR, I_RETNG };

typedef const __attribute__((address_space(4))) Args* CArgs;
struct Frame {
    LAS unsigned char* lds;
    int tid, lane, wave, bid, G;
    CArgs ap; float* out; unsigned char* ws;
    float* mod; bf16_t *Win_t, *Wout_t, *W1_t, *W2_t; float* xc; bf16_t *A, *Z, *PREP, *H;
};

__device__ __forceinline__ int mod_index(int m) { return m < ML ? (m >> 13) : 4; }
__device__ __forceinline__ int seq_row(int b, int dir, int s) {
    if (s < CTXL) { const int tc = dir ? (CTXL - 1 - s) : s; return ML + b * CTXL + tc; }
    const int tl = s - CTXL; const int t = dir ? (SEQ - 1 - tl) : tl; return b * SEQ + t;
}
__device__ __forceinline__ float zshift(const bf16_t* Z, int m, int col, float mu) {
    const bf16_t* p = Z + (size_t)m * ZP + col;
    const float z0 = bf2f(*p); float nb;
    if (m < ML) { const int t = m & (SEQ - 1), gr = t >> 6, gc = t & 63; float s = 0.f;
        if (gr > 0) s += bf2f(*(p - (ptrdiff_t)64 * ZP)); if (gr < 127) s += bf2f(*(p + (ptrdiff_t)64 * ZP));
        if (gc > 0) s += bf2f(*(p - (ptrdiff_t)ZP)); if (gc < 63) s += bf2f(*(p + (ptrdiff_t)ZP));
        nb = 0.25f * s;
    } else { const int t = (m - ML) & (CTXL - 1); float s = 0.f;
        if (t > 0) s += bf2f(*(p - (ptrdiff_t)ZP)); if (t < CTXL - 1) s += bf2f(*(p + (ptrdiff_t)ZP));
        nb = 0.5f * s; }
    return z0 + mu * (nb - z0);
}

__device__ __forceinline__ void phase_mod(Frame& F) {
    LAS float* sc = (LAS float*)F.lds;
    LAS float* red = sc + 5 * 1024;
    for (int i = F.tid; i < 5 * 1024; i += NTHR) { const int j = i >> 10, k = i & 1023; const float v = j < 4 ? F.ap->in[I_C][j * 1024 + k] : F.ap->in[I_CCTX][k]; sc[i] = siluf_(v); }
    __syncthreads();
    const int kg = F.tid >> 6, c = F.tid & 63;
    for (int it = F.bid; it < DEPTH * 96; it += F.G) {
        const int l = it / 96, cgp = it % 96, col = cgp * 64 + c;
        const float* W = F.ap->in[I_MODW] + (size_t)l * DM * 6144 + col;
        float a0 = 0.f, a1 = 0.f, a2 = 0.f, a3 = 0.f, a4 = 0.f;
#pragma unroll 4
        for (int k = kg * 128; k < kg * 128 + 128; ++k) { const float w = W[(size_t)k * 6144];
            a0 += sc[k] * w; a1 += sc[1024 + k] * w; a2 += sc[2048 + k] * w; a3 += sc[3072 + k] * w; a4 += sc[4096 + k] * w; }
        red[(kg * 5 + 0) * 64 + c] = a0; red[(kg * 5 + 1) * 64 + c] = a1; red[(kg * 5 + 2) * 64 + c] = a2; red[(kg * 5 + 3) * 64 + c] = a3; red[(kg * 5 + 4) * 64 + c] = a4;
        __syncthreads();
        if (F.tid < 320) { const int j = F.tid >> 6; float s = 0.f;
#pragma unroll
            for (int g = 0; g < 8; ++g) s += red[(g * 5 + j) * 64 + c];
            F.mod[((size_t)l * 5 + j) * 6144 + col] = s + F.ap->in[I_MODB][l * 6144 + col]; }
        __syncthreads();
    }
}

__device__ __forceinline__ void transpose_item(const float* W, int K, int N, bf16_t* WT, LAS float* scr, int item, int lane) {
    const int nblk = N / 32, kb = item / nblk, nb = item % nblk, k0 = 64 * kb, n0 = 32 * nb;
#pragma unroll 8
    for (int i = 0; i < 32; ++i) { const int kk = 2 * i + (lane >> 5); scr[kk * 33 + (lane & 31)] = W[(size_t)(k0 + kk) * N + n0 + (lane & 31)]; }
    LDS_WAIT(); asm volatile("" ::: "memory");
    const int c = lane & 7;
#pragma unroll
    for (int j = 0; j < 4; ++j) { const int n = (lane >> 3) + 8 * j; const LAS float* s = scr + (8 * c) * 33 + n;
        u32x4 o; o.x = pk2(s[0 * 33], s[1 * 33]); o.y = pk2(s[2 * 33], s[3 * 33]); o.z = pk2(s[4 * 33], s[5 * 33]); o.w = pk2(s[6 * 33], s[7 * 33]);
        *(u32x4*)(WT + (size_t)(n0 + n) * K + k0 + 8 * c) = o; }
    LDS_WAIT(); asm volatile("" ::: "memory");
}
__device__ __forceinline__ void phase_wconv(Frame& F, int l) {
    LAS float* scr = (LAS float*)(F.lds + F.wave * 16384);
    const int gw = F.bid * NWAVES + F.wave, NGW = F.G * NWAVES;
    constexpr int I_IN = (DM / 64) * (INC / 32), I_O = (DM / 64) * (DM / 32), I_1 = (DM / 64) * (DFF / 32), I_2 = (DFF / 64) * (DM / 32);
    const float* Win = F.ap->in[I_WIN] + (size_t)l * DM * INC; const float* Wout = F.ap->in[I_WOUT] + (size_t)l * DM * DM;
    const float* W1 = F.ap->in[I_W1] + (size_t)l * DM * DFF; const float* W2 = F.ap->in[I_W2] + (size_t)l * DFF * DM;
    for (int it = gw; it < I_IN + I_O + I_1 + I_2; it += NGW) {
        int r = it;
        if (r < I_IN) { transpose_item(Win, DM, INC, F.Win_t, scr, r, F.lane); continue; } r -= I_IN;
        if (r < I_O) { transpose_item(Wout, DM, DM, F.Wout_t, scr, r, F.lane); continue; } r -= I_O;
        if (r < I_1) { transpose_item(W1, DM, DFF, F.W1_t, scr, r, F.lane); continue; } r -= I_1;
        transpose_item(W2, DFF, DM, F.W2_t, scr, r, F.lane);
    }
    { u32x4* zp = (u32x4*)(F.Win_t + (size_t)INC * DM); const int n16 = (ZP - INC) * DM * 2 / 16;
      for (int i = F.bid * NTHR + F.tid; i < n16; i += F.G * NTHR) zp[i] = (u32x4){0u, 0u, 0u, 0u}; }
}

__device__ __forceinline__ void phase_norm(Frame& F, const float* src_lat, const float* src_ctx, const float* g, const float* modl, int shift_idx, int scale_idx, int Mrows) {
    const int gw = F.bid * NWAVES + F.wave, NGW = F.G * NWAVES;
    for (int m = gw; m < Mrows; m += NGW) {
        const float* xrow = m < ML ? src_lat + (size_t)m * DM : src_ctx + (size_t)(m - ML) * DM;
        const float* mv = modl + (size_t)mod_index(m) * 6144;
        const f32x4* xr = (const f32x4*)xrow + F.lane;
        f32x4 v[4]; float ss = 0.f;
#pragma unroll
        for (int j = 0; j < 4; ++j) { v[j] = xr[64 * j]; ss += (v[j].x * v[j].x + v[j].y * v[j].y) + (v[j].z * v[j].z + v[j].w * v[j].w); }
        const float r = rsqrtf(wave_sum(ss) * (1.f / DM) + 1e-6f);
        u32x2* o8 = (u32x2*)(F.A + (size_t)m * DM) + F.lane;
#pragma unroll
        for (int j = 0; j < 4; ++j) { const int col = 4 * F.lane + 256 * j;
            const f32x4 gg = *(const f32x4*)(g + col), sh = *(const f32x4*)(mv + shift_idx * 1024 + col), sc = *(const f32x4*)(mv + scale_idx * 1024 + col);
            const f32x4 y = v[j] * r * gg * (sc + 1.0f) + sh;
            u32x2 w; w.x = pk2(y.x, y.y); w.y = pk2(y.z, y.w); o8[64 * j] = w; }
    }
}
__device__ __forceinline__ void phase_final(Frame& F) {
    const int gw = F.bid * NWAVES + F.wave, NGW = F.G * NWAVES; const float* g = F.ap->in[I_FNG];
    for (int m = gw; m < ML; m += NGW) {
        f32x4* xr = (f32x4*)(F.out + (size_t)m * DM) + F.lane;
        f32x4 v[4]; float ss = 0.f;
#pragma unroll
        for (int j = 0; j < 4; ++j) { v[j] = xr[64 * j]; ss += (v[j].x * v[j].x + v[j].y * v[j].y) + (v[j].z * v[j].z + v[j].w * v[j].w); }
        const float r = rsqrtf(wave_sum(ss) * (1.f / DM) + 1e-6f);
#pragma unroll
        for (int j = 0; j < 4; ++j) { const f32x4 gg = *(const f32x4*)(g + 4 * F.lane + 256 * j); xr[64 * j] = v[j] * r * gg; }
    }
}

__device__ __forceinline__ void phase_prep(Frame& F, int l) {
    constexpr int TG = 8;
    LAS float* lr = (LAS float*)F.lds;
    const float* mu = F.ap->in[I_RMU] + l * 1312;
    const int c = F.tid;
    float w2f[32], w2b[32], a2[32]; float w0f = 0, w0b = 0, a0 = 0, kk_ = 0, ka_ = 0, mur = 0, muk = 0, muv = 0;
    if (c < 384) {
#pragma unroll
        for (int j = 0; j < 32; ++j) { w2f[j] = F.ap->in[I_RW2][((size_t)(l * 2 + 0) * 32 + j) * 384 + c]; w2b[j] = F.ap->in[I_RW2][((size_t)(l * 2 + 1) * 32 + j) * 384 + c]; a2[j] = F.ap->in[I_RA2][((size_t)l * 32 + j) * 384 + c]; }
        w0f = F.ap->in[I_RW0][(l * 2 + 0) * 384 + c]; w0b = F.ap->in[I_RW0][(l * 2 + 1) * 384 + c]; a0 = F.ap->in[I_RA0][l * 384 + c];
        kk_ = F.ap->in[I_RKK][l * 384 + c]; ka_ = F.ap->in[I_RKA][l * 384 + c]; mur = mu[c]; muk = mu[384 + c]; muv = mu[768 + c];
    }
    for (int it = F.bid; it < MT / TG; it += F.G) {
        const int m0 = it * TG;
        for (int i = F.tid; i < TG * 96; i += NTHR) { const int tok = i / 96, j = i % 96; const float v = zshift(F.Z, m0 + tok, RW_OFF + 1152 + j, mu[1152 + j]); lr[i] = j < 64 ? tanhf(v) : v; }
        __syncthreads();
        if (c < 384) {
            for (int tok = 0; tok < TG; ++tok) {
                const int m = m0 + tok;
                const float r = zshift(F.Z, m, RW_OFF + c, mur), k = zshift(F.Z, m, RW_OFF + 384 + c, muk), v = zshift(F.Z, m, RW_OFF + 768 + c, muv);
                float xf = w0f, xb = w0b, xa = a0;
#pragma unroll
                for (int j = 0; j < 32; ++j) { xf += lr[tok * 96 + j] * w2f[j]; xb += lr[tok * 96 + 32 + j] * w2b[j]; xa += lr[tok * 96 + 64 + j] * a2[j]; }
                const float ef = __expf(-softplusf_(-xf) - 0.5f), eb = __expf(-softplusf_(-xb) - 0.5f);
                const float dwf = -expm1f(-ef), dwb = -expm1f(-eb);
                const float a = sigmoidf_(xa);
                float kk = k * kk_; const float ss = wave_sum(kk * kk); kk *= rsqrtf(ss + 1e-12f);
                const float kp = k * (1.f + (a - 1.f) * ka_), bb = kk * a;
                const size_t o = (size_t)m * 384 + c;
                F.PREP[PR_R * PREP_STRIDE + o] = f2bf(r); F.PREP[PR_WF * PREP_STRIDE + o] = f2bf(dwf); F.PREP[PR_WB * PREP_STRIDE + o] = f2bf(dwb);
                F.PREP[PR_K * PREP_STRIDE + o] = f2bf(kp); F.PREP[PR_V * PREP_STRIDE + o] = f2bf(v); F.PREP[PR_KK * PREP_STRIDE + o] = f2bf(kk); F.PREP[PR_B * PREP_STRIDE + o] = f2bf(bb);
            }
        }
        __syncthreads();
    }
}

__device__ __forceinline__ void rwkv_scan_block(Frame& F, int chain, int half) {
    constexpr int TS = 32;
    const int dir = chain & 1, h = (chain >> 1) % 6, b = (chain >> 1) / 6;
    LAS float* vec = (LAS float*)F.lds;
    LAS float* vv = vec + 5 * TS * 64;
    LAS float* yb = vv + TS * 64;
    const int rg = F.lane >> 4, cgp = F.lane & 15, lrow = F.wave * 4 + rg, row = half * 32 + lrow;
    float s0 = 0.f, s1 = 0.f, s2 = 0.f, s3 = 0.f;
    const int vsel[6] = {PR_KK, dir ? PR_WB : PR_WF, PR_B, PR_K, PR_R, PR_V};
    for (int tile = 0; tile < SEQT / TS; ++tile) {
        const int sbase = tile * TS;
#pragma unroll
        for (int q = 0; q < 3; ++q) { const int idx = F.tid + NTHR * q, vi = idx >> 8, st = (idx & 255) >> 3, part = idx & 7;
            const int m = seq_row(b, dir, sbase + st);
            const int vs = vi == 0 ? vsel[0] : vi == 1 ? vsel[1] : vi == 2 ? vsel[2] : vi == 3 ? vsel[3] : vi == 4 ? vsel[4] : vsel[5];
            const u32x4 raw = *(const u32x4*)(F.PREP + (size_t)vs * PREP_STRIDE + (size_t)m * 384 + h * 64 + part * 8);
            f32x4 lo, hi;
            lo.x = __uint_as_float(raw.x << 16); lo.y = __uint_as_float(raw.x & 0xffff0000u); lo.z = __uint_as_float(raw.y << 16); lo.w = __uint_as_float(raw.y & 0xffff0000u);
            hi.x = __uint_as_float(raw.z << 16); hi.y = __uint_as_float(raw.z & 0xffff0000u); hi.z = __uint_as_float(raw.w << 16); hi.w = __uint_as_float(raw.w & 0xffff0000u);
            if (vi == 1) { lo = 1.0f - lo; hi = 1.0f - hi; }
            LAS float* dst = (vi < 5 ? vec + (vi * TS + st) * 64 : vv + st * 64) + part * 8;
            *(LAS f32x4*)dst = lo; *(LAS f32x4*)(dst + 4) = hi; }
        __syncthreads();
#pragma unroll 4
        for (int st = 0; st < TS; ++st) {
            const f32x4 kk4 = *(const LAS f32x4*)(vec + (0 * TS + st) * 64 + cgp * 4), w4 = *(const LAS f32x4*)(vec + (1 * TS + st) * 64 + cgp * 4);
            const f32x4 b4 = *(const LAS f32x4*)(vec + (2 * TS + st) * 64 + cgp * 4), k4 = *(const LAS f32x4*)(vec + (3 * TS + st) * 64 + cgp * 4);
            const f32x4 r4 = *(const LAS f32x4*)(vec + (4 * TS + st) * 64 + cgp * 4); const float vr = vv[st * 64 + row];
            float p = (s0 * kk4.x + s1 * kk4.y) + (s2 * kk4.z + s3 * kk4.w);
            p = reduce16(p);
            s0 = s0 * w4.x + (vr * k4.x - p * b4.x); s1 = s1 * w4.y + (vr * k4.y - p * b4.y); s2 = s2 * w4.z + (vr * k4.z - p * b4.z); s3 = s3 * w4.w + (vr * k4.w - p * b4.w);
            float y = (s0 * r4.x + s1 * r4.y) + (s2 * r4.z + s3 * r4.w);
            y = reduce16(y);
            if (cgp == 0) yb[st * 32 + lrow] = y;
        }
        __syncthreads();
#pragma unroll
        for (int q = 0; q < 2; ++q) { const int idx = F.tid + NTHR * q, st = idx >> 5, rr = idx & 31; const int m = seq_row(b, dir, sbase + st);
            const bf16_t o = f2bf(yb[st * 32 + rr]);
            if (dir == 0) F.A[(size_t)m * DM + 384 + h * 64 + half * 32 + rr] = o; else F.Z[(size_t)m * ZP + YB_OFF + 384 + h * 64 + half * 32 + rr] = o; }
    }
}

__device__ __forceinline__ void gla_scan_block(Frame& F, int l, int chain) {
    constexpr int TS = 64;
    const int dir = chain & 1, h = (chain >> 1) & 3, b = chain >> 3;
    LAS float* q = (LAS float*)F.lds;
    LAS float* k = q + TS * 48; LAS float* g = k + TS * 48;
    LAS float* v = g + TS * 48;
    LAS float* y = v + TS * 96;
    const float* W2 = F.ap->in[I_GGW2] + (size_t)(l * 2 + dir) * 16 * 192 + h * 48; const float* Bg = F.ap->in[I_GGB] + (l * 2 + dir) * 192 + h * 48;
    const float qs = 0.14433756729740643f;
    float S[48];
#pragma unroll
    for (int j = 0; j < 48; ++j) S[j] = 0.f;
    for (int tile = 0; tile < SEQT / TS; ++tile) {
        const int sbase = tile * TS;
        for (int i = F.tid; i < TS * 48; i += NTHR) { const int st = i / 48, j = i % 48; const int m = seq_row(b, dir, sbase + st); const bf16_t* zr = F.Z + (size_t)m * ZP;
            q[i] = bf2f(zr[GLA_OFF + h * 48 + j]) * qs; k[i] = bf2f(zr[GLA_OFF + 192 + h * 48 + j]);
            float x = Bg[j];
#pragma unroll
            for (int r = 0; r < 16; ++r) x += bf2f(zr[GLA_OFF + 1152 + dir * 16 + r]) * W2[r * 192 + j];
            const float ls = fminf(x, 0.f) - log1pf(__expf(-fabsf(x)));
            g[i] = __expf(ls * (1.0f / 16.0f)); }
        for (int i = F.tid; i < TS * 96; i += NTHR) { const int st = i / 96, n = i % 96; const int m = seq_row(b, dir, sbase + st); v[i] = bf2f(F.Z[(size_t)m * ZP + GLA_OFF + 384 + h * 96 + n]); }
        __syncthreads();
        if (F.tid < 96) {
            for (int st = 0; st < TS; ++st) { const float vn = v[st * 96 + F.tid]; float o = 0.f;
#pragma unroll
                for (int j = 0; j < 48; ++j) { S[j] = S[j] * g[st * 48 + j] + k[st * 48 + j] * vn; o += q[st * 48 + j] * S[j]; }
                y[st * 96 + F.tid] = o; }
        }
        __syncthreads();
        for (int i = F.tid; i < TS * 96; i += NTHR) { const int st = i / 96, n = i % 96; const int m = seq_row(b, dir, sbase + st); const bf16_t o = f2bf(y[i]);
            if (dir == 0) F.A[(size_t)m * DM + h * 96 + n] = o; else F.Z[(size_t)m * ZP + YB_OFF + h * 96 + n] = o; }
        __syncthreads();
    }
}
__device__ __forceinline__ void ret_scan_block(Frame& F, int l, int chain) {
    constexpr int TS = 64;
    const int dir = chain & 1, h = (chain >> 1) & 3, b = chain >> 3;
    LAS float* q = (LAS float*)F.lds; LAS float* k = q + TS * 64; LAS float* v = k + TS * 64; LAS float* y = v + TS * 64;
    const float gamma = __expf(-__expf(F.ap->in[I_RETLR][(l * 2 + dir) * 4 + h]));
    float S[64];
#pragma unroll
    for (int j = 0; j < 64; ++j) S[j] = 0.f;
    for (int tile = 0; tile < SEQT / TS; ++tile) {
        const int sbase = tile * TS;
        for (int i = F.tid; i < TS * 32; i += NTHR) { const int st = i >> 5, j = i & 31; const int m = seq_row(b, dir, sbase + st); const bf16_t* zr = F.Z + (size_t)m * ZP + RET_OFF + h * 64;
            float q1 = bf2f(zr[j]), q2 = bf2f(zr[j + 32]), k1 = bf2f(zr[256 + j]) * 0.125f, k2 = bf2f(zr[256 + j + 32]) * 0.125f;
            if (m < ML) { const int t = m & (SEQ - 1); const float pos = (float)(j < 16 ? (t >> 6) : (t & 63));
                const float inv = powf(10000.0f, -(float)(j & 15) * (1.0f / 16.0f)); float sn, cs; sincosf(pos * inv, &sn, &cs);
                const float a = q1 * cs - q2 * sn, bq = q1 * sn + q2 * cs; q1 = a; q2 = bq;
                const float c2 = k1 * cs - k2 * sn, d2 = k1 * sn + k2 * cs; k1 = c2; k2 = d2; }
            q[st * 64 + j] = q1; q[st * 64 + j + 32] = q2; k[st * 64 + j] = k1; k[st * 64 + j + 32] = k2; }
        for (int i = F.tid; i < TS * 64; i += NTHR) { const int st = i >> 6, n = i & 63; const int m = seq_row(b, dir, sbase + st); v[i] = bf2f(F.Z[(size_t)m * ZP + RET_OFF + 512 + h * 64 + n]); }
        __syncthreads();
        if (F.tid < 64) {
            for (int st = 0; st < TS; ++st) { const float vn = v[st * 64 + F.tid]; float o = 0.f;
#pragma unroll
                for (int j = 0; j < 64; ++j) { S[j] = S[j] * gamma + k[st * 64 + j] * vn; o += q[st * 64 + j] * S[j]; }
                y[st * 64 + F.tid] = o; }
        }
        __syncthreads();
        for (int i = F.tid; i < TS * 64; i += NTHR) { const int st = i >> 6, n = i & 63; const int m = seq_row(b, dir, sbase + st); const bf16_t o = f2bf(y[i]);
            if (dir == 0) F.A[(size_t)m * DM + 768 + h * 64 + n] = o; else F.Z[(size_t)m * ZP + YB_OFF + 768 + h * 64 + n] = o; }
        __syncthreads();
    }
}
__device__ __forceinline__ void phase_scan(Frame& F, int l) {
    for (int task = F.bid; task < 160; task += F.G) {
        if (task < 96) rwkv_scan_block(F, task >> 1, task & 1);
        else if (task < 128) gla_scan_block(F, l, task - 96);
        else ret_scan_block(F, l, task - 128);
        __syncthreads();
    }
}

__device__ __forceinline__ void phase_post(Frame& F, int l, int Mrows) {
    constexpr int TG = 8;
    LAS float* sg = (LAS float*)F.lds;
    const float* mu = F.ap->in[I_RMU] + l * 1312;
    const int c = F.tid;
    float g2[64]; float lng = 0, lnb = 0, rk = 0;
    if (c < 384) {
#pragma unroll
        for (int j = 0; j < 64; ++j) g2[j] = F.ap->in[I_RG2][((size_t)l * 64 + j) * 384 + c];
        lng = F.ap->in[I_RLNG][l * 384 + c]; lnb = F.ap->in[I_RLNB][l * 384 + c]; rk = F.ap->in[I_RRK][l * 384 + c];
    }
    for (int it = F.bid; it < Mrows / TG; it += F.G) {
        const int m0 = it * TG;
        { const int tok = F.tid >> 6, j = F.tid & 63; sg[F.tid] = sigmoidf_(zshift(F.Z, m0 + tok, RW_OFF + 1248 + j, mu[1248 + j])); }
        __syncthreads();
        if (c < 384) {
            for (int tok = 0; tok < TG; ++tok) { const int m = m0 + tok; const size_t o = (size_t)m * 384 + c;
                const float yv = bf2f(F.A[(size_t)m * DM + 384 + c]) + bf2f(F.Z[(size_t)m * ZP + YB_OFF + 384 + c]);
                const float mean = wave_sum(yv) * (1.f / 64.f); const float d = yv - mean; const float var = wave_sum(d * d) * (1.f / 64.f);
                const float yn = d * rsqrtf(var + 64e-5f) * lng + lnb;
                const float r = bf2f(F.PREP[PR_R * PREP_STRIDE + o]), kp = bf2f(F.PREP[PR_K * PREP_STRIDE + o]), v = bf2f(F.PREP[PR_V * PREP_STRIDE + o]);
                const float bon = wave_sum(r * kp * rk) * v;
                float gt = 0.f;
#pragma unroll
                for (int j = 0; j < 64; ++j) gt += sg[tok * 64 + j] * g2[j];
                F.A[(size_t)m * DM + 384 + c] = f2bf((yn + bon) * gt); }
        }
        for (int u = F.wave; u < TG * 8; u += NWAVES) { const int m = m0 + (u >> 3), hu = u & 7; const bf16_t* zr = F.Z + (size_t)m * ZP; bf16_t* ar = F.A + (size_t)m * DM;
            if (hu < 4) { const int c0 = hu * 96 + F.lane, c1 = c0 + 64; const bool two = F.lane < 32;
                const float y0 = bf2f(ar[c0]) + bf2f(zr[YB_OFF + c0]); const float y1 = two ? bf2f(ar[c1]) + bf2f(zr[YB_OFF + c1]) : 0.f;
                const float r = rsqrtf(wave_sum(y0 * y0 + y1 * y1) * (1.f / 96.f) + 1e-6f);
                ar[c0] = f2bf(siluf_(bf2f(zr[GLA_OFF + 768 + c0])) * y0 * r * F.ap->in[I_GNG][l * 384 + c0]);
                if (two) ar[c1] = f2bf(siluf_(bf2f(zr[GLA_OFF + 768 + c1])) * y1 * r * F.ap->in[I_GNG][l * 384 + c1]);
            } else { const int cc = (hu - 4) * 64 + F.lane;
                const float y0 = bf2f(ar[768 + cc]) + bf2f(zr[YB_OFF + 768 + cc]);
                const float r = rsqrtf(wave_sum(y0 * y0) * (1.f / 64.f) + 1e-6f);
                ar[768 + cc] = f2bf(siluf_(bf2f(zr[RET_OFF + 768 + cc])) * y0 * r * F.ap->in[I_RETNG][l * 256 + cc]); }
        }
        __syncthreads();
    }
}

constexpr int PH_PER_LAYER = 9, N_PHASES = 1 + DEPTH * PH_PER_LAYER + 1;
#define PHASE_ENTER() \
    CArgs ap = (CArgs)__builtin_amdgcn_kernarg_segment_ptr(); asm volatile("" : "+s"(ap)); \
    int tid = threadIdx.x; asm volatile("" : "+v"(tid)); \
    Frame F; F.lds = lds; F.ap = ap; F.tid = tid; F.lane = tid & 63; F.wave = __builtin_amdgcn_readfirstlane(tid >> 6); F.bid = blockIdx.x; F.G = gridDim.x; \
    unsigned char* ws = ap->ws; F.out = ap->out; F.ws = ws; \
    F.mod = (float*)(ws + WS_MOD); F.Win_t = (bf16_t*)(ws + WS_WIN); F.Wout_t = (bf16_t*)(ws + WS_WOUT); F.W1_t = (bf16_t*)(ws + WS_W1); F.W2_t = (bf16_t*)(ws + WS_W2); \
    F.xc = (float*)(ws + WS_XC); F.A = (bf16_t*)(ws + WS_ABUF); F.Z = (bf16_t*)(ws + WS_Z); F.PREP = (bf16_t*)(ws + WS_PREP); F.H = (bf16_t*)(ws + WS_H); \
    const float* modl = F.mod + (size_t)L * 5 * 6144; (void)modl; \
    const float* xl_in = L == 0 ? F.ap->in[I_X] : F.out; const float* xc_in = L == 0 ? F.ap->in[I_CTX] : F.xc; (void)xl_in; (void)xc_in;

#define IN(k) (lo <= (k) && (k) < hi)
#define SEAM(k) do { if (IN(k) && IN((k) + 1)) grid.sync(); } while (0)
template <int L> __device__ __forceinline__ void run_layer(int lo, int hi, LAS unsigned char* lds, cg::grid_group& grid) {
    constexpr int p0 = 1 + L * PH_PER_LAYER; constexpr bool last = (L == DEPTH - 1); constexpr int Mo = last ? ML : MT;
    if (IN(p0 + 0)) { PHASE_ENTER(); phase_wconv(F, L); phase_norm(F, xl_in, xc_in, F.ap->in[I_N1G] + L * DM, modl, 0, 1, MT); } SEAM(p0 + 0);
    if (IN(p0 + 1)) { PHASE_ENTER(); pg8::Gemm g{F.A, F.Win_t, MT, ZP, DM}; pg8::StaticOrder S; S.init(MT, ZP, F.G, F.bid); pg8::EpiBf16<0> E{F.Z, ZP};
        pg8::gemm_phase<pg8::EpiBf16<0>, pg8::StaticOrder, true, true>(F.lds, g, S, E, tid); } SEAM(p0 + 1);
    if (IN(p0 + 2)) { PHASE_ENTER(); phase_prep(F, L); } SEAM(p0 + 2);
    if (IN(p0 + 3)) { PHASE_ENTER(); phase_scan(F, L); } SEAM(p0 + 3);
    if (IN(p0 + 4)) { PHASE_ENTER(); phase_post(F, L, Mo); } SEAM(p0 + 4);
    if (IN(p0 + 5)) { PHASE_ENTER(); pg8::Gemm g{F.A, F.Wout_t, Mo, DM, DM}; pg8::StaticOrder S; S.init(Mo, DM, F.G, F.bid); pg8::EpiRes E{xl_in, xc_in, F.out, F.xc, modl + 2 * 1024};
        pg8::gemm_phase<pg8::EpiRes, pg8::StaticOrder, true, true>(F.lds, g, S, E, tid); } SEAM(p0 + 5);
    if (IN(p0 + 6)) { PHASE_ENTER(); phase_norm(F, F.out, F.xc, F.ap->in[I_N2G] + L * DM, modl, 3, 4, Mo); } SEAM(p0 + 6);
    if (IN(p0 + 7)) { PHASE_ENTER(); pg8::Gemm g{F.A, F.W1_t, Mo, DFF, DM}; pg8::StaticOrder S; S.init(Mo, DFF, F.G, F.bid); pg8::EpiBf16<2> E{F.H, DFF};
        pg8::gemm_phase<pg8::EpiBf16<2>, pg8::StaticOrder, true, true>(F.lds, g, S, E, tid); } SEAM(p0 + 7);
    if (IN(p0 + 8)) { PHASE_ENTER(); pg8::Gemm g{F.H, F.W2_t, Mo, DM, DFF}; pg8::StaticOrder S; S.init(Mo, DM, F.G, F.bid); pg8::EpiRes E{F.out, F.xc, F.out, F.xc, modl + 5 * 1024};
        pg8::gemm_phase<pg8::EpiRes, pg8::StaticOrder, true, true>(F.lds, g, S, E, tid); } SEAM(p0 + 8);
}
__global__ void __launch_bounds__(NTHR, 2) mega_fwd(Args args) {
    extern __shared__ __attribute__((aligned(16))) unsigned char lds_raw[];
    LAS unsigned char* lds = (LAS unsigned char*)lds_raw;
    const int lo = args.ph_lo, hi = args.ph_hi;
    cg::grid_group grid = cg::this_grid();
    { constexpr int L = 0; if (IN(0)) { PHASE_ENTER(); phase_mod(F); } SEAM(0); }
    run_layer<0>(lo, hi, lds, grid);
    run_layer<1>(lo, hi, lds, grid);
    { constexpr int L = 0; if (IN(N_PHASES - 1)) { PHASE_ENTER(); phase_final(F); } }
}
#undef IN
#undef SEAM

extern "C" void kernel_launch(void* const* d_in, const int* in_sizes, int n_in, void* d_out, int out_size, void* d_ws, size_t ws_size, hipStream_t stream) {
    static int grid = 0;
    if (grid == 0) {
        int dev = 0, cus = 0, per_cu = 0;
        hipGetDevice(&dev); hipDeviceGetAttribute(&cus, hipDeviceAttributeMultiprocessorCount, dev);
        hipFuncSetAttribute((const void*)mega_fwd, hipFuncAttributeMaxDynamicSharedMemorySize, LDS_BYTES);
        hipOccupancyMaxActiveBlocksPerMultiprocessor(&per_cu, (const void*)mega_fwd, NTHR, LDS_BYTES);
        if (per_cu < 1) { fprintf(stderr, "kernel_launch: occupancy query says %d blocks per CU\n", per_cu); per_cu = 1; }
        (void)hipGetLastError();
        grid = cus * per_cu;
        if (n_in != 29 || ws_size < WS_END) fprintf(stderr, "kernel_launch: unexpected n_in %d / ws_size %zu (need %zu)\n", n_in, ws_size, (size_t)WS_END);
    }
    Args a{};
    for (int i = 0; i < 29; ++i) a.in[i] = (const float*)d_in[i];
    a.out = (float*)d_out; a.ws = (unsigned char*)d_ws;
#if MK_ONE_LAUNCH
    a.ph_lo = 0; a.ph_hi = N_PHASES;
    void* kargs[] = {&a};
    hipError_t e = hipLaunchCooperativeKernel((const void*)mega_fwd, dim3(grid), dim3(NTHR), kargs, LDS_BYTES, stream);
    if (e != hipSuccess) fprintf(stderr, "cooperative launch failed: %s (grid %d)\n", hipGetErrorString(e), grid);
#else
    for (int ph = 0; ph < N_PHASES; ++ph) { a.ph_lo = ph; a.ph_hi = ph + 1;
        hipLaunchKernelGGL(mega_fwd, dim3(grid), dim3(NTHR), LDS_BYTES, stream, a); }
#endif
}
```

```cpp
#include <hip/hip_runtime.h>
#include <hip/hip_cooperative_groups.h>
#include <cstdio>
#include <cstdint>
namespace cg = cooperative_groups;

#ifndef MK_ONE_LAUNCH
#define MK_ONE_LAUNCH 1
#endif

#define LAS __attribute__((address_space(3)))
#define GAS __attribute__((address_space(1)))
typedef unsigned short bf16_t;
typedef float f32x4 __attribute__((ext_vector_type(4)));
typedef float f32x2 __attribute__((ext_vector_type(2)));
typedef unsigned u32x4 __attribute__((ext_vector_type(4)));
typedef unsigned u32x2 __attribute__((ext_vector_type(2)));

constexpr int DM = 1024, NB = 4, SEQ = 8192, CTXL = 256, DEPTH = 2, DFF = 4096;
constexpr int ML = NB * SEQ, MC = NB * CTXL, MT = ML + MC;
constexpr int INC = 3520, ZP = 3584;
constexpr int GLA_OFF = 0, RW_OFF = 1184, RET_OFF = 2496;
constexpr int YB_OFF = RW_OFF;
constexpr int SEQT = CTXL + SEQ;
constexpr int NTHR = 512, NWAVES = 8;

constexpr size_t MiB = 1u << 20;
constexpr size_t WS_CTL = 0, CTL_BYTES = 1 * MiB;
constexpr size_t WS_MOD = 1 * MiB;
constexpr size_t WS_WIN = 2 * MiB, WS_WOUT = 9 * MiB, WS_W1 = 11 * MiB, WS_W2 = 19 * MiB;
constexpr size_t WS_XC = 27 * MiB;
constexpr size_t WS_ABUF = 32 * MiB;
constexpr size_t WS_Z = 98 * MiB;
constexpr size_t WS_PREP = 329 * MiB;
constexpr size_t PREP_STRIDE = (size_t)MT * 384;
constexpr size_t WS_H = 98 * MiB;
constexpr size_t WS_END = WS_PREP + 7 * PREP_STRIDE * 2;
static_assert(WS_ABUF + (size_t)MT * DM * 2 <= WS_Z, "ws map");
static_assert(WS_Z + (size_t)MT * ZP * 2 <= WS_PREP, "ws map");
static_assert(WS_H + (size_t)MT * DFF * 2 <= WS_END, "ws map");
static_assert(WS_END <= 512 * MiB, "ws map");
enum { PR_R = 0, PR_WF = 1, PR_WB = 2, PR_K = 3, PR_V = 4, PR_KK = 5, PR_B = 6 };

constexpr int LDS_BYTES = 147456;

__device__ __forceinline__ float bf2f(bf16_t v) { return __uint_as_float(((unsigned)v) << 16); }
__device__ __forceinline__ unsigned f2bf_u(float f) { unsigned u = __float_as_uint(f); return (u + 0x7fffu + ((u >> 16) & 1u)) >> 16; }
__device__ __forceinline__ bf16_t f2bf(float f) { return (bf16_t)f2bf_u(f); }
__device__ __forceinline__ unsigned pk2(float lo, float hi) { return f2bf_u(lo) | (f2bf_u(hi) << 16); }
__device__ __forceinline__ float sigmoidf_(float x) { return 1.0f / (1.0f + __expf(-x)); }
__device__ __forceinline__ float siluf_(float x) { return x / (1.0f + __expf(-x)); }
__device__ __forceinline__ float softplusf_(float x) { return fmaxf(x, 0.f) + log1pf(__expf(-fabsf(x))); }
__device__ __forceinline__ float wave_sum(float v) {
#pragma unroll
    for (int o = 1; o < 64; o <<= 1) v += __shfl_xor(v, o);
    return v;
}
template <int CTRL> __device__ __forceinline__ float dpp_mov(float x) { return __int_as_float(__builtin_amdgcn_update_dpp(0, __float_as_int(x), CTRL, 0xF, 0xF, true)); }
__device__ __forceinline__ float reduce16(float x) {
    x += dpp_mov<0xB1>(x);
    x += dpp_mov<0x4E>(x);
    x += dpp_mov<0x141>(x);
    x += dpp_mov<0x140>(x);
    return x;
}
#define LDS_WAIT() asm volatile("s_waitcnt lgkmcnt(0)" ::: "memory")

namespace pg8 {
#define PG8_LAS __attribute__((address_space(3)))
typedef unsigned short bf16_t;
typedef short bf16x8 __attribute__((ext_vector_type(8)));
typedef float f32x4 __attribute__((ext_vector_type(4)));
typedef unsigned u32x4 __attribute__((ext_vector_type(4)));
constexpr int BM = 256, BK = 64, HALF = 128, HTB = HALF * BK * 2  , STAGE_BYTES = 8 * HTB, NXCD = 8, WGM = 8;

__host__ __device__ __forceinline__ int lds_byte(int r, int c) { const int st = (r >> 4) * 2 + (c >> 5), rr = r & 15, cc = c & 31, ob = rr * 64 + cc * 2; return st * 1024 + (ob ^ (((ob >> 9) & 1) << 5)); }
__host__ __device__ __forceinline__ void stage_rc(int b, int& R, int& C) { const int st = b / 1024, sb = b % 1024, swz = sb ^ (((sb >> 9) & 1) << 5); R = (st >> 1) * 16 + swz / 64; C = (st & 1) * 32 + (swz % 64) / 2; }
__host__ __device__ __forceinline__ int perm32(int rho) { const int n = rho >> 4, i = rho & 15; return 8 * (i >> 2) + 4 * n + (i & 3); }

struct Unit { int pm, pn; };
struct Gemm { const bf16_t* A; const bf16_t* Bt; int M, N, K; };

struct StaticOrder {
    int nM, nN, nwg, G, c;
    __host__ __device__ void init(int M, int N, int G_, int c_) { nM = M / BM; nN = N / BM; nwg = nM * nN; G = G_; c = c_; }
    __host__ __device__ bool next(int i, Unit& u) const {
        const long L = (long)i * G + c; if (L >= nwg) return false;
        int wgid = (int)L; { const int q = nwg / NXCD, r = nwg % NXCD, xcd = wgid % NXCD, off = wgid / NXCD; wgid = (xcd < r ? xcd * (q + 1) : r * (q + 1) + (xcd - r) * q) + off; }
        const int nig = WGM * nN, gid = wgid / nig, fm = gid * WGM, gsz = (nM - fm) < WGM ? (nM - fm) : WGM;
        u.pm = fm + ((wgid % nig) % gsz); u.pn = (wgid % nig) / gsz; return true;
    }
    __device__ __forceinline__ void a_ready(const Unit&) const {}
    __device__ __forceinline__ void done(const Unit&) const {}
};

template <class Epi, class Sched, bool ALIGN_EPI = false, bool SP2 = false>
__device__ __forceinline__ void gemm_phase(PG8_LAS unsigned char* lds, const Gemm g, const Sched& S, const Epi& E, const int tid) {
    const int wid = __builtin_amdgcn_readfirstlane(tid >> 6), lane = tid & 63, wr = wid >> 2, wc = wid & 3, fr = lane & 15, fq = lane >> 4;
    const int K = g.K, nt = K / BK;
    unsigned voffA[2], voffB[2];
#pragma unroll
    for (int i = 0; i < 2; ++i) { int R, C; stage_rc(tid * 16 + i * 8192, R, C); const int Rb = Epi::PERM ? ((R & ~31) + perm32(R & 31)) : R;
        voffA[i] = (unsigned)(R * K + C) * 2u; voffB[i] = (unsigned)(Rb * K + C) * 2u; }
    const size_t kstep = (size_t)(BK * 2);
    const size_t hstep = (size_t)HALF * K * 2;
    const size_t tstep = 2 * hstep;
    const unsigned ldsw = (unsigned)wid * 1024u;
    const int aoff = lds_byte(wr * 64 + fr, fq * 8), boff = lds_byte(wc * 32 + fr, fq * 8);
#define PG8_SA(b, h) (((b) * 2 + (h)) * HTB)
#define PG8_SB(b, h) ((4 + (b) * 2 + (h)) * HTB)
#define PG8_STAGE(bufoff, gbase, voff) do { _Pragma("unroll") for (int _i = 0; _i < 2; ++_i) \
        __builtin_amdgcn_global_load_lds((const unsigned*)((const char*)(gbase) + (voff)[_i]), (PG8_LAS unsigned*)(lds + (bufoff) + ldsw + _i * 8192), 16, 0, 0); } while (0)
#define PG8_LDA(dst, b, h) do { _Pragma("unroll") for (int m = 0; m < 4; ++m) _Pragma("unroll") for (int k = 0; k < 2; ++k) dst[m][k] = *(const PG8_LAS bf16x8*)(lds + PG8_SA(b, h) + aoff + m * 2048 + k * 1024); } while (0)
#define PG8_LDB(dst, b, h) do { _Pragma("unroll") for (int n = 0; n < 2; ++n) _Pragma("unroll") for (int k = 0; k < 2; ++k) dst[n][k] = *(const PG8_LAS bf16x8*)(lds + PG8_SB(b, h) + boff + n * 2048 + k * 1024); } while (0)
#define PG8_MMA(ai, bj, At, Bt) do { __builtin_amdgcn_s_setprio(1); _Pragma("unroll") for (int m = 0; m < 4; ++m) _Pragma("unroll") for (int n = 0; n < 2; ++n) _Pragma("unroll") for (int k = 0; k < 2; ++k) \
        acc[ai][bj][m][n] = __builtin_amdgcn_mfma_f32_16x16x32_bf16(Bt[n][k], At[m][k], acc[ai][bj][m][n], 0, 0, 0); __builtin_amdgcn_s_setprio(0); } while (0)
#define PG8_WAIT_V(n) asm volatile("s_waitcnt vmcnt(" #n ")" ::: "memory")
#define PG8_WAIT_L(n) asm volatile("s_waitcnt lgkmcnt(" #n ")" ::: "memory")
#define PG8_BAR __builtin_amdgcn_s_barrier()
#define PG8_SCHED __builtin_amdgcn_sched_barrier(0)
    Unit cur, nxt; int ui = 0;
    if (!S.next(0, cur)) return;
    f32x4 acc[2][2][4][2];
#pragma unroll
    for (int a = 0; a < 2; ++a)
#pragma unroll
        for (int b = 0; b < 2; ++b)
#pragma unroll
            for (int m = 0; m < 4; ++m)
#pragma unroll
                for (int n = 0; n < 2; ++n) acc[a][b][m][n] = (f32x4){0.f, 0.f, 0.f, 0.f};
    bf16x8 At[4][2], B0[2][2], B1[2][2];
    const char* cA = (const char*)g.A + (size_t)cur.pm * tstep; const char* cB = (const char*)g.Bt + (size_t)cur.pn * tstep;
    S.a_ready(cur);
    if constexpr (SP2) {
        PG8_STAGE(PG8_SB(0, 0), cB, voffB); PG8_STAGE(PG8_SB(0, 1), cB + hstep, voffB); PG8_STAGE(PG8_SA(0, 0), cA, voffA); PG8_STAGE(PG8_SA(0, 1), cA + hstep, voffA);
        if (wr == 1) PG8_BAR;
        PG8_WAIT_V(2); PG8_BAR;
        PG8_STAGE(PG8_SB(1, 0), cB + kstep, voffB); PG8_STAGE(PG8_SA(1, 0), cA + kstep, voffA); PG8_STAGE(PG8_SB(1, 1), cB + hstep + kstep, voffB);
        PG8_WAIT_V(6); PG8_BAR;
    } else {
        PG8_STAGE(PG8_SB(0, 0), cB, voffB); PG8_STAGE(PG8_SA(0, 0), cA, voffA); PG8_STAGE(PG8_SB(0, 1), cB + hstep, voffB); PG8_STAGE(PG8_SA(0, 1), cA + hstep, voffA);
        if (wr == 1) PG8_BAR;
        PG8_WAIT_V(4); PG8_BAR;
        PG8_STAGE(PG8_SB(1, 0), cB + kstep, voffB); PG8_STAGE(PG8_SA(1, 0), cA + kstep, voffA); PG8_STAGE(PG8_SB(1, 1), cB + hstep + kstep, voffB);
        PG8_WAIT_V(6); PG8_BAR;
    }
    for (;;) {
        const bool has_next = S.next(ui + 1, nxt);
        const char* nA = has_next ? (const char*)g.A + (size_t)nxt.pm * tstep : cA; const char* nB = has_next ? (const char*)g.Bt + (size_t)nxt.pn * tstep : cB;
        for (int t = 0; t < nt; t += 2) {
            const bool last = (t == nt - 2);
            const char* a1 = cA + (size_t)(t + 1) * kstep;
            const char* a2 = last ? nA : cA + (size_t)(t + 2) * kstep; const char* b2 = last ? nB : cB + (size_t)(t + 2) * kstep;
            const char* a3 = a2 + kstep; const char* b3 = b2 + kstep;
            if (last && has_next) S.a_ready(nxt);
            if constexpr (SP2) {
            PG8_LDB(B0, 0, 0); PG8_LDB(B1, 0, 1); PG8_SCHED; PG8_LDA(At, 0, 0); PG8_STAGE(PG8_SA(1, 1), a1 + hstep, voffA);
            PG8_WAIT_V(8); PG8_WAIT_L(0); PG8_BAR; PG8_MMA(0, 0, At, B0); PG8_MMA(0, 1, At, B1); PG8_BAR; PG8_SCHED;
            PG8_LDA(At, 0, 1); PG8_STAGE(PG8_SB(0, 0), b2, voffB); PG8_STAGE(PG8_SB(0, 1), b2 + hstep, voffB); PG8_STAGE(PG8_SA(0, 0), a2, voffA);
            PG8_WAIT_V(8); PG8_WAIT_L(0); PG8_BAR; PG8_MMA(1, 0, At, B0); PG8_MMA(1, 1, At, B1); PG8_BAR; PG8_SCHED;
            PG8_LDB(B0, 1, 0); PG8_LDB(B1, 1, 1); PG8_SCHED; PG8_LDA(At, 1, 0); PG8_STAGE(PG8_SA(0, 1), a2 + hstep, voffA);
            PG8_WAIT_V(8); PG8_WAIT_L(0); PG8_BAR; PG8_MMA(0, 0, At, B0); PG8_MMA(0, 1, At, B1); PG8_BAR; PG8_SCHED;
            PG8_LDA(At, 1, 1); PG8_STAGE(PG8_SB(1, 0), b3, voffB); PG8_STAGE(PG8_SB(1, 1), b3 + hstep, voffB); PG8_STAGE(PG8_SA(1, 0), a3, voffA);
            PG8_WAIT_V(8); PG8_WAIT_L(0); PG8_BAR; PG8_MMA(1, 0, At, B0); PG8_MMA(1, 1, At, B1); PG8_BAR; PG8_SCHED;
            } else {
            PG8_LDB(B0, 0, 0); PG8_SCHED; PG8_LDA(At, 0, 0); PG8_STAGE(PG8_SA(1, 1), a1 + hstep, voffA);
            PG8_WAIT_L(8); PG8_BAR; PG8_WAIT_L(0); PG8_MMA(0, 0, At, B0); PG8_BAR; PG8_SCHED;
            PG8_LDB(B1, 0, 1); PG8_STAGE(PG8_SB(0, 0), b2, voffB);
            PG8_BAR; PG8_WAIT_L(0); PG8_MMA(0, 1, At, B1); PG8_BAR;
            PG8_LDA(At, 0, 1); PG8_STAGE(PG8_SA(0, 0), a2, voffA);
            PG8_BAR; PG8_WAIT_L(0); PG8_MMA(1, 0, At, B0); PG8_BAR; PG8_SCHED;
            PG8_STAGE(PG8_SB(0, 1), b2 + hstep, voffB);
            PG8_WAIT_V(6); PG8_BAR; PG8_MMA(1, 1, At, B1); PG8_BAR;
            PG8_LDB(B0, 1, 0); PG8_SCHED; PG8_LDA(At, 1, 0); PG8_STAGE(PG8_SA(0, 1), a2 + hstep, voffA);
            PG8_WAIT_L(8); PG8_BAR; PG8_WAIT_L(0); PG8_MMA(0, 0, At, B0); PG8_BAR; PG8_SCHED;
            PG8_LDB(B1, 1, 1); PG8_STAGE(PG8_SB(1, 0), b3, voffB);
            PG8_BAR; PG8_WAIT_L(0); PG8_MMA(0, 1, At, B1); PG8_BAR;
            PG8_LDA(At, 1, 1); PG8_STAGE(PG8_SA(1, 0), a3, voffA);
            PG8_BAR; PG8_WAIT_L(0); PG8_MMA(1, 0, At, B0); PG8_BAR; PG8_SCHED;
            PG8_STAGE(PG8_SB(1, 1), b3 + hstep, voffB);
            PG8_WAIT_V(6); PG8_BAR; PG8_MMA(1, 1, At, B1); PG8_BAR;
            }
        }
        if constexpr (ALIGN_EPI) { if (wr == 0) PG8_BAR; }
        if constexpr (!Epi::AFTER_DRAIN) { E(acc, cur, wr, wc, fr, fq); S.done(cur); }
        if (!has_next) break;
#pragma unroll
        for (int a = 0; a < 2; ++a)
#pragma unroll
            for (int b = 0; b < 2; ++b)
#pragma unroll
                for (int m = 0; m < 4; ++m)
#pragma unroll
                    for (int n = 0; n < 2; ++n) acc[a][b][m][n] = (f32x4){0.f, 0.f, 0.f, 0.f};
        cur = nxt; cA = nA; cB = nB; ++ui;
        if constexpr (ALIGN_EPI) { if (wr == 1) PG8_BAR; }
    }
    PG8_WAIT_V(0);
    if constexpr (!ALIGN_EPI) { if (wr == 0) PG8_BAR; }
    PG8_BAR;
    if constexpr (Epi::AFTER_DRAIN) { E.fused(acc, cur, wr, wc, fr, fq, lds, wid, lane); S.done(cur); }
#undef PG8_SA
#undef PG8_SB
#undef PG8_STAGE
#undef PG8_LDA
#undef PG8_LDB
#undef PG8_MMA
#undef PG8_WAIT_V
#undef PG8_WAIT_L
#undef PG8_BAR
#undef PG8_SCHED
}
}

namespace pg8 {
template <int ACT> struct EpiBf16 {
    static constexpr bool PERM = true, AFTER_DRAIN = false;
    bf16_t* O; int ldc;
    __device__ __forceinline__ void operator()(const f32x4 (&acc)[2][2][4][2], const Unit& u, int wr, int wc, int fr, int fq) const {
        const int row0 = u.pm * BM + wr * 64 + fr; const int col0 = u.pn * BM + wc * 32 + 8 * fq;
#pragma unroll
        for (int ai = 0; ai < 2; ++ai)
#pragma unroll
            for (int m = 0; m < 4; ++m) { bf16_t* rowp = O + (size_t)(row0 + ai * HALF + m * 16) * ldc + col0;
#pragma unroll
                for (int bj = 0; bj < 2; ++bj) { f32x4 v0 = acc[ai][bj][m][0], v1 = acc[ai][bj][m][1];
                    if (ACT == 2) {
#pragma unroll
                        for (int e = 0; e < 4; ++e) { float a = fmaxf(v0[e], 0.f), b = fmaxf(v1[e], 0.f); v0[e] = a * a; v1[e] = b * b; } }
                    u32x4 w; w.x = ::pk2(v0[0], v0[1]); w.y = ::pk2(v0[2], v0[3]); w.z = ::pk2(v1[0], v1[1]); w.w = ::pk2(v1[2], v1[3]);
                    *(u32x4*)(rowp + bj * HALF) = w; } }
    }
};
struct EpiRes {
    static constexpr bool PERM = false, AFTER_DRAIN = false;
    const float* base_lat; const float* base_ctx; float* out_lat; float* out_ctx; const float* gate  ;
    __device__ __forceinline__ void operator()(const f32x4 (&acc)[2][2][4][2], const Unit& u, int wr, int wc, int fr, int fq) const {
        const bool lat = u.pm < (ML / BM); const int mi = lat ? (u.pm >> 5) : 4;
        const float* gv = gate + (size_t)mi * 6144;
        const size_t tile_off = lat ? (size_t)u.pm * BM * DM : (size_t)(u.pm - ML / BM) * BM * DM;
        const float* bp = (lat ? base_lat : base_ctx) + tile_off; float* op = (lat ? out_lat : out_ctx) + tile_off;
        const int col0 = u.pn * BM + wc * 32 + 4 * fq;
        f32x4 g4[2][2];
#pragma unroll
        for (int bj = 0; bj < 2; ++bj)
#pragma unroll
            for (int n = 0; n < 2; ++n) g4[bj][n] = *(const f32x4*)(gv + col0 + bj * HALF + n * 16);
#pragma unroll
        for (int ai = 0; ai < 2; ++ai)
#pragma unroll
            for (int m = 0; m < 4; ++m) { const size_t off = (size_t)(ai * HALF + wr * 64 + m * 16 + fr) * DM + col0;
#pragma unroll
                for (int bj = 0; bj < 2; ++bj)
#pragma unroll
                    for (int n = 0; n < 2; ++n) { const f32x4 bs = *(const f32x4*)(bp + off + bj * HALF + n * 16);
                        *(f32x4*)(op + off + bj * HALF + n * 16) = bs + g4[bj][n] * acc[ai][bj][m][n]; } }
    }
};
}

struct Args { const float* in[29]; float* out; unsigned char* ws; int ph_lo, ph_hi; };
enum { I_X = 0, I_C, I_CTX, I_CCTX, I_FNG, I_MODW, I_MODB, I_N1G, I_N2G, I_WIN, I_WOUT, I_W1, I_W2, I_GGW2, I_GGB, I_GNG, I_RMU, I_RW0, I_RW2, I_RA0, I_RA2, I_RG2,
       I_RKK, I_RKA, I_RRK, I_RLNG, I_RLNB, I_RETLR, I_RETNG };

typedef const __attribute__((address_space(4))) Args* CArgs;
struct Frame {
    LAS unsigned char* lds;
    int tid, lane, wave, bid, G;
    CArgs ap; float* out; unsigned char* ws;
    float* mod; bf16_t *Win_t, *Wout_t, *W1_t, *W2_t; float* xc; bf16_t *A, *Z, *PREP, *H;
};

__device__ __forceinline__ int mod_index(int m) { return m < ML ? (m >> 13) : 4; }
__device__ __forceinline__ int seq_row(int b, int dir, int s) {
    if (s < CTXL) { const int tc = dir ? (CTXL - 1 - s) : s; return ML + b * CTXL + tc; }
    const int tl = s - CTXL; const int t = dir ? (SEQ - 1 - tl) : tl; return b * SEQ + t;
}
__device__ __forceinline__ float zshift(const bf16_t* Z, int m, int col, float mu) {
    const bf16_t* p = Z + (size_t)m * ZP + col;
    const float z0 = bf2f(*p); float nb;
    if (m < ML) { const int t = m & (SEQ - 1), gr = t >> 6, gc = t & 63; float s = 0.f;
        if (gr > 0) s += bf2f(*(p - (ptrdiff_t)64 * ZP)); if (gr < 127) s += bf2f(*(p + (ptrdiff_t)64 * ZP));
        if (gc > 0) s += bf2f(*(p - (ptrdiff_t)ZP)); if (gc < 63) s += bf2f(*(p + (ptrdiff_t)ZP));
        nb = 0.25f * s;
    } else { const int t = (m - ML) & (CTXL - 1); float s = 0.f;
        if (t > 0) s += bf2f(*(p - (ptrdiff_t)ZP)); if (t < CTXL - 1) s += bf2f(*(p + (ptrdiff_t)ZP));
        nb = 0.5f * s; }
    return z0 + mu * (nb - z0);
}

__device__ __forceinline__ void phase_mod(Frame& F) {
    LAS float* sc = (LAS float*)F.lds;
    LAS float* red = sc + 5 * 1024;
    for (int i = F.tid; i < 5 * 1024; i += NTHR) { const int j = i >> 10, k = i & 1023; const float v = j < 4 ? F.ap->in[I_C][j * 1024 + k] : F.ap->in[I_CCTX][k]; sc[i] = siluf_(v); }
    __syncthreads();
    const int kg = F.tid >> 6, c = F.tid & 63;
    for (int it = F.bid; it < DEPTH * 96; it += F.G) {
        const int l = it / 96, cgp = it % 96, col = cgp * 64 + c;
        const float* W = F.ap->in[I_MODW] + (size_t)l * DM * 6144 + col;
        float a0 = 0.f, a1 = 0.f, a2 = 0.f, a3 = 0.f, a4 = 0.f;
#pragma unroll 4
        for (int k = kg * 128; k < kg * 128 + 128; ++k) { const float w = W[(size_t)k * 6144];
            a0 += sc[k] * w; a1 += sc[1024 + k] * w; a2 += sc[2048 + k] * w; a3 += sc[3072 + k] * w; a4 += sc[4096 + k] * w; }
        red[(kg * 5 + 0) * 64 + c] = a0; red[(kg * 5 + 1) * 64 + c] = a1; red[(kg * 5 + 2) * 64 + c] = a2; red[(kg * 5 + 3) * 64 + c] = a3; red[(kg * 5 + 4) * 64 + c] = a4;
        __syncthreads();
        if (F.tid < 320) { const int j = F.tid >> 6; float s = 0.f;
#pragma unroll
            for (int g = 0; g < 8; ++g) s += red[(g * 5 + j) * 64 + c];
            F.mod[((size_t)l * 5 + j) * 6144 + col] = s + F.ap->in[I_MODB][l * 6144 + col]; }
        __syncthreads();
    }
}

__device__ __forceinline__ void transpose_item(const float* W, int K, int N, bf16_t* WT, LAS float* scr, int item, int lane) {
    const int nblk = N / 32, kb = item / nblk, nb = item % nblk, k0 = 64 * kb, n0 = 32 * nb;
#pragma unroll 8
    for (int i = 0; i < 32; ++i) { const int kk = 2 * i + (lane >> 5); scr[kk * 33 + (lane & 31)] = W[(size_t)(k0 + kk) * N + n0 + (lane & 31)]; }
    LDS_WAIT(); asm volatile("" ::: "memory");
    const int c = lane & 7;
#pragma unroll
    for (int j = 0; j < 4; ++j) { const int n = (lane >> 3) + 8 * j; const LAS float* s = scr + (8 * c) * 33 + n;
        u32x4 o; o.x = pk2(s[0 * 33], s[1 * 33]); o.y = pk2(s[2 * 33], s[3 * 33]); o.z = pk2(s[4 * 33], s[5 * 33]); o.w = pk2(s[6 * 33], s[7 * 33]);
        *(u32x4*)(WT + (size_t)(n0 + n) * K + k0 + 8 * c) = o; }
    LDS_WAIT(); asm volatile("" ::: "memory");
}
__device__ __forceinline__ void phase_wconv(Frame& F, int l) {
    LAS float* scr = (LAS float*)(F.lds + F.wave * 16384);
    const int gw = F.bid * NWAVES + F.wave, NGW = F.G * NWAVES;
    constexpr int I_IN = (DM / 64) * (INC / 32), I_O = (DM / 64) * (DM / 32), I_1 = (DM / 64) * (DFF / 32), I_2 = (DFF / 64) * (DM / 32);
    const float* Win = F.ap->in[I_WIN] + (size_t)l * DM * INC; const float* Wout = F.ap->in[I_WOUT] + (size_t)l * DM * DM;
    const float* W1 = F.ap->in[I_W1] + (size_t)l * DM * DFF; const float* W2 = F.ap->in[I_W2] + (size_t)l * DFF * DM;
    for (int it = gw; it < I_IN + I_O + I_1 + I_2; it += NGW) {
        int r = it;
        if (r < I_IN) { transpose_item(Win, DM, INC, F.Win_t, scr, r, F.lane); continue; } r -= I_IN;
        if (r < I_O) { transpose_item(Wout, DM, DM, F.Wout_t, scr, r, F.lane); continue; } r -= I_O;
        if (r < I_1) { transpose_item(W1, DM, DFF, F.W1_t, scr, r, F.lane); continue; } r -= I_1;
        transpose_item(W2, DFF, DM, F.W2_t, scr, r, F.lane);
    }
    { u32x4* zp = (u32x4*)(F.Win_t + (size_t)INC * DM); const int n16 = (ZP - INC) * DM * 2 / 16;
      for (int i = F.bid * NTHR + F.tid; i < n16; i += F.G * NTHR) zp[i] = (u32x4){0u, 0u, 0u, 0u}; }
}

__device__ __forceinline__ void phase_norm(Frame& F, const float* src_lat, const float* src_ctx, const float* g, const float* modl, int shift_idx, int scale_idx, int Mrows) {
    const int gw = F.bid * NWAVES + F.wave, NGW = F.G * NWAVES;
    for (int m = gw; m < Mrows; m += NGW) {
        const float* xrow = m < ML ? src_lat + (size_t)m * DM : src_ctx + (size_t)(m - ML) * DM;
        const float* mv = modl + (size_t)mod_index(m) * 6144;
        const f32x4* xr = (const f32x4*)xrow + F.lane;
        f32x4 v[4]; float ss = 0.f;
#pragma unroll
        for (int j = 0; j < 4; ++j) { v[j] = xr[64 * j]; ss += (v[j].x * v[j].x + v[j].y * v[j].y) + (v[j].z * v[j].z + v[j].w * v[j].w); }
        const float r = rsqrtf(wave_sum(ss) * (1.f / DM) + 1e-6f);
        u32x2* o8 = (u32x2*)(F.A + (size_t)m * DM) + F.lane;
#pragma unroll
        for (int j = 0; j < 4; ++j) { const int col = 4 * F.lane + 256 * j;
            const f32x4 gg = *(const f32x4*)(g + col), sh = *(const f32x4*)(mv + shift_idx * 1024 + col), sc = *(const f32x4*)(mv + scale_idx * 1024 + col);
            const f32x4 y = v[j] * r * gg * (sc + 1.0f) + sh;
            u32x2 w; w.x = pk2(y.x, y.y); w.y = pk2(y.z, y.w); o8[64 * j] = w; }
    }
}
__device__ __forceinline__ void phase_final(Frame& F) {
    const int gw = F.bid * NWAVES + F.wave, NGW = F.G * NWAVES; const float* g = F.ap->in[I_FNG];
    for (int m = gw; m < ML; m += NGW) {
        f32x4* xr = (f32x4*)(F.out + (size_t)m * DM) + F.lane;
        f32x4 v[4]; float ss = 0.f;
#pragma unroll
        for (int j = 0; j < 4; ++j) { v[j] = xr[64 * j]; ss += (v[j].x * v[j].x + v[j].y * v[j].y) + (v[j].z * v[j].z + v[j].w * v[j].w); }
        const float r = rsqrtf(wave_sum(ss) * (1.f / DM) + 1e-6f);
#pragma unroll
        for (int j = 0; j < 4; ++j) { const f32x4 gg = *(const f32x4*)(g + 4 * F.lane + 256 * j); xr[64 * j] = v[j] * r * gg; }
    }
}

__device__ __forceinline__ void phase_prep(Frame& F, int l) {
    constexpr int TG = 8;
    LAS float* lr = (LAS float*)F.lds;
    const float* mu = F.ap->in[I_RMU] + l * 1312;
    const int c = F.tid;
    float w2f[32], w2b[32], a2[32]; float w0f = 0, w0b = 0, a0 = 0, kk_ = 0, ka_ = 0, mur = 0, muk = 0, muv = 0;
    if (c < 384) {
#pragma unroll
        for (int j = 0; j < 32; ++j) { w2f[j] = F.ap->in[I_RW2][((size_t)(l * 2 + 0) * 32 + j) * 384 + c]; w2b[j] = F.ap->in[I_RW2][((size_t)(l * 2 + 1) * 32 + j) * 384 + c]; a2[j] = F.ap->in[I_RA2][((size_t)l * 32 + j) * 384 + c]; }
        w0f = F.ap->in[I_RW0][(l * 2 + 0) * 384 + c]; w0b = F.ap->in[I_RW0][(l * 2 + 1) * 384 + c]; a0 = F.ap->in[I_RA0][l * 384 + c];
        kk_ = F.ap->in[I_RKK][l * 384 + c]; ka_ = F.ap->in[I_RKA][l * 384 + c]; mur = mu[c]; muk = mu[384 + c]; muv = mu[768 + c];
    }
    for (int it = F.bid; it < MT / TG; it += F.G) {
        const int m0 = it * TG;
        for (int i = F.tid; i < TG * 96; i += NTHR) { const int tok = i / 96, j = i % 96; const float v = zshift(F.Z, m0 + tok, RW_OFF + 1152 + j, mu[1152 + j]); lr[i] = j < 64 ? tanhf(v) : v; }
        __syncthreads();
        if (c < 384) {
            for (int tok = 0; tok < TG; ++tok) {
                const int m = m0 + tok;
                const float r = zshift(F.Z, m, RW_OFF + c, mur), k = zshift(F.Z, m, RW_OFF + 384 + c, muk), v = zshift(F.Z, m, RW_OFF + 768 + c, muv);
                float xf = w0f, xb = w0b, xa = a0;
#pragma unroll
                for (int j = 0; j < 32; ++j) { xf += lr[tok * 96 + j] * w2f[j]; xb += lr[tok * 96 + 32 + j] * w2b[j]; xa += lr[tok * 96 + 64 + j] * a2[j]; }
                const float ef = __expf(-softplusf_(-xf) - 0.5f), eb = __expf(-softplusf_(-xb) - 0.5f);
                const float dwf = -expm1f(-ef), dwb = -expm1f(-eb);
                const float a = sigmoidf_(xa);
                float kk = k * kk_; const float ss = wave_sum(kk * kk); kk *= rsqrtf(ss + 1e-12f);
                const float kp = k * (1.f + (a - 1.f) * ka_), bb = kk * a;
                const size_t o = (size_t)m * 384 + c;
                F.PREP[PR_R * PREP_STRIDE + o] = f2bf(r); F.PREP[PR_WF * PREP_STRIDE + o] = f2bf(dwf); F.PREP[PR_WB * PREP_STRIDE + o] = f2bf(dwb);
                F.PREP[PR_K * PREP_STRIDE + o] = f2bf(kp); F.PREP[PR_V * PREP_STRIDE + o] = f2bf(v); F.PREP[PR_KK * PREP_STRIDE + o] = f2bf(kk); F.PREP[PR_B * PREP_STRIDE + o] = f2bf(bb);
            }
        }
        __syncthreads();
    }
}

#ifndef SCAN_GLA_V0
#define SCAN_GLA_V0 0
#endif
__device__ __forceinline__ void gla_scan_block(Frame& F, int l, int chain) {
    constexpr int TS = 64;
    const int dir = chain & 1, h = (chain >> 1) & 3, b = chain >> 3;
    LAS float* q = (LAS float*)F.lds;
    LAS float* k = q + TS * 48; LAS float* g = k + TS * 48;
    LAS float* v = g + TS * 48;
    LAS float* y = v + TS * 96;
    const float* W2 = F.ap->in[I_GGW2] + (size_t)(l * 2 + dir) * 16 * 192 + h * 48; const float* Bg = F.ap->in[I_GGB] + (l * 2 + dir) * 192 + h * 48;
    const float qs = 0.14433756729740643f;
    float S[48];
#pragma unroll
    for (int j = 0; j < 48; ++j) S[j] = 0.f;
    for (int tile = 0; tile < SEQT / TS; ++tile) {
        const int sbase = tile * TS;
        for (int i = F.tid; i < TS * 48; i += NTHR) { const int st = i / 48, j = i % 48; const int m = seq_row(b, dir, sbase + st); const bf16_t* zr = F.Z + (size_t)m * ZP;
            q[i] = bf2f(zr[GLA_OFF + h * 48 + j]) * qs; k[i] = bf2f(zr[GLA_OFF + 192 + h * 48 + j]);
            float x = Bg[j];
#pragma unroll
            for (int r = 0; r < 16; ++r) x += bf2f(zr[GLA_OFF + 1152 + dir * 16 + r]) * W2[r * 192 + j];
            const float ls = fminf(x, 0.f) - log1pf(__expf(-fabsf(x)));
            g[i] = __expf(ls * (1.0f / 16.0f)); }
        for (int i = F.tid; i < TS * 96; i += NTHR) { const int st = i / 96, n = i % 96; const int m = seq_row(b, dir, sbase + st); v[i] = bf2f(F.Z[(size_t)m * ZP + GLA_OFF + 384 + h * 96 + n]); }
        __syncthreads();
        if (F.tid < 96) {
            for (int st = 0; st < TS; ++st) { const float vn = v[st * 96 + F.tid]; float o = 0.f;
#pragma unroll
                for (int j = 0; j < 48; ++j) { S[j] = S[j] * g[st * 48 + j] + k[st * 48 + j] * vn; o += q[st * 48 + j] * S[j]; }
                y[st * 96 + F.tid] = o; }
        }
        __syncthreads();
        for (int i = F.tid; i < TS * 96; i += NTHR) { const int st = i / 96, n = i % 96; const int m = seq_row(b, dir, sbase + st); const bf16_t o = f2bf(y[i]);
            if (dir == 0) F.A[(size_t)m * DM + h * 96 + n] = o; else F.Z[(size_t)m * ZP + YB_OFF + h * 96 + n] = o; }
        __syncthreads();
    }
}
typedef short bf16x8 __attribute__((ext_vector_type(8)));
__device__ __forceinline__ void rwkv_stage(const bf16_t* PREP, LAS float* vecb, LAS float* vvb, int b, int dir, int h, int quarter, int wsel, int sbase, int lt) {
    constexpr int TS = 32;
    const int st = lt >> 3, part = lt & 7; const int m = seq_row(b, dir, sbase + st);
    const bf16_t* src = PREP + (size_t)m * 384 + h * 64 + part * 8;
    u32x4 raw[5];
    raw[0] = *(const u32x4*)(src + (size_t)PR_KK * PREP_STRIDE); raw[1] = *(const u32x4*)(src + (size_t)wsel * PREP_STRIDE); raw[2] = *(const u32x4*)(src + (size_t)PR_B * PREP_STRIDE);
    raw[3] = *(const u32x4*)(src + (size_t)PR_K * PREP_STRIDE); raw[4] = *(const u32x4*)(src + (size_t)PR_R * PREP_STRIDE);
    bf16_t vraw[2];
#pragma unroll
    for (int q = 0; q < 2; ++q) { const int idx = lt + 256 * q, s2 = idx >> 4, rr = idx & 15; const int m2 = seq_row(b, dir, sbase + s2);
        vraw[q] = PREP[(size_t)PR_V * PREP_STRIDE + (size_t)m2 * 384 + h * 64 + quarter * 16 + rr]; }
#pragma unroll
    for (int vi = 0; vi < 5; ++vi) { const u32x4 r = raw[vi]; f32x4 lo, hi;
        lo.x = __uint_as_float(r.x << 16); lo.y = __uint_as_float(r.x & 0xffff0000u); lo.z = __uint_as_float(r.y << 16); lo.w = __uint_as_float(r.y & 0xffff0000u);
        hi.x = __uint_as_float(r.z << 16); hi.y = __uint_as_float(r.z & 0xffff0000u); hi.z = __uint_as_float(r.w << 16); hi.w = __uint_as_float(r.w & 0xffff0000u);
        if (vi == 1) { lo = 1.0f - lo; hi = 1.0f - hi; }
        LAS float* dst = vecb + (vi * TS + st) * 64 + part * 8; *(LAS f32x4*)dst = lo; *(LAS f32x4*)(dst + 4) = hi; }
#pragma unroll
    for (int q = 0; q < 2; ++q) { const int idx = lt + 256 * q; vvb[idx] = bf2f(vraw[q]); }
}
__device__ __forceinline__ void rwkv_flush(bf16_t* A, bf16_t* Z, const LAS float* ybb, int b, int dir, int h, int quarter, int sbase, int lt) {
#pragma unroll
    for (int q = 0; q < 2; ++q) { const int idx = lt + 256 * q, st = idx >> 4, rr = idx & 15; const int m = seq_row(b, dir, sbase + st);
        const bf16_t o = f2bf(ybb[idx]);
        if (dir == 0) A[(size_t)m * DM + 384 + h * 64 + quarter * 16 + rr] = o; else Z[(size_t)m * ZP + YB_OFF + 384 + h * 64 + quarter * 16 + rr] = o; }
}
__device__ __forceinline__ void rwkv_scan_block(Frame& F, int chain, int quarter) {
    constexpr int TS = 32, NT = SEQT / TS;
    const int dir = chain & 1, h = (chain >> 1) % 6, b = (chain >> 1) / 6;
    LAS float* vec = (LAS float*)F.lds;
    LAS float* vv = vec + 2 * 5 * TS * 64;
    LAS float* yb = vv + 2 * TS * 16;
    const bool comp = F.wave < 4;
    const int rg = F.lane >> 4, cgp = F.lane & 15, lrow = (F.wave & 3) * 4 + rg, lt = F.tid - 256;
    const int wsel = dir ? PR_WB : PR_WF;
    f32x2 sA = {0.f, 0.f}, sB = {0.f, 0.f};
    if (!comp) rwkv_stage(F.PREP, vec, vv, b, dir, h, quarter, wsel, 0, lt);
    __syncthreads();
    for (int tile = 0; tile < NT; ++tile) {
        const int cur = tile & 1;
        if (comp) {
            const LAS float* vb = vec + cur * 5 * TS * 64 + cgp * 4; const LAS float* vvb = vv + cur * TS * 16 + lrow; LAS float* ybb = yb + cur * TS * 16;
#pragma unroll
            for (int g = 0; g < TS / 16; ++g) { float yacc = 0.f;
#pragma unroll
                for (int s16 = 0; s16 < 16; ++s16) { const int st = g * 16 + s16;
                    const f32x4 kk4 = *(const LAS f32x4*)(vb + (0 * TS + st) * 64), w4 = *(const LAS f32x4*)(vb + (1 * TS + st) * 64), b4 = *(const LAS f32x4*)(vb + (2 * TS + st) * 64);
                    const f32x4 k4 = *(const LAS f32x4*)(vb + (3 * TS + st) * 64), r4 = *(const LAS f32x4*)(vb + (4 * TS + st) * 64); const float vr = vvb[st * 16];
                    const f32x2 p2 = sA * kk4.xy + sB * kk4.zw; float p = p2.x + p2.y;
                    sA = sA * w4.xy + k4.xy * vr; sB = sB * w4.zw + k4.zw * vr;
                    p = reduce16(p);
                    sA = sA - b4.xy * p; sB = sB - b4.zw * p;
                    const f32x2 y2 = sA * r4.xy + sB * r4.zw; float y = y2.x + y2.y;
                    y = reduce16(y);
                    yacc = (cgp == s16) ? y : yacc; }
                ybb[(g * 16 + cgp) * 16 + lrow] = yacc; }
        } else {
            if (tile + 1 < NT) rwkv_stage(F.PREP, vec + (cur ^ 1) * 5 * TS * 64, vv + (cur ^ 1) * TS * 16, b, dir, h, quarter, wsel, (tile + 1) * TS, lt);
            if (tile > 0) rwkv_flush(F.A, F.Z, yb + (cur ^ 1) * TS * 16, b, dir, h, quarter, (tile - 1) * TS, lt);
        }
        __syncthreads();
    }
    if (!comp) rwkv_flush(F.A, F.Z, yb + ((NT - 1) & 1) * TS * 16, b, dir, h, quarter, (NT - 1) * TS, lt);
}

namespace ce {
constexpr int PITCH = 72, IMG = 64 * PITCH * 2;
constexpr int VTB = 96 * PITCH * 2;
constexpr int O_QG = 0, O_KG = 2 * IMG, O_KET = 4 * IMG, O_VT = 6 * IMG, O_PB = O_VT + 2 * VTB, O_ST = O_PB + IMG, O_DEC = O_ST + 2 * VTB, O_WSUM = O_DEC + 512, O_END = O_WSUM + 8 * 48 * 4, O_W2 = O_END, O_END2 = O_W2 + 17 * 48 * 4;
static_assert(O_END2 <= 131072, "chunk engine LDS");
__device__ __forceinline__ bf16x8 frag(const LAS unsigned char* img, int row, int col) { return *(const LAS bf16x8*)(img + (row * PITCH + col) * 2); }
__device__ __forceinline__ void st4(LAS unsigned char* img, int row, int col, f32x4 v) { u32x2 w; w.x = pk2(v.x, v.y); w.y = pk2(v.z, v.w); *(LAS u32x2*)(img + (row * PITCH + col) * 2) = w; }
__device__ __forceinline__ f32x2 up2(unsigned u) { f32x2 r; r.x = __uint_as_float(u << 16); r.y = __uint_as_float(u & 0xffff0000u); return r; }

template <int DV> __device__ __forceinline__ void chunk_mma(Frame& F, LAS unsigned char* L, int cb, int sb, f32x4 (&acc_s)[DV / 32], int b, int dir, int cs, int ycol0) {
    constexpr int NQ = DV / 32;
    const int lane = F.lane, w = F.wave, lr = lane & 15, lq = lane >> 4;
    LAS unsigned char* Qg = L + O_QG + cb * IMG; LAS unsigned char* Kg = L + O_KG + cb * IMG; LAS unsigned char* KeT = L + O_KET + cb * IMG;
    LAS unsigned char* Vt = L + O_VT + cb * VTB; LAS unsigned char* Pb = L + O_PB; LAS unsigned char* St = L + O_ST + sb * VTB; LAS unsigned char* Sn = L + O_ST + (sb ^ 1) * VTB;
    const LAS float* dec = (const LAS float*)(L + O_DEC + cb * 256);
#pragma unroll
    for (int q = 0; q < 2; ++q) { const int idx = w + 8 * q; if (idx < 10) {
            const int jt = idx < 4 ? 0 : idx < 7 ? 1 : idx < 9 ? 2 : 3; const int it = idx < 4 ? idx : idx < 7 ? idx - 3 : idx < 9 ? idx - 5 : 3;
            f32x4 acc = {0.f, 0.f, 0.f, 0.f};
#pragma unroll
            for (int ks = 0; ks < 2; ++ks) acc = __builtin_amdgcn_mfma_f32_16x16x32_bf16(frag(Kg, jt * 16 + lr, 32 * ks + 8 * lq), frag(Qg, it * 16 + lr, 32 * ks + 8 * lq), acc, 0, 0, 0);
            if (jt == it) {
#pragma unroll
                for (int r = 0; r < 4; ++r) if (4 * lq + r > lr) acc[r] = 0.f; }
            st4(Pb, it * 16 + lr, jt * 16 + 4 * lq, acc); } }
    __syncthreads();
#pragma unroll
    for (int q = 0; q < NQ; ++q) { const int id = w + 8 * q, nt = id >> 2, it = id & 3;
        f32x4 acc = {0.f, 0.f, 0.f, 0.f};
#pragma unroll
        for (int ks = 0; ks < 2; ++ks) acc = __builtin_amdgcn_mfma_f32_16x16x32_bf16(frag(St, nt * 16 + lr, 32 * ks + 8 * lq), frag(Qg, it * 16 + lr, 32 * ks + 8 * lq), acc, 0, 0, 0);
#pragma unroll
        for (int ks = 0; ks < 2; ++ks) acc = __builtin_amdgcn_mfma_f32_16x16x32_bf16(frag(Vt, nt * 16 + lr, 32 * ks + 8 * lq), frag(Pb, it * 16 + lr, 32 * ks + 8 * lq), acc, 0, 0, 0);
        const int m = seq_row(b, dir, cs * 64 + it * 16 + lr); const int col = ycol0 + nt * 16 + 4 * lq;
        u32x2 o; o.x = pk2(acc.x, acc.y); o.y = pk2(acc.z, acc.w);
        if (dir == 0) *(u32x2*)(F.A + (size_t)m * DM + col) = o; else *(u32x2*)(F.Z + (size_t)m * ZP + YB_OFF + col) = o; }
#pragma unroll
    for (int q = 0; q < NQ; ++q) { const int id = w + 8 * q, kt = id & 3, nt = id >> 2;
        const f32x4 d4 = *(const LAS f32x4*)(dec + kt * 16 + 4 * lq);
        f32x4 acc = acc_s[q] * d4;
#pragma unroll
        for (int ks = 0; ks < 2; ++ks) acc = __builtin_amdgcn_mfma_f32_16x16x32_bf16(frag(KeT, kt * 16 + lr, 32 * ks + 8 * lq), frag(Vt, nt * 16 + lr, 32 * ks + 8 * lq), acc, 0, 0, 0);
        acc_s[q] = acc;
        st4(Sn, nt * 16 + lr, kt * 16 + 4 * lq, acc); }
}

__device__ __forceinline__ void ret_chain(Frame& F, int l, int chain) {
    constexpr int DV = 64, NCH = SEQT / 64;
    const int dir = chain & 1, h = (chain >> 1) & 3, b = chain >> 3;
    LAS unsigned char* L = F.lds;
    const int tp = F.tid >> 4, jj = F.tid & 15, t0 = 2 * tp, t1 = t0 + 1;
    const float lgam = -__expf(F.ap->in[I_RETLR][(l * 2 + dir) * 4 + h]);
    float eq[2], ek[2], ee[2];
#pragma unroll
    for (int e = 0; e < 2; ++e) { const float G = (float)(t0 + e + 1) * lgam; eq[e] = __expf(G); ek[e] = 0.125f * __expf(-G); ee[e] = 0.125f * __expf(64.0f * lgam - G); }
    const int d0 = 2 * jj;
    const bool rowb = d0 < 16; float inv[2];
#pragma unroll
    for (int e = 0; e < 2; ++e) inv[e] = powf(10000.0f, -(float)((d0 + e) & 15) * (1.0f / 16.0f));
    float ccs[2][2], csn[2][2];
#pragma unroll
    for (int tk = 0; tk < 2; ++tk)
#pragma unroll
        for (int e = 0; e < 2; ++e) { const float pos = (float)(dir ? 63 - (t0 + tk) : (t0 + tk)); sincosf(pos * inv[e], &csn[tk][e], &ccs[tk][e]); }
    for (int i = F.tid; i < IMG / 4; i += NTHR) ((LAS unsigned*)(L + O_PB))[i] = 0u;
    for (int i = F.tid; i < VTB / 4; i += NTHR) ((LAS unsigned*)(L + O_ST))[i] = 0u;
    if (F.tid < 128) ((LAS float*)(L + O_DEC))[F.tid] = __expf(64.0f * lgam);
    f32x4 acc_s[DV / 32];
#pragma unroll
    for (int q = 0; q < DV / 32; ++q) acc_s[q] = (f32x4){0.f, 0.f, 0.f, 0.f};
    unsigned rq[2][2], rk[2][2], rv[2][2];
    const bf16_t* Zc = F.Z + RET_OFF + h * 64 + d0;
#define RET_LOAD(cs_) do { _Pragma("unroll") for (int tk = 0; tk < 2; ++tk) { const int m = seq_row(b, dir, (cs_) * 64 + t0 + tk); const bf16_t* zr = Zc + (size_t)m * ZP; \
        rq[tk][0] = *(const unsigned*)(zr); rq[tk][1] = *(const unsigned*)(zr + 32); rk[tk][0] = *(const unsigned*)(zr + 256); rk[tk][1] = *(const unsigned*)(zr + 288); \
        rv[tk][0] = *(const unsigned*)(zr + 512); rv[tk][1] = *(const unsigned*)(zr + 544); } } while (0)
#define RET_STAGE(cs_, cb_) do { \
        LAS unsigned char* Qg = L + O_QG + (cb_) * IMG; LAS unsigned char* Kg = L + O_KG + (cb_) * IMG; LAS unsigned char* KeT = L + O_KET + (cb_) * IMG; LAS unsigned char* Vt = L + O_VT + (cb_) * VTB; \
        const bool lat = (cs_) >= 4; float rc[2] = {1.f, 1.f}, rs[2] = {0.f, 0.f}; \
        if (lat && rowb) { const float row = (float)(dir ? 127 - ((cs_) - 4) : (cs_) - 4); _Pragma("unroll") for (int e = 0; e < 2; ++e) { rs[e] = __sinf(row * inv[e]); rc[e] = __cosf(row * inv[e]); } } \
        f32x2 ke_lo[2], ke_hi[2], v_lo[2], v_hi[2]; \
        _Pragma("unroll") for (int tk = 0; tk < 2; ++tk) { \
            f32x2 q1 = up2(rq[tk][0]), q2 = up2(rq[tk][1]), k1 = up2(rk[tk][0]), k2 = up2(rk[tk][1]); \
            f32x2 c, s; if (rowb) { c.x = rc[0]; c.y = rc[1]; s.x = rs[0]; s.y = rs[1]; } else { c.x = lat ? ccs[tk][0] : 1.f; c.y = lat ? ccs[tk][1] : 1.f; s.x = lat ? csn[tk][0] : 0.f; s.y = lat ? csn[tk][1] : 0.f; } \
            const f32x2 qa = q1 * c - q2 * s, qb = q1 * s + q2 * c, ka = k1 * c - k2 * s, kb = k1 * s + k2 * c; \
            const int t = t0 + tk; \
            *(LAS unsigned*)(Qg + (t * PITCH + d0) * 2) = pk2(qa.x * eq[tk], qa.y * eq[tk]); *(LAS unsigned*)(Qg + (t * PITCH + d0 + 32) * 2) = pk2(qb.x * eq[tk], qb.y * eq[tk]); \
            *(LAS unsigned*)(Kg + (t * PITCH + d0) * 2) = pk2(ka.x * ek[tk], ka.y * ek[tk]); *(LAS unsigned*)(Kg + (t * PITCH + d0 + 32) * 2) = pk2(kb.x * ek[tk], kb.y * ek[tk]); \
            ke_lo[tk] = ka * ee[tk]; ke_hi[tk] = kb * ee[tk]; v_lo[tk] = up2(rv[tk][0]); v_hi[tk] = up2(rv[tk][1]); } \
        *(LAS unsigned*)(KeT + ((d0) * PITCH + t0) * 2) = pk2(ke_lo[0].x, ke_lo[1].x); *(LAS unsigned*)(KeT + ((d0 + 1) * PITCH + t0) * 2) = pk2(ke_lo[0].y, ke_lo[1].y); \
        *(LAS unsigned*)(KeT + ((d0 + 32) * PITCH + t0) * 2) = pk2(ke_hi[0].x, ke_hi[1].x); *(LAS unsigned*)(KeT + ((d0 + 33) * PITCH + t0) * 2) = pk2(ke_hi[0].y, ke_hi[1].y); \
        *(LAS unsigned*)(Vt + ((d0) * PITCH + t0) * 2) = pk2(v_lo[0].x, v_lo[1].x); *(LAS unsigned*)(Vt + ((d0 + 1) * PITCH + t0) * 2) = pk2(v_lo[0].y, v_lo[1].y); \
        *(LAS unsigned*)(Vt + ((d0 + 32) * PITCH + t0) * 2) = pk2(v_hi[0].x, v_hi[1].x); *(LAS unsigned*)(Vt + ((d0 + 33) * PITCH + t0) * 2) = pk2(v_hi[0].y, v_hi[1].y); \
    } while (0)
    RET_LOAD(0); RET_STAGE(0, 0);
    __syncthreads();
    for (int cs = 0; cs < NCH; ++cs) { const int cb = cs & 1;
        if (cs + 1 < NCH) RET_LOAD(cs + 1);
        chunk_mma<DV>(F, L, cb, cb, acc_s, b, dir, cs, 768 + h * 64);
        if (cs + 1 < NCH) RET_STAGE(cs + 1, cb ^ 1);
        __syncthreads();
    }
#undef RET_LOAD
#undef RET_STAGE
}

__device__ __forceinline__ void gla_chain(Frame& F, int l, int chain) {
    constexpr int DV = 96, NCH = SEQT / 64;
    const int dir = chain & 1, h = (chain >> 1) & 3, b = chain >> 3;
    LAS unsigned char* L = F.lds;
    const int t = F.tid >> 3, j8 = F.tid & 7, d0 = 2 * j8;
    LAS float* wsum = (LAS float*)(L + O_WSUM);
    const float qs = 0.14433756729740643f;
    LAS float* w2s = (LAS float*)(L + O_W2);
    for (int i = F.tid; i < O_END / 4; i += NTHR) ((LAS unsigned*)L)[i] = 0u;
    { const float* W2 = F.ap->in[I_GGW2] + (size_t)(l * 2 + dir) * 16 * 192 + h * 48; const float* Bg = F.ap->in[I_GGB] + (l * 2 + dir) * 192 + h * 48;
      for (int i = F.tid; i < 17 * 48; i += NTHR) { const int r = i / 48, d = i % 48; w2s[i] = r < 16 ? W2[r * 192 + d] : Bg[d]; } }
    f32x4 acc_s[DV / 32];
#pragma unroll
    for (int q = 0; q < DV / 32; ++q) acc_s[q] = (f32x4){0.f, 0.f, 0.f, 0.f};
    unsigned rq[3], rk[3], rv[6]; u32x4 rl[2];
    const bf16_t* Zc = F.Z + GLA_OFF + h * 48 + d0;
#define GLA_LOAD(cs_) do { const int m = seq_row(b, dir, (cs_) * 64 + t); const bf16_t* zr = Zc + (size_t)m * ZP; const bf16_t* zv = F.Z + (size_t)m * ZP + GLA_OFF + 384 + h * 96 + d0; \
        _Pragma("unroll") for (int q = 0; q < 3; ++q) { rq[q] = *(const unsigned*)(zr + 16 * q); rk[q] = *(const unsigned*)(zr + 192 + 16 * q); } \
        _Pragma("unroll") for (int q = 0; q < 6; ++q) rv[q] = *(const unsigned*)(zv + 16 * q); \
        const u32x4* zl = (const u32x4*)(F.Z + (size_t)m * ZP + GLA_OFF + 1152 + dir * 16); rl[0] = zl[0]; rl[1] = zl[1]; } while (0)
#define GLA_STAGE(cs_, cb_) do { \
        LAS unsigned char* Qg = L + O_QG + (cb_) * IMG; LAS unsigned char* Kg = L + O_KG + (cb_) * IMG; LAS unsigned char* KeT = L + O_KET + (cb_) * IMG; LAS unsigned char* Vt = L + O_VT + (cb_) * VTB; \
        float lrv[16]; { const f32x2 a0 = up2(rl[0].x), a1 = up2(rl[0].y), a2 = up2(rl[0].z), a3 = up2(rl[0].w), a4 = up2(rl[1].x), a5 = up2(rl[1].y), a6 = up2(rl[1].z), a7 = up2(rl[1].w); \
            lrv[0] = a0.x; lrv[1] = a0.y; lrv[2] = a1.x; lrv[3] = a1.y; lrv[4] = a2.x; lrv[5] = a2.y; lrv[6] = a3.x; lrv[7] = a3.y; lrv[8] = a4.x; lrv[9] = a4.y; lrv[10] = a5.x; lrv[11] = a5.y; lrv[12] = a6.x; lrv[13] = a6.y; lrv[14] = a7.x; lrv[15] = a7.y; } \
        float G[6]; \
        { f32x2 x2[3]; _Pragma("unroll") for (int q = 0; q < 3; ++q) x2[q] = *(const LAS f32x2*)(w2s + 16 * 48 + d0 + 16 * q); \
          _Pragma("unroll") for (int r = 0; r < 16; ++r) { _Pragma("unroll") for (int q = 0; q < 3; ++q) x2[q] += *(const LAS f32x2*)(w2s + r * 48 + d0 + 16 * q) * lrv[r]; } \
          _Pragma("unroll") for (int q = 0; q < 3; ++q) { G[2 * q] = x2[q].x; G[2 * q + 1] = x2[q].y; } } \
        _Pragma("unroll") for (int e = 0; e < 6; ++e) { const float x = G[e]; G[e] = (fminf(x, 0.f) - log1pf(__expf(-fabsf(x)))) * (1.0f / 16.0f); } \
          \
        _Pragma("unroll") for (int o = 8; o < 64; o <<= 1) { _Pragma("unroll") for (int e = 0; e < 6; ++e) { const float u = __shfl_up(G[e], o); if (F.lane >= o) G[e] += u; } } \
        if (F.lane >= 56) { _Pragma("unroll") for (int q = 0; q < 3; ++q) *(LAS f32x2*)(wsum + F.wave * 48 + d0 + 16 * q) = (f32x2){G[2 * q], G[2 * q + 1]}; } \
        __syncthreads(); \
        float Ge[6]; \
        _Pragma("unroll") for (int q = 0; q < 3; ++q) { f32x2 off = {0.f, 0.f}, tot = {0.f, 0.f}; \
            _Pragma("unroll") for (int ww = 0; ww < 8; ++ww) { const f32x2 s = *(const LAS f32x2*)(wsum + ww * 48 + d0 + 16 * q); tot += s; if (ww < F.wave) off += s; } \
            G[2 * q] += off.x; G[2 * q + 1] += off.y; Ge[2 * q] = tot.x; Ge[2 * q + 1] = tot.y; } \
        if (t == 0) { _Pragma("unroll") for (int q = 0; q < 3; ++q) *(LAS f32x2*)((LAS float*)(L + O_DEC + (cb_) * 256) + d0 + 16 * q) = (f32x2){__expf(Ge[2 * q]), __expf(Ge[2 * q + 1])}; } \
        _Pragma("unroll") for (int q = 0; q < 3; ++q) { const f32x2 qv = up2(rq[q]), kv = up2(rk[q]); const int d = d0 + 16 * q; \
            const float eq0 = __expf(G[2 * q]) * qs, eq1 = __expf(G[2 * q + 1]) * qs, ek0 = __expf(-G[2 * q]), ek1 = __expf(-G[2 * q + 1]), ee0 = __expf(Ge[2 * q] - G[2 * q]), ee1 = __expf(Ge[2 * q + 1] - G[2 * q + 1]); \
            *(LAS unsigned*)(Qg + (t * PITCH + d) * 2) = pk2(qv.x * eq0, qv.y * eq1); *(LAS unsigned*)(Kg + (t * PITCH + d) * 2) = pk2(kv.x * ek0, kv.y * ek1); \
            *(LAS bf16_t*)(KeT + (d * PITCH + t) * 2) = f2bf(kv.x * ee0); *(LAS bf16_t*)(KeT + ((d + 1) * PITCH + t) * 2) = f2bf(kv.y * ee1); } \
        _Pragma("unroll") for (int q = 0; q < 6; ++q) { const int d = d0 + 16 * q; *(LAS bf16_t*)(Vt + (d * PITCH + t) * 2) = (bf16_t)(rv[q] & 0xffffu); *(LAS bf16_t*)(Vt + ((d + 1) * PITCH + t) * 2) = (bf16_t)(rv[q] >> 16); } \
    } while (0)
    __syncthreads();
    GLA_LOAD(0); GLA_STAGE(0, 0);
    __syncthreads();
    for (int cs = 0; cs < NCH; ++cs) { const int cb = cs & 1;
        if (cs + 1 < NCH) GLA_LOAD(cs + 1);
        chunk_mma<DV>(F, L, cb, cb, acc_s, b, dir, cs, h * 96);
        if (cs + 1 < NCH) GLA_STAGE(cs + 1, cb ^ 1);
        __syncthreads();
    }
#undef GLA_LOAD
#undef GLA_STAGE
}
}

__device__ __forceinline__ void phase_scan(Frame& F, int l) {
    for (int task = F.bid; task < 256; task += F.G) {
        if (task < 192) rwkv_scan_block(F, task >> 2, task & 3);
        else if (task < 224) {
#if SCAN_GLA_V0
            gla_scan_block(F, l, task - 192);
#else
            ce::gla_chain(F, l, task - 192);
#endif
        } else ce::ret_chain(F, l, task - 224);
        __syncthreads();
    }
}
__device__ __forceinline__ void phase_post(Frame& F, int l, int Mrows) {
    constexpr int TG = 8;
    LAS float* sg = (LAS float*)F.lds;
    const float* mu = F.ap->in[I_RMU] + l * 1312;
    const int c = F.tid;
    float g2[64]; float lng = 0, lnb = 0, rk = 0;
    if (c < 384) {
#pragma unroll
        for (int j = 0; j < 64; ++j) g2[j] = F.ap->in[I_RG2][((size_t)l * 64 + j) * 384 + c];
        lng = F.ap->in[I_RLNG][l * 384 + c]; lnb = F.ap->in[I_RLNB][l * 384 + c]; rk = F.ap->in[I_RRK][l * 384 + c];
    }
    for (int it = F.bid; it < Mrows / TG; it += F.G) {
        const int m0 = it * TG;
        { const int tok = F.tid >> 6, j = F.tid & 63; sg[F.tid] = sigmoidf_(zshift(F.Z, m0 + tok, RW_OFF + 1248 + j, mu[1248 + j])); }
        __syncthreads();
        if (c < 384) {
            for (int tok = 0; tok < TG; ++tok) { const int m = m0 + tok; const size_t o = (size_t)m * 384 + c;
                const float yv = bf2f(F.A[(size_t)m * DM + 384 + c]) + bf2f(F.Z[(size_t)m * ZP + YB_OFF + 384 + c]);
                const float mean = wave_sum(yv) * (1.f / 64.f); const float d = yv - mean; const float var = wave_sum(d * d) * (1.f / 64.f);
                const float yn = d * rsqrtf(var + 64e-5f) * lng + lnb;
                const float r = bf2f(F.PREP[PR_R * PREP_STRIDE + o]), kp = bf2f(F.PREP[PR_K * PREP_STRIDE + o]), v = bf2f(F.PREP[PR_V * PREP_STRIDE + o]);
                const float bon = wave_sum(r * kp * rk) * v;
                float gt = 0.f;
#pragma unroll
                for (int j = 0; j < 64; ++j) gt += sg[tok * 64 + j] * g2[j];
                F.A[(size_t)m * DM + 384 + c] = f2bf((yn + bon) * gt); }
        }
        for (int u = F.wave; u < TG * 8; u += NWAVES) { const int m = m0 + (u >> 3), hu = u & 7; const bf16_t* zr = F.Z + (size_t)m * ZP; bf16_t* ar = F.A + (size_t)m * DM;
            if (hu < 4) { const int c0 = hu * 96 + F.lane, c1 = c0 + 64; const bool two = F.lane < 32;
                const float y0 = bf2f(ar[c0]) + bf2f(zr[YB_OFF + c0]); const float y1 = two ? bf2f(ar[c1]) + bf2f(zr[YB_OFF + c1]) : 0.f;
                const float r = rsqrtf(wave_sum(y0 * y0 + y1 * y1) * (1.f / 96.f) + 1e-6f);
                ar[c0] = f2bf(siluf_(bf2f(zr[GLA_OFF + 768 + c0])) * y0 * r * F.ap->in[I_GNG][l * 384 + c0]);
                if (two) ar[c1] = f2bf(siluf_(bf2f(zr[GLA_OFF + 768 + c1])) * y1 * r * F.ap->in[I_GNG][l * 384 + c1]);
            } else { const int cc = (hu - 4) * 64 + F.lane;
                const float y0 = bf2f(ar[768 + cc]) + bf2f(zr[YB_OFF + 768 + cc]);
                const float r = rsqrtf(wave_sum(y0 * y0) * (1.f / 64.f) + 1e-6f);
                ar[768 + cc] = f2bf(siluf_(bf2f(zr[RET_OFF + 768 + cc])) * y0 * r * F.ap->in[I_RETNG][l * 256 + cc]); }
        }
        __syncthreads();
    }
}

constexpr int PH_PER_LAYER = 9, N_PHASES = 1 + DEPTH * PH_PER_LAYER + 1;
#define PHASE_ENTER() \
    CArgs ap = (CArgs)__builtin_amdgcn_kernarg_segment_ptr(); asm volatile("" : "+s"(ap)); \
    int tid = threadIdx.x; asm volatile("" : "+v"(tid)); \
    Frame F; F.lds = lds; F.ap = ap; F.tid = tid; F.lane = tid & 63; F.wave = __builtin_amdgcn_readfirstlane(tid >> 6); F.bid = blockIdx.x; F.G = gridDim.x; \
    unsigned char* ws = ap->ws; F.out = ap->out; F.ws = ws; \
    F.mod = (float*)(ws + WS_MOD); F.Win_t = (bf16_t*)(ws + WS_WIN); F.Wout_t = (bf16_t*)(ws + WS_WOUT); F.W1_t = (bf16_t*)(ws + WS_W1); F.W2_t = (bf16_t*)(ws + WS_W2); \
    F.xc = (float*)(ws + WS_XC); F.A = (bf16_t*)(ws + WS_ABUF); F.Z = (bf16_t*)(ws + WS_Z); F.PREP = (bf16_t*)(ws + WS_PREP); F.H = (bf16_t*)(ws + WS_H); \
    const float* modl = F.mod + (size_t)L * 5 * 6144; (void)modl; \
    const float* xl_in = L == 0 ? F.ap->in[I_X] : F.out; const float* xc_in = L == 0 ? F.ap->in[I_CTX] : F.xc; (void)xl_in; (void)xc_in;

#define IN(k) (lo <= (k) && (k) < hi)
#define SEAM(k) do { if (IN(k) && IN((k) + 1)) grid.sync(); } while (0)
template <int L> __device__ __forceinline__ void run_layer(int lo, int hi, LAS unsigned char* lds, cg::grid_group& grid) {
    constexpr int p0 = 1 + L * PH_PER_LAYER; constexpr bool last = (L == DEPTH - 1); constexpr int Mo = last ? ML : MT;
    if (IN(p0 + 0)) { PHASE_ENTER(); phase_wconv(F, L); phase_norm(F, xl_in, xc_in, F.ap->in[I_N1G] + L * DM, modl, 0, 1, MT); } SEAM(p0 + 0);
    if (IN(p0 + 1)) { PHASE_ENTER(); pg8::Gemm g{F.A, F.Win_t, MT, ZP, DM}; pg8::StaticOrder S; S.init(MT, ZP, F.G, F.bid); pg8::EpiBf16<0> E{F.Z, ZP};
        pg8::gemm_phase<pg8::EpiBf16<0>, pg8::StaticOrder, true, true>(F.lds, g, S, E, tid); } SEAM(p0 + 1);
    if (IN(p0 + 2)) { PHASE_ENTER(); phase_prep(F, L); } SEAM(p0 + 2);
    if (IN(p0 + 3)) { PHASE_ENTER(); phase_scan(F, L); } SEAM(p0 + 3);
    if (IN(p0 + 4)) { PHASE_ENTER(); phase_post(F, L, Mo); } SEAM(p0 + 4);
    if (IN(p0 + 5)) { PHASE_ENTER(); pg8::Gemm g{F.A, F.Wout_t, Mo, DM, DM}; pg8::StaticOrder S; S.init(Mo, DM, F.G, F.bid); pg8::EpiRes E{xl_in, xc_in, F.out, F.xc, modl + 2 * 1024};
        pg8::gemm_phase<pg8::EpiRes, pg8::StaticOrder, true, true>(F.lds, g, S, E, tid); } SEAM(p0 + 5);
    if (IN(p0 + 6)) { PHASE_ENTER(); phase_norm(F, F.out, F.xc, F.ap->in[I_N2G] + L * DM, modl, 3, 4, Mo); } SEAM(p0 + 6);
    if (IN(p0 + 7)) { PHASE_ENTER(); pg8::Gemm g{F.A, F.W1_t, Mo, DFF, DM}; pg8::StaticOrder S; S.init(Mo, DFF, F.G, F.bid); pg8::EpiBf16<2> E{F.H, DFF};
        pg8::gemm_phase<pg8::EpiBf16<2>, pg8::StaticOrder, true, true>(F.lds, g, S, E, tid); } SEAM(p0 + 7);
    if (IN(p0 + 8)) { PHASE_ENTER(); pg8::Gemm g{F.H, F.W2_t, Mo, DM, DFF}; pg8::StaticOrder S; S.init(Mo, DM, F.G, F.bid); pg8::EpiRes E{F.out, F.xc, F.out, F.xc, modl + 5 * 1024};
        pg8::gemm_phase<pg8::EpiRes, pg8::StaticOrder, true, true>(F.lds, g, S, E, tid); } SEAM(p0 + 8);
}
__global__ void __launch_bounds__(NTHR, 2) mega_fwd(Args args) {
    extern __shared__ __attribute__((aligned(16))) unsigned char lds_raw[];
    LAS unsigned char* lds = (LAS unsigned char*)lds_raw;
    const int lo = args.ph_lo, hi = args.ph_hi;
    cg::grid_group grid = cg::this_grid();
    { constexpr int L = 0; if (IN(0)) { PHASE_ENTER(); phase_mod(F); } SEAM(0); }
    run_layer<0>(lo, hi, lds, grid);
    run_layer<1>(lo, hi, lds, grid);
    { constexpr int L = 0; if (IN(N_PHASES - 1)) { PHASE_ENTER(); phase_final(F); } }
}
#undef IN
#undef SEAM

extern "C" void kernel_launch(void* const* d_in, const int* in_sizes, int n_in, void* d_out, int out_size, void* d_ws, size_t ws_size, hipStream_t stream) {
    static int grid = 0;
    if (grid == 0) {
        int dev = 0, cus = 0, per_cu = 0;
        hipGetDevice(&dev); hipDeviceGetAttribute(&cus, hipDeviceAttributeMultiprocessorCount, dev);
        hipFuncSetAttribute((const void*)mega_fwd, hipFuncAttributeMaxDynamicSharedMemorySize, LDS_BYTES);
        hipOccupancyMaxActiveBlocksPerMultiprocessor(&per_cu, (const void*)mega_fwd, NTHR, LDS_BYTES);
        if (per_cu < 1) { fprintf(stderr, "kernel_launch: occupancy query says %d blocks per CU\n", per_cu); per_cu = 1; }
        (void)hipGetLastError();
        grid = cus * per_cu;
        if (n_in != 29 || ws_size < WS_END) fprintf(stderr, "kernel_launch: unexpected n_in %d / ws_size %zu (need %zu)\n", n_in, ws_size, (size_t)WS_END);
    }
    Args a{};
    for (int i = 0; i < 29; ++i) a.in[i] = (const float*)d_in[i];
    a.out = (float*)d_out; a.ws = (unsigned char*)d_ws;
#if MK_ONE_LAUNCH
    a.ph_lo = 0; a.ph_hi = N_PHASES;
    void* kargs[] = {&a};
    hipError_t e = hipLaunchCooperativeKernel((const void*)mega_fwd, dim3(grid), dim3(NTHR), kargs, LDS_BYTES, stream);
    if (e != hipSuccess) fprintf(stderr, "cooperative launch failed: %s (grid %d)\n", hipGetErrorString(e), grid);
#else
    for (int ph = 0; ph < N_PHASES; ++ph) { a.ph_lo = ph; a.ph_hi = ph + 1;
        hipLaunchKernelGGL(mega_fwd, dim3(grid), dim3(NTHR), LDS_BYTES, stream, a); }
#endif
}
```

```cpp
#include <hip/hip_runtime.h>
#include <hip/hip_cooperative_groups.h>
#include <cstdio>
#include <cstdint>
namespace cg = cooperative_groups;

#ifndef MK_ONE_LAUNCH
#define MK_ONE_LAUNCH 1
#endif

#define LAS __attribute__((address_space(3)))
#define GAS __attribute__((address_space(1)))
typedef unsigned short bf16_t;
typedef float f32x4 __attribute__((ext_vector_type(4)));
typedef float f32x2 __attribute__((ext_vector_type(2)));
typedef unsigned u32x4 __attribute__((ext_vector_type(4)));
typedef unsigned u32x2 __attribute__((ext_vector_type(2)));

constexpr int DM = 1024, NB = 4, SEQ = 8192, CTXL = 256, DEPTH = 2, DFF = 4096;
constexpr int ML = NB * SEQ, MC = NB * CTXL, MT = ML + MC;
constexpr int INC = 3520, ZP = 3584;
constexpr int GLA_OFF = 0, RW_OFF = 1184, RET_OFF = 2496;
constexpr int YB_OFF = RW_OFF;
constexpr int SEQT = CTXL + SEQ;
constexpr int NTHR = 512, NWAVES = 8;

constexpr size_t MiB = 1u << 20;
constexpr size_t WS_CTL = 0, CTL_BYTES = 1 * MiB;
constexpr size_t WS_MOD = 1 * MiB;
constexpr size_t WS_WIN = 2 * MiB, WS_WOUT = 9 * MiB, WS_W1 = 11 * MiB, WS_W2 = 19 * MiB;
constexpr size_t WS_XC = 27 * MiB;
constexpr size_t WS_ABUF = 32 * MiB;
constexpr size_t WS_Z = 98 * MiB;
constexpr size_t WS_PREP = 329 * MiB;
constexpr size_t PREP_STRIDE = (size_t)MT * 384;
constexpr size_t WS_H = 98 * MiB;
constexpr size_t WS_END = WS_PREP + 7 * PREP_STRIDE * 2;
static_assert(WS_ABUF + (size_t)MT * DM * 2 <= WS_Z, "ws map");
static_assert(WS_Z + (size_t)MT * ZP * 2 <= WS_PREP, "ws map");
static_assert(WS_H + (size_t)MT * DFF * 2 <= WS_END, "ws map");
static_assert(WS_END <= 512 * MiB, "ws map");
enum { PR_R = 0, PR_WF = 1, PR_WB = 2, PR_K = 3, PR_V = 4, PR_KK = 5, PR_B = 6 };

constexpr int LDS_BYTES = 147456;

__device__ __forceinline__ float bf2f(bf16_t v) { return __uint_as_float(((unsigned)v) << 16); }
__device__ __forceinline__ unsigned f2bf_u(float f) { unsigned u = __float_as_uint(f); return (u + 0x7fffu + ((u >> 16) & 1u)) >> 16; }
__device__ __forceinline__ bf16_t f2bf(float f) { return (bf16_t)f2bf_u(f); }
__device__ __forceinline__ unsigned pk2(float lo, float hi) { return f2bf_u(lo) | (f2bf_u(hi) << 16); }
__device__ __forceinline__ float sigmoidf_(float x) { return 1.0f / (1.0f + __expf(-x)); }
__device__ __forceinline__ float siluf_(float x) { return x / (1.0f + __expf(-x)); }
__device__ __forceinline__ float softplusf_(float x) { return fmaxf(x, 0.f) + log1pf(__expf(-fabsf(x))); }
__device__ __forceinline__ float wave_sum(float v) {
#pragma unroll
    for (int o = 1; o < 64; o <<= 1) v += __shfl_xor(v, o);
    return v;
}
template <int CTRL> __device__ __forceinline__ float dpp_mov(float x) { return __int_as_float(__builtin_amdgcn_update_dpp(0, __float_as_int(x), CTRL, 0xF, 0xF, true)); }
__device__ __forceinline__ float reduce16(float x) {
    x += dpp_mov<0xB1>(x);
    x += dpp_mov<0x4E>(x);
    x += dpp_mov<0x141>(x);
    x += dpp_mov<0x140>(x);
    return x;
}
#define LDS_WAIT() asm volatile("s_waitcnt lgkmcnt(0)" ::: "memory")


#define XB_TMO      128
#define XB_XCNT(j)  (256  + 64 * (j))
#define XB_XSUB(j)  (1280 + 64 * (j))
#define XB_XGEN(j)  (2304 + 64 * (j))
#define XB_TOP      3328
#define XB_TOPGEN   3392
#define XCD_BAR_WORDS 3456
#define XB_SPIN_CAP (1u << 18)

__device__ __forceinline__ unsigned xb_ld(unsigned* p)              { return __hip_atomic_load(p, __ATOMIC_RELAXED, __HIP_MEMORY_SCOPE_AGENT); }
__device__ __forceinline__ unsigned xb_add(unsigned* p, unsigned v) { return __hip_atomic_fetch_add(p, v, __ATOMIC_RELAXED, __HIP_MEMORY_SCOPE_AGENT); }
__device__ __forceinline__ unsigned xb_xcc_id() { return (unsigned)__builtin_amdgcn_s_getreg((3 << 11) | 20) & 0xFu; }
#define XB_SPIN(cond, bar) do { unsigned _sp = 0; while (cond) { __builtin_amdgcn_s_sleep(1); \
    if ((++_sp & 255u) == 0u) { if (xb_ld(&(bar)[XB_TMO])) break; if (_sp > XB_SPIN_CAP) { atomicAdd(&(bar)[XB_TMO], 1u); break; } } } } while (0)

struct XcdBarrier {
    unsigned* bar; unsigned x;
    volatile LAS unsigned* st;
};

__device__ __forceinline__ XcdBarrier xcd_barrier_post(unsigned* bar, volatile LAS unsigned* st) {
    XcdBarrier b; b.bar = bar; b.x = xb_xcc_id(); b.st = st;
    if (threadIdx.x == 0) (void)xb_add(&bar[XB_XCNT(b.x)], 1u);
    return b;
}
__device__ __forceinline__ void xcd_barrier_complete(unsigned* bar, unsigned x, unsigned& nloc, unsigned& nx) {
    const unsigned G = gridDim.x * gridDim.y * gridDim.z;
    unsigned sum, cnt, mine, sp = 0u;
    for (;;) {
        sum = 0u; cnt = 0u; mine = 0u;
#pragma unroll
        for (unsigned j = 0; j < 16; ++j) { const unsigned c = xb_ld(&bar[XB_XCNT(j)]); sum += c; cnt += (c > 0u) ? 1u : 0u; mine = (j == x) ? c : mine; }
        if (sum == G) break;
        __builtin_amdgcn_s_sleep(1);
        if ((++sp & 255u) == 0u) { if (xb_ld(&bar[XB_TMO])) break; if (sp > XB_SPIN_CAP) { atomicAdd(&bar[XB_TMO], 1u); break; } }
    }
    nloc = mine > 0u ? mine : 1u; nx = cnt > 0u ? cnt : 1u;
}

__device__ __forceinline__ void xcd_barrier(const XcdBarrier& b) {
    asm volatile("s_waitcnt vmcnt(0)" ::: "memory");
    __syncthreads();
    if (threadIdx.x == 0) {
        unsigned* bar = b.bar;
        __builtin_amdgcn_s_waitcnt(0);
        unsigned nloc = b.st[0], nx = b.st[1];
        if (nloc == 0u) { xcd_barrier_complete(bar, b.x, nloc, nx); b.st[0] = nloc; b.st[1] = nx; }
        const unsigned old = xb_add(&bar[XB_XSUB(b.x)], 1u);
        const unsigned gen = old / nloc;
        if (old + 1u == (gen + 1u) * nloc) {
            __builtin_amdgcn_fence(__ATOMIC_RELEASE, "agent");
            asm volatile("s_waitcnt vmcnt(0)" ::: "memory");
            const unsigned og = xb_add(&bar[XB_TOP], 1u);
            const unsigned tg = og / nx;
            if (og + 1u == (tg + 1u) * nx) xb_add(&bar[XB_TOPGEN], 1u);
            else XB_SPIN(xb_ld(&bar[XB_TOPGEN]) == tg, bar);
            __builtin_amdgcn_fence(__ATOMIC_ACQUIRE, "agent");
            xb_add(&bar[XB_XGEN(b.x)], 1u);
            asm volatile("s_waitcnt vmcnt(0)" ::: "memory");
        } else {
            XB_SPIN(xb_ld(&bar[XB_XGEN(b.x)]) == gen, bar);
            __builtin_amdgcn_fence(__ATOMIC_ACQUIRE, "agent");
            asm volatile("s_waitcnt vmcnt(0)" ::: "memory");
        }
    }
    __syncthreads();
}


namespace pg8 {
#define PG8_LAS __attribute__((address_space(3)))
typedef unsigned short bf16_t;
typedef short bf16x8 __attribute__((ext_vector_type(8)));
typedef float f32x4 __attribute__((ext_vector_type(4)));
typedef unsigned u32x4 __attribute__((ext_vector_type(4)));
constexpr int BM = 256, BK = 64, HALF = 128, HTB = HALF * BK * 2  , STAGE_BYTES = 8 * HTB, NXCD = 8, WGM = 8;

__host__ __device__ __forceinline__ int lds_byte(int r, int c) { const int st = (r >> 4) * 2 + (c >> 5), rr = r & 15, cc = c & 31, ob = rr * 64 + cc * 2; return st * 1024 + (ob ^ (((ob >> 9) & 1) << 5)); }
__host__ __device__ __forceinline__ void stage_rc(int b, int& R, int& C) { const int st = b / 1024, sb = b % 1024, swz = sb ^ (((sb >> 9) & 1) << 5); R = (st >> 1) * 16 + swz / 64; C = (st & 1) * 32 + (swz % 64) / 2; }
__host__ __device__ __forceinline__ int perm32(int rho) { const int n = rho >> 4, i = rho & 15; return 8 * (i >> 2) + 4 * n + (i & 3); }

struct Unit { int pm, pn; };
struct Gemm { const bf16_t* A; const bf16_t* Bt; int M, N, K; };

struct StaticOrder {
    int nM, nN, nwg, G, c;
    __host__ __device__ void init(int M, int N, int G_, int c_) { nM = M / BM; nN = N / BM; nwg = nM * nN; G = G_; c = c_; }
    __host__ __device__ bool next(int i, Unit& u) const {
        const long L = (long)i * G + c; if (L >= nwg) return false;
        int wgid = (int)L; { const int q = nwg / NXCD, r = nwg % NXCD, xcd = wgid % NXCD, off = wgid / NXCD; wgid = (xcd < r ? xcd * (q + 1) : r * (q + 1) + (xcd - r) * q) + off; }
        const int nig = WGM * nN, gid = wgid / nig, fm = gid * WGM, gsz = (nM - fm) < WGM ? (nM - fm) : WGM;
        u.pm = fm + ((wgid % nig) % gsz); u.pn = (wgid % nig) / gsz; return true;
    }
    __device__ __forceinline__ void a_ready(const Unit&) const {}
    __device__ __forceinline__ void done(const Unit&) const {}
};

template <class Epi, class Sched, bool ALIGN_EPI = false, bool SP2 = false>
__device__ __forceinline__ void gemm_phase(PG8_LAS unsigned char* lds, const Gemm g, const Sched& S, const Epi& E, const int tid) {
    const int wid = __builtin_amdgcn_readfirstlane(tid >> 6), lane = tid & 63, wr = wid >> 2, wc = wid & 3, fr = lane & 15, fq = lane >> 4;
    const int K = g.K, nt = K / BK;
    unsigned voffA[2], voffB[2];
#pragma unroll
    for (int i = 0; i < 2; ++i) { int R, C; stage_rc(tid * 16 + i * 8192, R, C); const int Rb = Epi::PERM ? ((R & ~31) + perm32(R & 31)) : R;
        voffA[i] = (unsigned)(R * K + C) * 2u; voffB[i] = (unsigned)(Rb * K + C) * 2u; }
    const size_t kstep = (size_t)(BK * 2);
    const size_t hstep = (size_t)HALF * K * 2;
    const size_t tstep = 2 * hstep;
    const unsigned ldsw = (unsigned)wid * 1024u;
    const int aoff = lds_byte(wr * 64 + fr, fq * 8), boff = lds_byte(wc * 32 + fr, fq * 8);
#define PG8_SA(b, h) (((b) * 2 + (h)) * HTB)
#define PG8_SB(b, h) ((4 + (b) * 2 + (h)) * HTB)
#define PG8_STAGE(bufoff, gbase, voff) do { _Pragma("unroll") for (int _i = 0; _i < 2; ++_i) \
        __builtin_amdgcn_global_load_lds((const unsigned*)((const char*)(gbase) + (voff)[_i]), (PG8_LAS unsigned*)(lds + (bufoff) + ldsw + _i * 8192), 16, 0, 0); } while (0)
#define PG8_LDA(dst, b, h) do { _Pragma("unroll") for (int m = 0; m < 4; ++m) _Pragma("unroll") for (int k = 0; k < 2; ++k) dst[m][k] = *(const PG8_LAS bf16x8*)(lds + PG8_SA(b, h) + aoff + m * 2048 + k * 1024); } while (0)
#define PG8_LDB(dst, b, h) do { _Pragma("unroll") for (int n = 0; n < 2; ++n) _Pragma("unroll") for (int k = 0; k < 2; ++k) dst[n][k] = *(const PG8_LAS bf16x8*)(lds + PG8_SB(b, h) + boff + n * 2048 + k * 1024); } while (0)
#define PG8_MMA(ai, bj, At, Bt) do { __builtin_amdgcn_s_setprio(1); _Pragma("unroll") for (int m = 0; m < 4; ++m) _Pragma("unroll") for (int n = 0; n < 2; ++n) _Pragma("unroll") for (int k = 0; k < 2; ++k) \
        acc[ai][bj][m][n] = __builtin_amdgcn_mfma_f32_16x16x32_bf16(Bt[n][k], At[m][k], acc[ai][bj][m][n], 0, 0, 0); __builtin_amdgcn_s_setprio(0); } while (0)
#define PG8_WAIT_V(n) asm volatile("s_waitcnt vmcnt(" #n ")" ::: "memory")
#define PG8_WAIT_L(n) asm volatile("s_waitcnt lgkmcnt(" #n ")" ::: "memory")
#define PG8_BAR __builtin_amdgcn_s_barrier()
#define PG8_SCHED __builtin_amdgcn_sched_barrier(0)
    Unit cur, nxt; int ui = 0;
    if (!S.next(0, cur)) return;
    f32x4 acc[2][2][4][2];
#pragma unroll
    for (int a = 0; a < 2; ++a)
#pragma unroll
        for (int b = 0; b < 2; ++b)
#pragma unroll
            for (int m = 0; m < 4; ++m)
#pragma unroll
                for (int n = 0; n < 2; ++n) acc[a][b][m][n] = (f32x4){0.f, 0.f, 0.f, 0.f};
    bf16x8 At[4][2], B0[2][2], B1[2][2];
    const char* cA = (const char*)g.A + (size_t)cur.pm * tstep; const char* cB = (const char*)g.Bt + (size_t)cur.pn * tstep;
    S.a_ready(cur);
    if constexpr (SP2) {
        PG8_STAGE(PG8_SB(0, 0), cB, voffB); PG8_STAGE(PG8_SB(0, 1), cB + hstep, voffB); PG8_STAGE(PG8_SA(0, 0), cA, voffA); PG8_STAGE(PG8_SA(0, 1), cA + hstep, voffA);
        if (wr == 1) PG8_BAR;
        PG8_WAIT_V(2); PG8_BAR;
        PG8_STAGE(PG8_SB(1, 0), cB + kstep, voffB); PG8_STAGE(PG8_SA(1, 0), cA + kstep, voffA); PG8_STAGE(PG8_SB(1, 1), cB + hstep + kstep, voffB);
        PG8_WAIT_V(6); PG8_BAR;
    } else {
        PG8_STAGE(PG8_SB(0, 0), cB, voffB); PG8_STAGE(PG8_SA(0, 0), cA, voffA); PG8_STAGE(PG8_SB(0, 1), cB + hstep, voffB); PG8_STAGE(PG8_SA(0, 1), cA + hstep, voffA);
        if (wr == 1) PG8_BAR;
        PG8_WAIT_V(4); PG8_BAR;
        PG8_STAGE(PG8_SB(1, 0), cB + kstep, voffB); PG8_STAGE(PG8_SA(1, 0), cA + kstep, voffA); PG8_STAGE(PG8_SB(1, 1), cB + hstep + kstep, voffB);
        PG8_WAIT_V(6); PG8_BAR;
    }
    for (;;) {
        const bool has_next = S.next(ui + 1, nxt);
        const char* nA = has_next ? (const char*)g.A + (size_t)nxt.pm * tstep : cA; const char* nB = has_next ? (const char*)g.Bt + (size_t)nxt.pn * tstep : cB;
        for (int t = 0; t < nt; t += 2) {
            const bool last = (t == nt - 2);
            const char* a1 = cA + (size_t)(t + 1) * kstep;
            const char* a2 = last ? nA : cA + (size_t)(t + 2) * kstep; const char* b2 = last ? nB : cB + (size_t)(t + 2) * kstep;
            const char* a3 = a2 + kstep; const char* b3 = b2 + kstep;
            if (last && has_next) S.a_ready(nxt);
            if constexpr (SP2) {
            PG8_LDB(B0, 0, 0); PG8_LDB(B1, 0, 1); PG8_SCHED; PG8_LDA(At, 0, 0); PG8_STAGE(PG8_SA(1, 1), a1 + hstep, voffA);
            PG8_WAIT_V(8); PG8_WAIT_L(0); PG8_BAR; PG8_MMA(0, 0, At, B0); PG8_MMA(0, 1, At, B1); PG8_BAR; PG8_SCHED;
            PG8_LDA(At, 0, 1); PG8_STAGE(PG8_SB(0, 0), b2, voffB); PG8_STAGE(PG8_SB(0, 1), b2 + hstep, voffB); PG8_STAGE(PG8_SA(0, 0), a2, voffA);
            PG8_WAIT_V(8); PG8_WAIT_L(0); PG8_BAR; PG8_MMA(1, 0, At, B0); PG8_MMA(1, 1, At, B1); PG8_BAR; PG8_SCHED;
            PG8_LDB(B0, 1, 0); PG8_LDB(B1, 1, 1); PG8_SCHED; PG8_LDA(At, 1, 0); PG8_STAGE(PG8_SA(0, 1), a2 + hstep, voffA);
            PG8_WAIT_V(8); PG8_WAIT_L(0); PG8_BAR; PG8_MMA(0, 0, At, B0); PG8_MMA(0, 1, At, B1); PG8_BAR; PG8_SCHED;
            PG8_LDA(At, 1, 1); PG8_STAGE(PG8_SB(1, 0), b3, voffB); PG8_STAGE(PG8_SB(1, 1), b3 + hstep, voffB); PG8_STAGE(PG8_SA(1, 0), a3, voffA);
            PG8_WAIT_V(8); PG8_WAIT_L(0); PG8_BAR; PG8_MMA(1, 0, At, B0); PG8_MMA(1, 1, At, B1); PG8_BAR; PG8_SCHED;
            } else {
            PG8_LDB(B0, 0, 0); PG8_SCHED; PG8_LDA(At, 0, 0); PG8_STAGE(PG8_SA(1, 1), a1 + hstep, voffA);
            PG8_WAIT_L(8); PG8_BAR; PG8_WAIT_L(0); PG8_MMA(0, 0, At, B0); PG8_BAR; PG8_SCHED;
            PG8_LDB(B1, 0, 1); PG8_STAGE(PG8_SB(0, 0), b2, voffB);
            PG8_BAR; PG8_WAIT_L(0); PG8_MMA(0, 1, At, B1); PG8_BAR;
            PG8_LDA(At, 0, 1); PG8_STAGE(PG8_SA(0, 0), a2, voffA);
            PG8_BAR; PG8_WAIT_L(0); PG8_MMA(1, 0, At, B0); PG8_BAR; PG8_SCHED;
            PG8_STAGE(PG8_SB(0, 1), b2 + hstep, voffB);
            PG8_WAIT_V(6); PG8_BAR; PG8_MMA(1, 1, At, B1); PG8_BAR;
            PG8_LDB(B0, 1, 0); PG8_SCHED; PG8_LDA(At, 1, 0); PG8_STAGE(PG8_SA(0, 1), a2 + hstep, voffA);
            PG8_WAIT_L(8); PG8_BAR; PG8_WAIT_L(0); PG8_MMA(0, 0, At, B0); PG8_BAR; PG8_SCHED;
            PG8_LDB(B1, 1, 1); PG8_STAGE(PG8_SB(1, 0), b3, voffB);
            PG8_BAR; PG8_WAIT_L(0); PG8_MMA(0, 1, At, B1); PG8_BAR;
            PG8_LDA(At, 1, 1); PG8_STAGE(PG8_SA(1, 0), a3, voffA);
            PG8_BAR; PG8_WAIT_L(0); PG8_MMA(1, 0, At, B0); PG8_BAR; PG8_SCHED;
            PG8_STAGE(PG8_SB(1, 1), b3 + hstep, voffB);
            PG8_WAIT_V(6); PG8_BAR; PG8_MMA(1, 1, At, B1); PG8_BAR;
            }
        }
        if constexpr (ALIGN_EPI) { if (wr == 0) PG8_BAR; }
        if constexpr (!Epi::AFTER_DRAIN) { E(acc, cur, wr, wc, fr, fq); S.done(cur); }
        if (!has_next) break;
#pragma unroll
        for (int a = 0; a < 2; ++a)
#pragma unroll
            for (int b = 0; b < 2; ++b)
#pragma unroll
                for (int m = 0; m < 4; ++m)
#pragma unroll
                    for (int n = 0; n < 2; ++n) acc[a][b][m][n] = (f32x4){0.f, 0.f, 0.f, 0.f};
        cur = nxt; cA = nA; cB = nB; ++ui;
        if constexpr (ALIGN_EPI) { if (wr == 1) PG8_BAR; }
    }
    PG8_WAIT_V(0);
    if constexpr (!ALIGN_EPI) { if (wr == 0) PG8_BAR; }
    PG8_BAR;
    if constexpr (Epi::AFTER_DRAIN) { E.fused(acc, cur, wr, wc, fr, fq, lds, wid, lane); S.done(cur); }
#undef PG8_SA
#undef PG8_SB
#undef PG8_STAGE
#undef PG8_LDA
#undef PG8_LDB
#undef PG8_MMA
#undef PG8_WAIT_V
#undef PG8_WAIT_L
#undef PG8_BAR
#undef PG8_SCHED
}
}

namespace pg8 {
template <int ACT> struct EpiBf16 {
    static constexpr bool PERM = true, AFTER_DRAIN = false;
    bf16_t* O; int ldc;
    __device__ __forceinline__ void operator()(const f32x4 (&acc)[2][2][4][2], const Unit& u, int wr, int wc, int fr, int fq) const {
        const int row0 = u.pm * BM + wr * 64 + fr; const int col0 = u.pn * BM + wc * 32 + 8 * fq;
#pragma unroll
        for (int ai = 0; ai < 2; ++ai)
#pragma unroll
            for (int m = 0; m < 4; ++m) { bf16_t* rowp = O + (size_t)(row0 + ai * HALF + m * 16) * ldc + col0;
#pragma unroll
                for (int bj = 0; bj < 2; ++bj) { f32x4 v0 = acc[ai][bj][m][0], v1 = acc[ai][bj][m][1];
                    if (ACT == 2) {
#pragma unroll
                        for (int e = 0; e < 4; ++e) { float a = fmaxf(v0[e], 0.f), b = fmaxf(v1[e], 0.f); v0[e] = a * a; v1[e] = b * b; } }
                    u32x4 w; w.x = ::pk2(v0[0], v0[1]); w.y = ::pk2(v0[2], v0[3]); w.z = ::pk2(v1[0], v1[1]); w.w = ::pk2(v1[2], v1[3]);
                    *(u32x4*)(rowp + bj * HALF) = w; } }
    }
};
struct EpiRes {
    static constexpr bool PERM = false, AFTER_DRAIN = false;
    const float* base_lat; const float* base_ctx; float* out_lat; float* out_ctx; const float* gate  ;
    __device__ __forceinline__ void operator()(const f32x4 (&acc)[2][2][4][2], const Unit& u, int wr, int wc, int fr, int fq) const {
        const bool lat = u.pm < (ML / BM); const int mi = lat ? (u.pm >> 5) : 4;
        const float* gv = gate + (size_t)mi * 6144;
        const size_t tile_off = lat ? (size_t)u.pm * BM * DM : (size_t)(u.pm - ML / BM) * BM * DM;
        const float* bp = (lat ? base_lat : base_ctx) + tile_off; float* op = (lat ? out_lat : out_ctx) + tile_off;
        const int col0 = u.pn * BM + wc * 32 + 4 * fq;
        f32x4 g4[2][2];
#pragma unroll
        for (int bj = 0; bj < 2; ++bj)
#pragma unroll
            for (int n = 0; n < 2; ++n) g4[bj][n] = *(const f32x4*)(gv + col0 + bj * HALF + n * 16);
#pragma unroll
        for (int ai = 0; ai < 2; ++ai)
#pragma unroll
            for (int m = 0; m < 4; ++m) { const size_t off = (size_t)(ai * HALF + wr * 64 + m * 16 + fr) * DM + col0;
#pragma unroll
                for (int bj = 0; bj < 2; ++bj)
#pragma unroll
                    for (int n = 0; n < 2; ++n) { const f32x4 bs = *(const f32x4*)(bp + off + bj * HALF + n * 16);
                        *(f32x4*)(op + off + bj * HALF + n * 16) = bs + g4[bj][n] * acc[ai][bj][m][n]; } }
    }
};
}

struct Args { const float* in[29]; float* out; unsigned char* ws; int ph_lo, ph_hi; };
enum { I_X = 0, I_C, I_CTX, I_CCTX, I_FNG, I_MODW, I_MODB, I_N1G, I_N2G, I_WIN, I_WOUT, I_W1, I_W2, I_GGW2, I_GGB, I_GNG, I_RMU, I_RW0, I_RW2, I_RA0, I_RA2, I_RG2,
       I_RKK, I_RKA, I_RRK, I_RLNG, I_RLNB, I_RETLR, I_RETNG };

typedef const __attribute__((address_space(4))) Args* CArgs;
struct Frame {
    LAS unsigned char* lds;
    int tid, lane, wave, bid, G;
    CArgs ap; float* out; unsigned char* ws;
    float* mod; bf16_t *Win_t, *Wout_t, *W1_t, *W2_t; float* xc; bf16_t *A, *Z, *PREP, *H;
};

__device__ __forceinline__ int mod_index(int m) { return m < ML ? (m >> 13) : 4; }
__device__ __forceinline__ int seq_row(int b, int dir, int s) {
    if (s < CTXL) { const int tc = dir ? (CTXL - 1 - s) : s; return ML + b * CTXL + tc; }
    const int tl = s - CTXL; const int t = dir ? (SEQ - 1 - tl) : tl; return b * SEQ + t;
}
__device__ __forceinline__ float zshift(const bf16_t* Z, int m, int col, float mu) {
    const bf16_t* p = Z + (size_t)m * ZP + col;
    const float z0 = bf2f(*p); float nb;
    if (m < ML) { const int t = m & (SEQ - 1), gr = t >> 6, gc = t & 63; float s = 0.f;
        if (gr > 0) s += bf2f(*(p - (ptrdiff_t)64 * ZP)); if (gr < 127) s += bf2f(*(p + (ptrdiff_t)64 * ZP));
        if (gc > 0) s += bf2f(*(p - (ptrdiff_t)ZP)); if (gc < 63) s += bf2f(*(p + (ptrdiff_t)ZP));
        nb = 0.25f * s;
    } else { const int t = (m - ML) & (CTXL - 1); float s = 0.f;
        if (t > 0) s += bf2f(*(p - (ptrdiff_t)ZP)); if (t < CTXL - 1) s += bf2f(*(p + (ptrdiff_t)ZP));
        nb = 0.5f * s; }
    return z0 + mu * (nb - z0);
}


struct ZNb { ptrdiff_t o[4]; float w[4]; };
__device__ __forceinline__ ZNb znb(int m) { ZNb n;
    if (m < ML) { const int t = m & (SEQ - 1), gr = t >> 6, gc = t & 63;
        n.o[0] = gr > 0 ? -(ptrdiff_t)64 * ZP : 0; n.o[1] = gr < 127 ? (ptrdiff_t)64 * ZP : 0; n.o[2] = gc > 0 ? -(ptrdiff_t)ZP : 0; n.o[3] = gc < 63 ? (ptrdiff_t)ZP : 0;
        n.w[0] = gr > 0 ? 0.25f : 0.f; n.w[1] = gr < 127 ? 0.25f : 0.f; n.w[2] = gc > 0 ? 0.25f : 0.f; n.w[3] = gc < 63 ? 0.25f : 0.f;
    } else { const int t = (m - ML) & (CTXL - 1);
        n.o[0] = 0; n.o[1] = 0; n.o[2] = t > 0 ? -(ptrdiff_t)ZP : 0; n.o[3] = t < CTXL - 1 ? (ptrdiff_t)ZP : 0;
        n.w[0] = 0.f; n.w[1] = 0.f; n.w[2] = t > 0 ? 0.5f : 0.f; n.w[3] = t < CTXL - 1 ? 0.5f : 0.f; }
    return n; }
struct ZRaw { bf16_t c, n0, n1, n2, n3; };
__device__ __forceinline__ ZRaw zload(const bf16_t* p, const ZNb& n) { ZRaw r; r.c = *p; r.n0 = *(p + n.o[0]); r.n1 = *(p + n.o[1]); r.n2 = *(p + n.o[2]); r.n3 = *(p + n.o[3]); return r; }
__device__ __forceinline__ float zmix(const ZRaw& r, const ZNb& n, float mu) { const float z0 = bf2f(r.c);
    const float nb = (bf2f(r.n0) * n.w[0] + bf2f(r.n1) * n.w[1]) + (bf2f(r.n2) * n.w[2] + bf2f(r.n3) * n.w[3]); return z0 + mu * (nb - z0); }
__device__ __forceinline__ float fast_tanh(float x) { const float e = __expf(2.0f * x); return 1.0f - 2.0f / (e + 1.0f); }

__device__ __forceinline__ void phase_mod(Frame& F) {
    LAS float* sc = (LAS float*)F.lds;
    LAS float* red = sc + 5 * 1024;
    for (int i = F.tid; i < 5 * 1024; i += NTHR) { const int j = i >> 10, k = i & 1023; const float v = j < 4 ? F.ap->in[I_C][j * 1024 + k] : F.ap->in[I_CCTX][k]; sc[i] = siluf_(v); }
    __syncthreads();
    const int kg = F.tid >> 6, c = F.tid & 63;
    for (int it = F.bid; it < DEPTH * 96; it += F.G) {
        const int l = it / 96, cgp = it % 96, col = cgp * 64 + c;
        const float* W = F.ap->in[I_MODW] + (size_t)l * DM * 6144 + col;
        float a0 = 0.f, a1 = 0.f, a2 = 0.f, a3 = 0.f, a4 = 0.f;
#pragma unroll 4
        for (int k = kg * 128; k < kg * 128 + 128; ++k) { const float w = W[(size_t)k * 6144];
            a0 += sc[k] * w; a1 += sc[1024 + k] * w; a2 += sc[2048 + k] * w; a3 += sc[3072 + k] * w; a4 += sc[4096 + k] * w; }
        red[(kg * 5 + 0) * 64 + c] = a0; red[(kg * 5 + 1) * 64 + c] = a1; red[(kg * 5 + 2) * 64 + c] = a2; red[(kg * 5 + 3) * 64 + c] = a3; red[(kg * 5 + 4) * 64 + c] = a4;
        __syncthreads();
        if (F.tid < 320) { const int j = F.tid >> 6; float s = 0.f;
#pragma unroll
            for (int g = 0; g < 8; ++g) s += red[(g * 5 + j) * 64 + c];
            F.mod[((size_t)l * 5 + j) * 6144 + col] = s + F.ap->in[I_MODB][l * 6144 + col]; }
        __syncthreads();
    }
}

__device__ __forceinline__ void transpose_item(const float* W, int K, int N, bf16_t* WT, LAS float* scr, int item, int lane) {
    const int nblk = N / 32, kb = item / nblk, nb = item % nblk, k0 = 64 * kb, n0 = 32 * nb;
#pragma unroll 8
    for (int i = 0; i < 32; ++i) { const int kk = 2 * i + (lane >> 5); scr[kk * 33 + (lane & 31)] = W[(size_t)(k0 + kk) * N + n0 + (lane & 31)]; }
    LDS_WAIT(); asm volatile("" ::: "memory");
    const int c = lane & 7;
#pragma unroll
    for (int j = 0; j < 4; ++j) { const int n = (lane >> 3) + 8 * j; const LAS float* s = scr + (8 * c) * 33 + n;
        u32x4 o; o.x = pk2(s[0 * 33], s[1 * 33]); o.y = pk2(s[2 * 33], s[3 * 33]); o.z = pk2(s[4 * 33], s[5 * 33]); o.w = pk2(s[6 * 33], s[7 * 33]);
        *(u32x4*)(WT + (size_t)(n0 + n) * K + k0 + 8 * c) = o; }
    LDS_WAIT(); asm volatile("" ::: "memory");
}
__device__ __forceinline__ void phase_wconv(Frame& F, int l) {
    LAS float* scr = (LAS float*)(F.lds + F.wave * 16384);
    const int gw = F.bid * NWAVES + F.wave, NGW = F.G * NWAVES;
    constexpr int I_IN = (DM / 64) * (INC / 32), I_O = (DM / 64) * (DM / 32), I_1 = (DM / 64) * (DFF / 32), I_2 = (DFF / 64) * (DM / 32);
    const float* Win = F.ap->in[I_WIN] + (size_t)l * DM * INC; const float* Wout = F.ap->in[I_WOUT] + (size_t)l * DM * DM;
    const float* W1 = F.ap->in[I_W1] + (size_t)l * DM * DFF; const float* W2 = F.ap->in[I_W2] + (size_t)l * DFF * DM;
    for (int it = gw; it < I_IN + I_O + I_1 + I_2; it += NGW) {
        int r = it;
        if (r < I_IN) { transpose_item(Win, DM, INC, F.Win_t, scr, r, F.lane); continue; } r -= I_IN;
        if (r < I_O) { transpose_item(Wout, DM, DM, F.Wout_t, scr, r, F.lane); continue; } r -= I_O;
        if (r < I_1) { transpose_item(W1, DM, DFF, F.W1_t, scr, r, F.lane); continue; } r -= I_1;
        transpose_item(W2, DFF, DM, F.W2_t, scr, r, F.lane);
    }
    { u32x4* zp = (u32x4*)(F.Win_t + (size_t)INC * DM); const int n16 = (ZP - INC) * DM * 2 / 16;
      for (int i = F.bid * NTHR + F.tid; i < n16; i += F.G * NTHR) zp[i] = (u32x4){0u, 0u, 0u, 0u}; }
}

__device__ __forceinline__ void phase_norm(Frame& F, const float* src_lat, const float* src_ctx, const float* g, const float* modl, int shift_idx, int scale_idx, int Mrows) {
    const int gw = F.bid * NWAVES + F.wave, NGW = F.G * NWAVES;
    for (int m = gw; m < Mrows; m += NGW) {
        const float* xrow = m < ML ? src_lat + (size_t)m * DM : src_ctx + (size_t)(m - ML) * DM;
        const float* mv = modl + (size_t)mod_index(m) * 6144;
        const f32x4* xr = (const f32x4*)xrow + F.lane;
        f32x4 v[4]; float ss = 0.f;
#pragma unroll
        for (int j = 0; j < 4; ++j) { v[j] = xr[64 * j]; ss += (v[j].x * v[j].x + v[j].y * v[j].y) + (v[j].z * v[j].z + v[j].w * v[j].w); }
        const float r = rsqrtf(wave_sum(ss) * (1.f / DM) + 1e-6f);
        u32x2* o8 = (u32x2*)(F.A + (size_t)m * DM) + F.lane;
#pragma unroll
        for (int j = 0; j < 4; ++j) { const int col = 4 * F.lane + 256 * j;
            const f32x4 gg = *(const f32x4*)(g + col), sh = *(const f32x4*)(mv + shift_idx * 1024 + col), sc = *(const f32x4*)(mv + scale_idx * 1024 + col);
            const f32x4 y = v[j] * r * gg * (sc + 1.0f) + sh;
            u32x2 w; w.x = pk2(y.x, y.y); w.y = pk2(y.z, y.w); o8[64 * j] = w; }
    }
}
__device__ __forceinline__ void phase_final(Frame& F) {
    const int gw = F.bid * NWAVES + F.wave, NGW = F.G * NWAVES; const float* g = F.ap->in[I_FNG];
    for (int m = gw; m < ML; m += NGW) {
        f32x4* xr = (f32x4*)(F.out + (size_t)m * DM) + F.lane;
        f32x4 v[4]; float ss = 0.f;
#pragma unroll
        for (int j = 0; j < 4; ++j) { v[j] = xr[64 * j]; ss += (v[j].x * v[j].x + v[j].y * v[j].y) + (v[j].z * v[j].z + v[j].w * v[j].w); }
        const float r = rsqrtf(wave_sum(ss) * (1.f / DM) + 1e-6f);
#pragma unroll
        for (int j = 0; j < 4; ++j) { const f32x4 gg = *(const f32x4*)(g + 4 * F.lane + 256 * j); xr[64 * j] = v[j] * r * gg; }
    }
}

__device__ __forceinline__ void phase_prep(Frame& F, int l) {
    constexpr int TG = 8;
    LAS float* lr = (LAS float*)F.lds;
    const float* mu = F.ap->in[I_RMU] + l * 1312;
    const int c = F.tid;
    float w2f[32], w2b[32], a2[32]; float w0f = 0, w0b = 0, a0 = 0, kk_ = 0, ka_ = 0, mur = 0, muk = 0, muv = 0;
    if (c < 384) {
#pragma unroll
        for (int j = 0; j < 32; ++j) { w2f[j] = F.ap->in[I_RW2][((size_t)(l * 2 + 0) * 32 + j) * 384 + c]; w2b[j] = F.ap->in[I_RW2][((size_t)(l * 2 + 1) * 32 + j) * 384 + c]; a2[j] = F.ap->in[I_RA2][((size_t)l * 32 + j) * 384 + c]; }
        w0f = F.ap->in[I_RW0][(l * 2 + 0) * 384 + c]; w0b = F.ap->in[I_RW0][(l * 2 + 1) * 384 + c]; a0 = F.ap->in[I_RA0][l * 384 + c];
        kk_ = F.ap->in[I_RKK][l * 384 + c]; ka_ = F.ap->in[I_RKA][l * 384 + c]; mur = mu[c]; muk = mu[384 + c]; muv = mu[768 + c];
    }
    for (int it = F.bid; it < MT / TG; it += F.G) {
        const int m0 = it * TG;
        for (int i = F.tid; i < TG * 96; i += NTHR) { const int tok = i / 96, j = i % 96; const float v = zshift(F.Z, m0 + tok, RW_OFF + 1152 + j, mu[1152 + j]); lr[i] = j < 64 ? fast_tanh(v) : v; }
        __syncthreads();
        if (c < 384) {
#pragma unroll
            for (int tb = 0; tb < TG; tb += 4) {
                ZRaw zr[4][3]; ZNb nbv[4];
#pragma unroll
                for (int u = 0; u < 4; ++u) { const int m = m0 + tb + u; nbv[u] = znb(m); const bf16_t* p = F.Z + (size_t)m * ZP + RW_OFF + c;
                    zr[u][0] = zload(p, nbv[u]); zr[u][1] = zload(p + 384, nbv[u]); zr[u][2] = zload(p + 768, nbv[u]); }
#pragma unroll
                for (int u = 0; u < 4; ++u) { const int tok = tb + u, m = m0 + tok;
                    const float r = zmix(zr[u][0], nbv[u], mur), k = zmix(zr[u][1], nbv[u], muk), v = zmix(zr[u][2], nbv[u], muv);
                    float xf = w0f, xb = w0b, xa = a0;
#pragma unroll
                    for (int j = 0; j < 32; ++j) { xf += lr[tok * 96 + j] * w2f[j]; xb += lr[tok * 96 + 32 + j] * w2b[j]; xa += lr[tok * 96 + 64 + j] * a2[j]; }
                    const float ef = sigmoidf_(xf) * 0.6065306597f, eb = sigmoidf_(xb) * 0.6065306597f;
                    const float dwf = 1.0f - __expf(-ef), dwb = 1.0f - __expf(-eb);
                    const float a = sigmoidf_(xa);
                    float kk = k * kk_; const float ss = wave_sum(kk * kk); kk *= rsqrtf(ss + 1e-12f);
                    const float kp = k * (1.f + (a - 1.f) * ka_), bb = kk * a;
                    const size_t o = (size_t)m * 384 + c;
                    F.PREP[PR_R * PREP_STRIDE + o] = f2bf(r); F.PREP[PR_WF * PREP_STRIDE + o] = f2bf(dwf); F.PREP[PR_WB * PREP_STRIDE + o] = f2bf(dwb);
                    F.PREP[PR_K * PREP_STRIDE + o] = f2bf(kp); F.PREP[PR_V * PREP_STRIDE + o] = f2bf(v); F.PREP[PR_KK * PREP_STRIDE + o] = f2bf(kk); F.PREP[PR_B * PREP_STRIDE + o] = f2bf(bb);
                }
            }
        }
        __syncthreads();
    }
}

#ifndef SCAN_GLA_V0
#define SCAN_GLA_V0 0
#endif
__device__ __forceinline__ void gla_scan_block(Frame& F, int l, int chain) {
    constexpr int TS = 64;
    const int dir = chain & 1, h = (chain >> 1) & 3, b = chain >> 3;
    LAS float* q = (LAS float*)F.lds;
    LAS float* k = q + TS * 48; LAS float* g = k + TS * 48;
    LAS float* v = g + TS * 48;
    LAS float* y = v + TS * 96;
    const float* W2 = F.ap->in[I_GGW2] + (size_t)(l * 2 + dir) * 16 * 192 + h * 48; const float* Bg = F.ap->in[I_GGB] + (l * 2 + dir) * 192 + h * 48;
    const float qs = 0.14433756729740643f;
    float S[48];
#pragma unroll
    for (int j = 0; j < 48; ++j) S[j] = 0.f;
    for (int tile = 0; tile < SEQT / TS; ++tile) {
        const int sbase = tile * TS;
        for (int i = F.tid; i < TS * 48; i += NTHR) { const int st = i / 48, j = i % 48; const int m = seq_row(b, dir, sbase + st); const bf16_t* zr = F.Z + (size_t)m * ZP;
            q[i] = bf2f(zr[GLA_OFF + h * 48 + j]) * qs; k[i] = bf2f(zr[GLA_OFF + 192 + h * 48 + j]);
            float x = Bg[j];
#pragma unroll
            for (int r = 0; r < 16; ++r) x += bf2f(zr[GLA_OFF + 1152 + dir * 16 + r]) * W2[r * 192 + j];
            const float ls = fminf(x, 0.f) - log1pf(__expf(-fabsf(x)));
            g[i] = __expf(ls * (1.0f / 16.0f)); }
        for (int i = F.tid; i < TS * 96; i += NTHR) { const int st = i / 96, n = i % 96; const int m = seq_row(b, dir, sbase + st); v[i] = bf2f(F.Z[(size_t)m * ZP + GLA_OFF + 384 + h * 96 + n]); }
        __syncthreads();
        if (F.tid < 96) {
            for (int st = 0; st < TS; ++st) { const float vn = v[st * 96 + F.tid]; float o = 0.f;
#pragma unroll
                for (int j = 0; j < 48; ++j) { S[j] = S[j] * g[st * 48 + j] + k[st * 48 + j] * vn; o += q[st * 48 + j] * S[j]; }
                y[st * 96 + F.tid] = o; }
        }
        __syncthreads();
        for (int i = F.tid; i < TS * 96; i += NTHR) { const int st = i / 96, n = i % 96; const int m = seq_row(b, dir, sbase + st); const bf16_t o = f2bf(y[i]);
            if (dir == 0) F.A[(size_t)m * DM + h * 96 + n] = o; else F.Z[(size_t)m * ZP + YB_OFF + h * 96 + n] = o; }
        __syncthreads();
    }
}
typedef short bf16x8 __attribute__((ext_vector_type(8)));
__device__ __forceinline__ void rwkv_stage(const bf16_t* PREP, LAS float* vecb, LAS float* vvb, int b, int dir, int h, int quarter, int wsel, int sbase, int lt) {
    constexpr int TS = 32;
    const int st = lt >> 3, part = lt & 7; const int m = seq_row(b, dir, sbase + st);
    const bf16_t* src = PREP + (size_t)m * 384 + h * 64 + part * 8;
    u32x4 raw[5];
    raw[0] = *(const u32x4*)(src + (size_t)PR_KK * PREP_STRIDE); raw[1] = *(const u32x4*)(src + (size_t)wsel * PREP_STRIDE); raw[2] = *(const u32x4*)(src + (size_t)PR_B * PREP_STRIDE);
    raw[3] = *(const u32x4*)(src + (size_t)PR_K * PREP_STRIDE); raw[4] = *(const u32x4*)(src + (size_t)PR_R * PREP_STRIDE);
    bf16_t vraw[2];
#pragma unroll
    for (int q = 0; q < 2; ++q) { const int idx = lt + 256 * q, s2 = idx >> 4, rr = idx & 15; const int m2 = seq_row(b, dir, sbase + s2);
        vraw[q] = PREP[(size_t)PR_V * PREP_STRIDE + (size_t)m2 * 384 + h * 64 + quarter * 16 + rr]; }
#pragma unroll
    for (int vi = 0; vi < 5; ++vi) { const u32x4 r = raw[vi]; f32x4 lo, hi;
        lo.x = __uint_as_float(r.x << 16); lo.y = __uint_as_float(r.x & 0xffff0000u); lo.z = __uint_as_float(r.y << 16); lo.w = __uint_as_float(r.y & 0xffff0000u);
        hi.x = __uint_as_float(r.z << 16); hi.y = __uint_as_float(r.z & 0xffff0000u); hi.z = __uint_as_float(r.w << 16); hi.w = __uint_as_float(r.w & 0xffff0000u);
        if (vi == 1) { lo = 1.0f - lo; hi = 1.0f - hi; }
        LAS float* dst = vecb + (vi * TS + st) * 64 + part * 8; *(LAS f32x4*)dst = lo; *(LAS f32x4*)(dst + 4) = hi; }
#pragma unroll
    for (int q = 0; q < 2; ++q) { const int idx = lt + 256 * q; vvb[idx] = bf2f(vraw[q]); }
}
__device__ __forceinline__ void rwkv_flush(bf16_t* A, bf16_t* Z, const LAS float* ybb, int b, int dir, int h, int quarter, int sbase, int lt) {
#pragma unroll
    for (int q = 0; q < 2; ++q) { const int idx = lt + 256 * q, st = idx >> 4, rr = idx & 15; const int m = seq_row(b, dir, sbase + st);
        const bf16_t o = f2bf(ybb[idx]);
        if (dir == 0) A[(size_t)m * DM + 384 + h * 64 + quarter * 16 + rr] = o; else Z[(size_t)m * ZP + YB_OFF + 384 + h * 64 + quarter * 16 + rr] = o; }
}
__device__ __forceinline__ void rwkv_scan_block(Frame& F, int chain, int quarter) {
    constexpr int TS = 32, NT = SEQT / TS;
    const int dir = chain & 1, h = (chain >> 1) % 6, b = (chain >> 1) / 6;
    LAS float* vec = (LAS float*)F.lds;
    LAS float* vv = vec + 2 * 5 * TS * 64;
    LAS float* yb = vv + 2 * TS * 16;
    const bool comp = F.wave < 4;
    const int rg = F.lane >> 4, cgp = F.lane & 15, lrow = (F.wave & 3) * 4 + rg, lt = F.tid - 256;
    const int wsel = dir ? PR_WB : PR_WF;
    f32x2 sA = {0.f, 0.f}, sB = {0.f, 0.f};
    if (!comp) rwkv_stage(F.PREP, vec, vv, b, dir, h, quarter, wsel, 0, lt);
    __syncthreads();
    for (int tile = 0; tile < NT; ++tile) {
        const int cur = tile & 1;
        if (comp) {
            const LAS float* vb = vec + cur * 5 * TS * 64 + cgp * 4; const LAS float* vvb = vv + cur * TS * 16 + lrow; LAS float* ybb = yb + cur * TS * 16;
            f32x4 kk_n = *(const LAS f32x4*)(vb + (0 * TS) * 64), w_n = *(const LAS f32x4*)(vb + (1 * TS) * 64), b_n = *(const LAS f32x4*)(vb + (2 * TS) * 64);
            f32x4 k_n = *(const LAS f32x4*)(vb + (3 * TS) * 64), r_n = *(const LAS f32x4*)(vb + (4 * TS) * 64); float v_n = vvb[0];
#pragma unroll
            for (int g = 0; g < TS / 16; ++g) { float yacc = 0.f;
#pragma unroll
                for (int s16 = 0; s16 < 16; ++s16) { const int st = g * 16 + s16;
                    const f32x4 kk4 = kk_n, w4 = w_n, b4 = b_n, k4 = k_n, r4 = r_n; const float vr = v_n;
                    if (st + 1 < TS) { kk_n = *(const LAS f32x4*)(vb + (0 * TS + st + 1) * 64); w_n = *(const LAS f32x4*)(vb + (1 * TS + st + 1) * 64); b_n = *(const LAS f32x4*)(vb + (2 * TS + st + 1) * 64);
                        k_n = *(const LAS f32x4*)(vb + (3 * TS + st + 1) * 64); r_n = *(const LAS f32x4*)(vb + (4 * TS + st + 1) * 64); v_n = vvb[(st + 1) * 16]; }
                    const f32x2 p2 = sA * kk4.xy + sB * kk4.zw; float p = p2.x + p2.y;
                    sA = sA * w4.xy + k4.xy * vr; sB = sB * w4.zw + k4.zw * vr;
                    p = reduce16(p);
                    sA = sA - b4.xy * p; sB = sB - b4.zw * p;
                    const f32x2 y2 = sA * r4.xy + sB * r4.zw; float y = y2.x + y2.y;
                    y = reduce16(y);
                    yacc = (cgp == s16) ? y : yacc; }
                ybb[(g * 16 + cgp) * 16 + lrow] = yacc; }
        } else {
            if (tile + 1 < NT) rwkv_stage(F.PREP, vec + (cur ^ 1) * 5 * TS * 64, vv + (cur ^ 1) * TS * 16, b, dir, h, quarter, wsel, (tile + 1) * TS, lt);
            if (tile > 0) rwkv_flush(F.A, F.Z, yb + (cur ^ 1) * TS * 16, b, dir, h, quarter, (tile - 1) * TS, lt);
        }
        __syncthreads();
    }
    if (!comp) rwkv_flush(F.A, F.Z, yb + ((NT - 1) & 1) * TS * 16, b, dir, h, quarter, (NT - 1) * TS, lt);
}

namespace ce {
constexpr int PITCH = 72, IMG = 64 * PITCH * 2;
constexpr int VTB = 96 * PITCH * 2;
constexpr int O_QG = 0, O_KG = 2 * IMG, O_KET = 4 * IMG, O_VT = 6 * IMG, O_PB = O_VT + 2 * VTB, O_ST = O_PB + IMG, O_DEC = O_ST + 2 * VTB, O_WSUM = O_DEC + 512, O_END = O_WSUM + 8 * 48 * 4, O_W2 = O_END, O_END2 = O_W2 + 17 * 48 * 4;
static_assert(O_END2 <= 131072, "chunk engine LDS");
__device__ __forceinline__ bf16x8 frag(const LAS unsigned char* img, int row, int col) { return *(const LAS bf16x8*)(img + (row * PITCH + col) * 2); }
__device__ __forceinline__ void st4(LAS unsigned char* img, int row, int col, f32x4 v) { u32x2 w; w.x = pk2(v.x, v.y); w.y = pk2(v.z, v.w); *(LAS u32x2*)(img + (row * PITCH + col) * 2) = w; }
__device__ __forceinline__ f32x2 up2(unsigned u) { f32x2 r; r.x = __uint_as_float(u << 16); r.y = __uint_as_float(u & 0xffff0000u); return r; }

template <int DV> __device__ __forceinline__ void chunk_mma(Frame& F, LAS unsigned char* L, int cb, int sb, f32x4 (&acc_s)[DV / 32], int b, int dir, int cs, int ycol0) {
    constexpr int NQ = DV / 32;
    const int lane = F.lane, w = F.wave, lr = lane & 15, lq = lane >> 4;
    LAS unsigned char* Qg = L + O_QG + cb * IMG; LAS unsigned char* Kg = L + O_KG + cb * IMG; LAS unsigned char* KeT = L + O_KET + cb * IMG;
    LAS unsigned char* Vt = L + O_VT + cb * VTB; LAS unsigned char* Pb = L + O_PB; LAS unsigned char* St = L + O_ST + sb * VTB; LAS unsigned char* Sn = L + O_ST + (sb ^ 1) * VTB;
    const LAS float* dec = (const LAS float*)(L + O_DEC + cb * 256);
#pragma unroll
    for (int q = 0; q < 2; ++q) { const int idx = w + 8 * q; if (idx < 10) {
            const int jt = idx < 4 ? 0 : idx < 7 ? 1 : idx < 9 ? 2 : 3; const int it = idx < 4 ? idx : idx < 7 ? idx - 3 : idx < 9 ? idx - 5 : 3;
            f32x4 acc = {0.f, 0.f, 0.f, 0.f};
#pragma unroll
            for (int ks = 0; ks < 2; ++ks) acc = __builtin_amdgcn_mfma_f32_16x16x32_bf16(frag(Kg, jt * 16 + lr, 32 * ks + 8 * lq), frag(Qg, it * 16 + lr, 32 * ks + 8 * lq), acc, 0, 0, 0);
            if (jt == it) {
#pragma unroll
                for (int r = 0; r < 4; ++r) if (4 * lq + r > lr) acc[r] = 0.f; }
            st4(Pb, it * 16 + lr, jt * 16 + 4 * lq, acc); } }
    __syncthreads();
#pragma unroll
    for (int q = 0; q < NQ; ++q) { const int id = w + 8 * q, nt = id >> 2, it = id & 3;
        f32x4 acc = {0.f, 0.f, 0.f, 0.f};
#pragma unroll
        for (int ks = 0; ks < 2; ++ks) acc = __builtin_amdgcn_mfma_f32_16x16x32_bf16(frag(St, nt * 16 + lr, 32 * ks + 8 * lq), frag(Qg, it * 16 + lr, 32 * ks + 8 * lq), acc, 0, 0, 0);
#pragma unroll
        for (int ks = 0; ks < 2; ++ks) acc = __builtin_amdgcn_mfma_f32_16x16x32_bf16(frag(Vt, nt * 16 + lr, 32 * ks + 8 * lq), frag(Pb, it * 16 + lr, 32 * ks + 8 * lq), acc, 0, 0, 0);
        const int m = seq_row(b, dir, cs * 64 + it * 16 + lr); const int col = ycol0 + nt * 16 + 4 * lq;
        u32x2 o; o.x = pk2(acc.x, acc.y); o.y = pk2(acc.z, acc.w);
        if (dir == 0) *(u32x2*)(F.A + (size_t)m * DM + col) = o; else *(u32x2*)(F.Z + (size_t)m * ZP + YB_OFF + col) = o; }
#pragma unroll
    for (int q = 0; q < NQ; ++q) { const int id = w + 8 * q, kt = id & 3, nt = id >> 2;
        const f32x4 d4 = *(const LAS f32x4*)(dec + kt * 16 + 4 * lq);
        f32x4 acc = acc_s[q] * d4;
#pragma unroll
        for (int ks = 0; ks < 2; ++ks) acc = __builtin_amdgcn_mfma_f32_16x16x32_bf16(frag(KeT, kt * 16 + lr, 32 * ks + 8 * lq), frag(Vt, nt * 16 + lr, 32 * ks + 8 * lq), acc, 0, 0, 0);
        acc_s[q] = acc;
        st4(Sn, nt * 16 + lr, kt * 16 + 4 * lq, acc); }
}

__device__ __forceinline__ void ret_chain(Frame& F, int l, int chain) {
    constexpr int DV = 64, NCH = SEQT / 64;
    const int dir = chain & 1, h = (chain >> 1) & 3, b = chain >> 3;
    LAS unsigned char* L = F.lds;
    const int tp = F.tid >> 4, jj = F.tid & 15, t0 = 2 * tp, t1 = t0 + 1;
    const float lgam = -__expf(F.ap->in[I_RETLR][(l * 2 + dir) * 4 + h]);
    float eq[2], ek[2], ee[2];
#pragma unroll
    for (int e = 0; e < 2; ++e) { const float G = (float)(t0 + e + 1) * lgam; eq[e] = __expf(G); ek[e] = 0.125f * __expf(-G); ee[e] = 0.125f * __expf(64.0f * lgam - G); }
    const int d0 = 2 * jj;
    const bool rowb = d0 < 16; float inv[2];
#pragma unroll
    for (int e = 0; e < 2; ++e) inv[e] = powf(10000.0f, -(float)((d0 + e) & 15) * (1.0f / 16.0f));
    float ccs[2][2], csn[2][2];
#pragma unroll
    for (int tk = 0; tk < 2; ++tk)
#pragma unroll
        for (int e = 0; e < 2; ++e) { const float pos = (float)(dir ? 63 - (t0 + tk) : (t0 + tk)); sincosf(pos * inv[e], &csn[tk][e], &ccs[tk][e]); }
    for (int i = F.tid; i < IMG / 4; i += NTHR) ((LAS unsigned*)(L + O_PB))[i] = 0u;
    for (int i = F.tid; i < VTB / 4; i += NTHR) ((LAS unsigned*)(L + O_ST))[i] = 0u;
    if (F.tid < 128) ((LAS float*)(L + O_DEC))[F.tid] = __expf(64.0f * lgam);
    f32x4 acc_s[DV / 32];
#pragma unroll
    for (int q = 0; q < DV / 32; ++q) acc_s[q] = (f32x4){0.f, 0.f, 0.f, 0.f};
    unsigned rq[2][2], rk[2][2], rv[2][2];
    const bf16_t* Zc = F.Z + RET_OFF + h * 64 + d0;
#define RET_LOAD(cs_) do { _Pragma("unroll") for (int tk = 0; tk < 2; ++tk) { const int m = seq_row(b, dir, (cs_) * 64 + t0 + tk); const bf16_t* zr = Zc + (size_t)m * ZP; \
        rq[tk][0] = *(const unsigned*)(zr); rq[tk][1] = *(const unsigned*)(zr + 32); rk[tk][0] = *(const unsigned*)(zr + 256); rk[tk][1] = *(const unsigned*)(zr + 288); \
        rv[tk][0] = *(const unsigned*)(zr + 512); rv[tk][1] = *(const unsigned*)(zr + 544); } } while (0)
#define RET_STAGE(cs_, cb_) do { \
        LAS unsigned char* Qg = L + O_QG + (cb_) * IMG; LAS unsigned char* Kg = L + O_KG + (cb_) * IMG; LAS unsigned char* KeT = L + O_KET + (cb_) * IMG; LAS unsigned char* Vt = L + O_VT + (cb_) * VTB; \
        const bool lat = (cs_) >= 4; float rc[2] = {1.f, 1.f}, rs[2] = {0.f, 0.f}; \
        if (lat && rowb) { const float row = (float)(dir ? 127 - ((cs_) - 4) : (cs_) - 4); _Pragma("unroll") for (int e = 0; e < 2; ++e) { rs[e] = __sinf(row * inv[e]); rc[e] = __cosf(row * inv[e]); } } \
        f32x2 ke_lo[2], ke_hi[2], v_lo[2], v_hi[2]; \
        _Pragma("unroll") for (int tk = 0; tk < 2; ++tk) { \
            f32x2 q1 = up2(rq[tk][0]), q2 = up2(rq[tk][1]), k1 = up2(rk[tk][0]), k2 = up2(rk[tk][1]); \
            f32x2 c, s; if (rowb) { c.x = rc[0]; c.y = rc[1]; s.x = rs[0]; s.y = rs[1]; } else { c.x = lat ? ccs[tk][0] : 1.f; c.y = lat ? ccs[tk][1] : 1.f; s.x = lat ? csn[tk][0] : 0.f; s.y = lat ? csn[tk][1] : 0.f; } \
            const f32x2 qa = q1 * c - q2 * s, qb = q1 * s + q2 * c, ka = k1 * c - k2 * s, kb = k1 * s + k2 * c; \
            const int t = t0 + tk; \
            *(LAS unsigned*)(Qg + (t * PITCH + d0) * 2) = pk2(qa.x * eq[tk], qa.y * eq[tk]); *(LAS unsigned*)(Qg + (t * PITCH + d0 + 32) * 2) = pk2(qb.x * eq[tk], qb.y * eq[tk]); \
            *(LAS unsigned*)(Kg + (t * PITCH + d0) * 2) = pk2(ka.x * ek[tk], ka.y * ek[tk]); *(LAS unsigned*)(Kg + (t * PITCH + d0 + 32) * 2) = pk2(kb.x * ek[tk], kb.y * ek[tk]); \
            ke_lo[tk] = ka * ee[tk]; ke_hi[tk] = kb * ee[tk]; v_lo[tk] = up2(rv[tk][0]); v_hi[tk] = up2(rv[tk][1]); } \
        *(LAS unsigned*)(KeT + ((d0) * PITCH + t0) * 2) = pk2(ke_lo[0].x, ke_lo[1].x); *(LAS unsigned*)(KeT + ((d0 + 1) * PITCH + t0) * 2) = pk2(ke_lo[0].y, ke_lo[1].y); \
        *(LAS unsigned*)(KeT + ((d0 + 32) * PITCH + t0) * 2) = pk2(ke_hi[0].x, ke_hi[1].x); *(LAS unsigned*)(KeT + ((d0 + 33) * PITCH + t0) * 2) = pk2(ke_hi[0].y, ke_hi[1].y); \
        *(LAS unsigned*)(Vt + ((d0) * PITCH + t0) * 2) = pk2(v_lo[0].x, v_lo[1].x); *(LAS unsigned*)(Vt + ((d0 + 1) * PITCH + t0) * 2) = pk2(v_lo[0].y, v_lo[1].y); \
        *(LAS unsigned*)(Vt + ((d0 + 32) * PITCH + t0) * 2) = pk2(v_hi[0].x, v_hi[1].x); *(LAS unsigned*)(Vt + ((d0 + 33) * PITCH + t0) * 2) = pk2(v_hi[0].y, v_hi[1].y); \
    } while (0)
    RET_LOAD(0); RET_STAGE(0, 0);
    __syncthreads();
    for (int cs = 0; cs < NCH; ++cs) { const int cb = cs & 1;
        if (cs + 1 < NCH) RET_LOAD(cs + 1);
        chunk_mma<DV>(F, L, cb, cb, acc_s, b, dir, cs, 768 + h * 64);
        if (cs + 1 < NCH) RET_STAGE(cs + 1, cb ^ 1);
        __syncthreads();
    }
#undef RET_LOAD
#undef RET_STAGE
}

__device__ __forceinline__ void gla_chain(Frame& F, int l, int chain) {
    constexpr int DV = 96, NCH = SEQT / 64;
    const int dir = chain & 1, h = (chain >> 1) & 3, b = chain >> 3;
    LAS unsigned char* L = F.lds;
    const int t = F.tid >> 3, j8 = F.tid & 7, d0 = 2 * j8;
    LAS float* wsum = (LAS float*)(L + O_WSUM);
    const float qs = 0.14433756729740643f;
    LAS float* w2s = (LAS float*)(L + O_W2);
    for (int i = F.tid; i < O_END / 4; i += NTHR) ((LAS unsigned*)L)[i] = 0u;
    { const float* W2 = F.ap->in[I_GGW2] + (size_t)(l * 2 + dir) * 16 * 192 + h * 48; const float* Bg = F.ap->in[I_GGB] + (l * 2 + dir) * 192 + h * 48;
      for (int i = F.tid; i < 17 * 48; i += NTHR) { const int r = i / 48, d = i % 48; w2s[i] = r < 16 ? W2[r * 192 + d] : Bg[d]; } }
    f32x4 acc_s[DV / 32];
#pragma unroll
    for (int q = 0; q < DV / 32; ++q) acc_s[q] = (f32x4){0.f, 0.f, 0.f, 0.f};
    unsigned rq[3], rk[3], rv[6]; u32x4 rl[2];
    const bf16_t* Zc = F.Z + GLA_OFF + h * 48 + d0;
#define GLA_LOAD(cs_) do { const int m = seq_row(b, dir, (cs_) * 64 + t); const bf16_t* zr = Zc + (size_t)m * ZP; const bf16_t* zv = F.Z + (size_t)m * ZP + GLA_OFF + 384 + h * 96 + d0; \
        _Pragma("unroll") for (int q = 0; q < 3; ++q) { rq[q] = *(const unsigned*)(zr + 16 * q); rk[q] = *(const unsigned*)(zr + 192 + 16 * q); } \
        _Pragma("unroll") for (int q = 0; q < 6; ++q) rv[q] = *(const unsigned*)(zv + 16 * q); \
        const u32x4* zl = (const u32x4*)(F.Z + (size_t)m * ZP + GLA_OFF + 1152 + dir * 16); rl[0] = zl[0]; rl[1] = zl[1]; } while (0)
#define GLA_STAGE(cs_, cb_) do { \
        LAS unsigned char* Qg = L + O_QG + (cb_) * IMG; LAS unsigned char* Kg = L + O_KG + (cb_) * IMG; LAS unsigned char* KeT = L + O_KET + (cb_) * IMG; LAS unsigned char* Vt = L + O_VT + (cb_) * VTB; \
        float lrv[16]; { const f32x2 a0 = up2(rl[0].x), a1 = up2(rl[0].y), a2 = up2(rl[0].z), a3 = up2(rl[0].w), a4 = up2(rl[1].x), a5 = up2(rl[1].y), a6 = up2(rl[1].z), a7 = up2(rl[1].w); \
            lrv[0] = a0.x; lrv[1] = a0.y; lrv[2] = a1.x; lrv[3] = a1.y; lrv[4] = a2.x; lrv[5] = a2.y; lrv[6] = a3.x; lrv[7] = a3.y; lrv[8] = a4.x; lrv[9] = a4.y; lrv[10] = a5.x; lrv[11] = a5.y; lrv[12] = a6.x; lrv[13] = a6.y; lrv[14] = a7.x; lrv[15] = a7.y; } \
        float G[6]; \
        { f32x2 x2[3]; _Pragma("unroll") for (int q = 0; q < 3; ++q) x2[q] = *(const LAS f32x2*)(w2s + 16 * 48 + d0 + 16 * q); \
          _Pragma("unroll") for (int r = 0; r < 16; ++r) { _Pragma("unroll") for (int q = 0; q < 3; ++q) x2[q] += *(const LAS f32x2*)(w2s + r * 48 + d0 + 16 * q) * lrv[r]; } \
          _Pragma("unroll") for (int q = 0; q < 3; ++q) { G[2 * q] = x2[q].x; G[2 * q + 1] = x2[q].y; } } \
        _Pragma("unroll") for (int e = 0; e < 6; ++e) { const float x = G[e]; G[e] = (fminf(x, 0.f) - log1pf(__expf(-fabsf(x)))) * (1.0f / 16.0f); } \
          \
        _Pragma("unroll") for (int o = 8; o < 64; o <<= 1) { _Pragma("unroll") for (int e = 0; e < 6; ++e) { const float u = __shfl_up(G[e], o); if (F.lane >= o) G[e] += u; } } \
        if (F.lane >= 56) { _Pragma("unroll") for (int q = 0; q < 3; ++q) *(LAS f32x2*)(wsum + F.wave * 48 + d0 + 16 * q) = (f32x2){G[2 * q], G[2 * q + 1]}; } \
        __syncthreads(); \
        float Ge[6]; \
        _Pragma("unroll") for (int q = 0; q < 3; ++q) { f32x2 off = {0.f, 0.f}, tot = {0.f, 0.f}; \
            _Pragma("unroll") for (int ww = 0; ww < 8; ++ww) { const f32x2 s = *(const LAS f32x2*)(wsum + ww * 48 + d0 + 16 * q); tot += s; if (ww < F.wave) off += s; } \
            G[2 * q] += off.x; G[2 * q + 1] += off.y; Ge[2 * q] = tot.x; Ge[2 * q + 1] = tot.y; } \
        if (t == 0) { _Pragma("unroll") for (int q = 0; q < 3; ++q) *(LAS f32x2*)((LAS float*)(L + O_DEC + (cb_) * 256) + d0 + 16 * q) = (f32x2){__expf(Ge[2 * q]), __expf(Ge[2 * q + 1])}; } \
        _Pragma("unroll") for (int q = 0; q < 3; ++q) { const f32x2 qv = up2(rq[q]), kv = up2(rk[q]); const int d = d0 + 16 * q; \
            const float eq0 = __expf(G[2 * q]) * qs, eq1 = __expf(G[2 * q + 1]) * qs, ek0 = __expf(-G[2 * q]), ek1 = __expf(-G[2 * q + 1]), ee0 = __expf(Ge[2 * q] - G[2 * q]), ee1 = __expf(Ge[2 * q + 1] - G[2 * q + 1]); \
            *(LAS unsigned*)(Qg + (t * PITCH + d) * 2) = pk2(qv.x * eq0, qv.y * eq1); *(LAS unsigned*)(Kg + (t * PITCH + d) * 2) = pk2(kv.x * ek0, kv.y * ek1); \
            *(LAS bf16_t*)(KeT + (d * PITCH + t) * 2) = f2bf(kv.x * ee0); *(LAS bf16_t*)(KeT + ((d + 1) * PITCH + t) * 2) = f2bf(kv.y * ee1); } \
        _Pragma("unroll") for (int q = 0; q < 6; ++q) { const int d = d0 + 16 * q; *(LAS bf16_t*)(Vt + (d * PITCH + t) * 2) = (bf16_t)(rv[q] & 0xffffu); *(LAS bf16_t*)(Vt + ((d + 1) * PITCH + t) * 2) = (bf16_t)(rv[q] >> 16); } \
    } while (0)
    __syncthreads();
    GLA_LOAD(0); GLA_STAGE(0, 0);
    __syncthreads();
    for (int cs = 0; cs < NCH; ++cs) { const int cb = cs & 1;
        if (cs + 1 < NCH) GLA_LOAD(cs + 1);
        chunk_mma<DV>(F, L, cb, cb, acc_s, b, dir, cs, h * 96);
        if (cs + 1 < NCH) GLA_STAGE(cs + 1, cb ^ 1);
        __syncthreads();
    }
#undef GLA_LOAD
#undef GLA_STAGE
}
}

#ifndef PROBE_DUP
#define PROBE_DUP 0
#endif
__device__ __forceinline__ void phase_scan(Frame& F, int l) {
    for (int task = F.bid; task < 256; task += F.G) {
        if ((PROBE_DUP & 32) && task < 192) { rwkv_scan_block(F, task >> 2, task & 3); __syncthreads(); }
        if ((PROBE_DUP & 64) && task >= 192 && task < 224) { ce::gla_chain(F, l, task - 192); __syncthreads(); }
        if ((PROBE_DUP & 128) && task >= 224) { ce::ret_chain(F, l, task - 224); __syncthreads(); }
        if (task < 192) rwkv_scan_block(F, task >> 2, task & 3);
        else if (task < 224) {
#if SCAN_GLA_V0
            gla_scan_block(F, l, task - 192);
#else
            ce::gla_chain(F, l, task - 192);
#endif
        } else ce::ret_chain(F, l, task - 224);
        __syncthreads();
    }
}
__device__ __forceinline__ void phase_post(Frame& F, int l, int Mrows) {
    constexpr int TG = 8;
    LAS float* sg = (LAS float*)F.lds;
    const float* mu = F.ap->in[I_RMU] + l * 1312;
    const int c = F.tid;
    float g2[64]; float lng = 0, lnb = 0, rk = 0;
    if (c < 384) {
#pragma unroll
        for (int j = 0; j < 64; ++j) g2[j] = F.ap->in[I_RG2][((size_t)l * 64 + j) * 384 + c];
        lng = F.ap->in[I_RLNG][l * 384 + c]; lnb = F.ap->in[I_RLNB][l * 384 + c]; rk = F.ap->in[I_RRK][l * 384 + c];
    }
    for (int it = F.bid; it < Mrows / TG; it += F.G) {
        const int m0 = it * TG;
        { const int tok = F.tid >> 6, j = F.tid & 63; sg[F.tid] = sigmoidf_(zshift(F.Z, m0 + tok, RW_OFF + 1248 + j, mu[1248 + j])); }
        __syncthreads();
        if (c < 384) {
#pragma unroll
            for (int tb = 0; tb < TG; tb += 4) {
                bf16_t ryf[4], ryb[4], rr[4], rkp[4], rvv[4];
#pragma unroll
                for (int u = 0; u < 4; ++u) { const int m = m0 + tb + u; const size_t o = (size_t)m * 384 + c;
                    ryf[u] = F.A[(size_t)m * DM + 384 + c]; ryb[u] = F.Z[(size_t)m * ZP + YB_OFF + 384 + c];
                    rr[u] = F.PREP[PR_R * PREP_STRIDE + o]; rkp[u] = F.PREP[PR_K * PREP_STRIDE + o]; rvv[u] = F.PREP[PR_V * PREP_STRIDE + o]; }
#pragma unroll
                for (int u = 0; u < 4; ++u) { const int tok = tb + u, m = m0 + tok;
                    const float yv = bf2f(ryf[u]) + bf2f(ryb[u]);
                    const float mean = wave_sum(yv) * (1.f / 64.f); const float d = yv - mean; const float var = wave_sum(d * d) * (1.f / 64.f);
                    const float yn = d * rsqrtf(var + 64e-5f) * lng + lnb;
                    const float bon = wave_sum(bf2f(rr[u]) * bf2f(rkp[u]) * rk) * bf2f(rvv[u]);
                    float gt = 0.f;
#pragma unroll
                    for (int j = 0; j < 64; ++j) gt += sg[tok * 64 + j] * g2[j];
                    F.A[(size_t)m * DM + 384 + c] = f2bf((yn + bon) * gt); }
            }
        }
        for (int u = F.wave; u < TG * 8; u += NWAVES) { const int m = m0 + (u >> 3), hu = u & 7; const bf16_t* zr = F.Z + (size_t)m * ZP; bf16_t* ar = F.A + (size_t)m * DM;
            if (hu < 4) { const int c0 = hu * 96 + F.lane, c1 = c0 + 64; const bool two = F.lane < 32;
                const float y0 = bf2f(ar[c0]) + bf2f(zr[YB_OFF + c0]); const float y1 = two ? bf2f(ar[c1]) + bf2f(zr[YB_OFF + c1]) : 0.f;
                const float r = rsqrtf(wave_sum(y0 * y0 + y1 * y1) * (1.f / 96.f) + 1e-6f);
                ar[c0] = f2bf(siluf_(bf2f(zr[GLA_OFF + 768 + c0])) * y0 * r * F.ap->in[I_GNG][l * 384 + c0]);
                if (two) ar[c1] = f2bf(siluf_(bf2f(zr[GLA_OFF + 768 + c1])) * y1 * r * F.ap->in[I_GNG][l * 384 + c1]);
            } else { const int cc = (hu - 4) * 64 + F.lane;
                const float y0 = bf2f(ar[768 + cc]) + bf2f(zr[YB_OFF + 768 + cc]);
                const float r = rsqrtf(wave_sum(y0 * y0) * (1.f / 64.f) + 1e-6f);
                ar[768 + cc] = f2bf(siluf_(bf2f(zr[RET_OFF + 768 + cc])) * y0 * r * F.ap->in[I_RETNG][l * 256 + cc]); }
        }
        __syncthreads();
    }
}

constexpr int PH_PER_LAYER = 9, N_PHASES = 1 + DEPTH * PH_PER_LAYER + 1;
#define PHASE_ENTER() \
    CArgs ap = (CArgs)__builtin_amdgcn_kernarg_segment_ptr(); asm volatile("" : "+s"(ap)); \
    int tid = threadIdx.x; asm volatile("" : "+v"(tid)); \
    Frame F; F.lds = lds; F.ap = ap; F.tid = tid; F.lane = tid & 63; F.wave = __builtin_amdgcn_readfirstlane(tid >> 6); F.bid = blockIdx.x; F.G = gridDim.x; \
    unsigned char* ws = ap->ws; F.out = ap->out; F.ws = ws; \
    F.mod = (float*)(ws + WS_MOD); F.Win_t = (bf16_t*)(ws + WS_WIN); F.Wout_t = (bf16_t*)(ws + WS_WOUT); F.W1_t = (bf16_t*)(ws + WS_W1); F.W2_t = (bf16_t*)(ws + WS_W2); \
    F.xc = (float*)(ws + WS_XC); F.A = (bf16_t*)(ws + WS_ABUF); F.Z = (bf16_t*)(ws + WS_Z); F.PREP = (bf16_t*)(ws + WS_PREP); F.H = (bf16_t*)(ws + WS_H); \
    const float* modl = F.mod + (size_t)L * 5 * 6144; (void)modl; \
    const float* xl_in = L == 0 ? F.ap->in[I_X] : F.out; const float* xc_in = L == 0 ? F.ap->in[I_CTX] : F.xc; (void)xl_in; (void)xc_in;

#ifndef PROBE_DUP
#define PROBE_DUP 0
#endif
#define IN(k) (lo <= (k) && (k) < hi)
#define SEAM(k) do { if (IN(k) && IN((k) + 1)) { if ((k) == 0) grid.sync(); else xcd_barrier(bar); if (PROBE_DUP & 16) xcd_barrier(bar); } } while (0)
template <int L> __device__ __forceinline__ void run_layer(int lo, int hi, LAS unsigned char* lds, cg::grid_group& grid, const XcdBarrier& bar) {
    constexpr int p0 = 1 + L * PH_PER_LAYER; constexpr bool last = (L == DEPTH - 1); constexpr int Mo = last ? ML : MT;
    if (IN(p0 + 0)) { PHASE_ENTER(); phase_wconv(F, L); phase_norm(F, xl_in, xc_in, F.ap->in[I_N1G] + L * DM, modl, 0, 1, MT); } SEAM(p0 + 0);
    if (PROBE_DUP & 4) { if (IN(p0 + 0)) { PHASE_ENTER(); phase_wconv(F, L); phase_norm(F, xl_in, xc_in, F.ap->in[I_N1G] + L * DM, modl, 0, 1, MT); } SEAM(p0 + 0); }
    if (IN(p0 + 1)) { PHASE_ENTER(); pg8::Gemm g{F.A, F.Win_t, MT, ZP, DM}; pg8::StaticOrder S; S.init(MT, ZP, F.G, F.bid); pg8::EpiBf16<0> E{F.Z, ZP};
        pg8::gemm_phase<pg8::EpiBf16<0>, pg8::StaticOrder, true, true>(F.lds, g, S, E, tid); if (PROBE_DUP & 8) { grid.sync(); pg8::gemm_phase<pg8::EpiBf16<0>, pg8::StaticOrder, true, true>(F.lds, g, S, E, tid); } } SEAM(p0 + 1);
    if (IN(p0 + 2)) { PHASE_ENTER(); phase_prep(F, L); if (PROBE_DUP & 2) { grid.sync(); phase_prep(F, L); } } SEAM(p0 + 2);
    if (IN(p0 + 3)) { PHASE_ENTER(); phase_scan(F, L); if (PROBE_DUP & 1) { grid.sync(); phase_scan(F, L); } } SEAM(p0 + 3);
    if (IN(p0 + 4)) { PHASE_ENTER(); phase_post(F, L, Mo); } SEAM(p0 + 4);
    if (IN(p0 + 5)) { PHASE_ENTER(); pg8::Gemm g{F.A, F.Wout_t, Mo, DM, DM}; pg8::StaticOrder S; S.init(Mo, DM, F.G, F.bid); pg8::EpiRes E{xl_in, xc_in, F.out, F.xc, modl + 2 * 1024};
        pg8::gemm_phase<pg8::EpiRes, pg8::StaticOrder, true, true>(F.lds, g, S, E, tid); } SEAM(p0 + 5);
    if (IN(p0 + 6)) { PHASE_ENTER(); phase_norm(F, F.out, F.xc, F.ap->in[I_N2G] + L * DM, modl, 3, 4, Mo); if (PROBE_DUP & 4) { grid.sync(); phase_norm(F, F.out, F.xc, F.ap->in[I_N2G] + L * DM, modl, 3, 4, Mo); } } SEAM(p0 + 6);
    if (IN(p0 + 7)) { PHASE_ENTER(); pg8::Gemm g{F.A, F.W1_t, Mo, DFF, DM}; pg8::StaticOrder S; S.init(Mo, DFF, F.G, F.bid); pg8::EpiBf16<2> E{F.H, DFF};
        pg8::gemm_phase<pg8::EpiBf16<2>, pg8::StaticOrder, true, true>(F.lds, g, S, E, tid); if (PROBE_DUP & 8) { grid.sync(); pg8::gemm_phase<pg8::EpiBf16<2>, pg8::StaticOrder, true, true>(F.lds, g, S, E, tid); } } SEAM(p0 + 7);
    if (IN(p0 + 8)) { PHASE_ENTER(); pg8::Gemm g{F.H, F.W2_t, Mo, DM, DFF}; pg8::StaticOrder S; S.init(Mo, DM, F.G, F.bid); pg8::EpiRes E{F.out, F.xc, F.out, F.xc, modl + 5 * 1024};
        pg8::gemm_phase<pg8::EpiRes, pg8::StaticOrder, true, true>(F.lds, g, S, E, tid); } SEAM(p0 + 8);
}
__global__ void __launch_bounds__(NTHR, 2) mega_fwd(Args args) {
    extern __shared__ __attribute__((aligned(16))) unsigned char lds_raw[];
    LAS unsigned char* lds = (LAS unsigned char*)lds_raw;
    const int lo = args.ph_lo, hi = args.ph_hi;
    cg::grid_group grid = cg::this_grid();
    volatile LAS unsigned* misc = (volatile LAS unsigned*)(lds + LDS_BYTES - 256);
    if (threadIdx.x < 4) misc[threadIdx.x] = 0u;
    __syncthreads();
    const XcdBarrier bar = xcd_barrier_post((unsigned*)(args.ws + WS_CTL) + 1024, misc);
    { constexpr int L = 0; if (IN(0)) { PHASE_ENTER(); phase_mod(F); } SEAM(0); }
    run_layer<0>(lo, hi, lds, grid, bar);
    run_layer<1>(lo, hi, lds, grid, bar);
    { constexpr int L = 0; if (IN(N_PHASES - 1)) { PHASE_ENTER(); phase_final(F); } }
}
#undef IN
#undef SEAM

extern "C" void kernel_launch(void* const* d_in, const int* in_sizes, int n_in, void* d_out, int out_size, void* d_ws, size_t ws_size, hipStream_t stream) {
    static int grid = 0;
    if (grid == 0) {
        int dev = 0, cus = 0, per_cu = 0;
        hipGetDevice(&dev); hipDeviceGetAttribute(&cus, hipDeviceAttributeMultiprocessorCount, dev);
        hipFuncSetAttribute((const void*)mega_fwd, hipFuncAttributeMaxDynamicSharedMemorySize, LDS_BYTES);
        hipOccupancyMaxActiveBlocksPerMultiprocessor(&per_cu, (const void*)mega_fwd, NTHR, LDS_BYTES);
        if (per_cu < 1) { fprintf(stderr, "kernel_launch: occupancy query says %d blocks per CU\n", per_cu); per_cu = 1; }
        (void)hipGetLastError();
        grid = cus * per_cu;
        if (n_in != 29 || ws_size < WS_END) fprintf(stderr, "kernel_launch: unexpected n_in %d / ws_size %zu (need %zu)\n", n_in, ws_size, (size_t)WS_END);
    }
    Args a{};
    for (int i = 0; i < 29; ++i) a.in[i] = (const float*)d_in[i];
    a.out = (float*)d_out; a.ws = (unsigned char*)d_ws;
#if MK_ONE_LAUNCH
    (void)hipMemsetAsync((char*)d_ws + WS_CTL, 0, 65536, stream);
    a.ph_lo = 0; a.ph_hi = N_PHASES;
    void* kargs[] = {&a};
    hipError_t e = hipLaunchCooperativeKernel((const void*)mega_fwd, dim3(grid), dim3(NTHR), kargs, LDS_BYTES, stream);
    if (e != hipSuccess) fprintf(stderr, "cooperative launch failed: %s (grid %d)\n", hipGetErrorString(e), grid);
#else
    for (int ph = 0; ph < N_PHASES; ++ph) { a.ph_lo = ph; a.ph_hi = ph + 1;
        hipLaunchKernelGGL(mega_fwd, dim3(grid), dim3(NTHR), LDS_BYTES, stream, a); }
#endif
}
```

```cpp
#include <hip/hip_runtime.h>
#include <hip/hip_cooperative_groups.h>
#include <cstdio>
#include <cstdint>
namespace cg = cooperative_groups;

#ifndef MK_ONE_LAUNCH
#define MK_ONE_LAUNCH 1
#endif

#define LAS __attribute__((address_space(3)))
#define GAS __attribute__((address_space(1)))
typedef unsigned short bf16_t;
typedef float f32x4 __attribute__((ext_vector_type(4)));
typedef float f32x2 __attribute__((ext_vector_type(2)));
typedef unsigned u32x4 __attribute__((ext_vector_type(4)));
typedef unsigned u32x2 __attribute__((ext_vector_type(2)));

constexpr int DM = 1024, NB = 4, SEQ = 8192, CTXL = 256, DEPTH = 2, DFF = 4096;
constexpr int ML = NB * SEQ, MC = NB * CTXL, MT = ML + MC;
constexpr int INC = 3520, ZP = 3584;
constexpr int GLA_OFF = 0, RW_OFF = 1184, RET_OFF = 2496;
constexpr int YB_OFF = RW_OFF;
constexpr int SEQT = CTXL + SEQ;
constexpr int NTHR = 512, NWAVES = 8;

constexpr size_t MiB = 1u << 20;
constexpr size_t WS_CTL = 0, CTL_BYTES = 1 * MiB;
constexpr size_t WS_MOD = 1 * MiB;
constexpr size_t WS_WIN = 2 * MiB, WS_WOUT = 9 * MiB, WS_W1 = 11 * MiB, WS_W2 = 19 * MiB;
constexpr size_t WS_XC = 27 * MiB;
constexpr size_t WS_ABUF = 32 * MiB;
constexpr size_t WS_Z = 98 * MiB;
constexpr size_t WS_PREP = 329 * MiB;
constexpr size_t PREP_STRIDE = (size_t)MT * 384;
constexpr size_t WS_H = 98 * MiB;
constexpr size_t WS_END = WS_PREP + 7 * PREP_STRIDE * 2;
static_assert(WS_ABUF + (size_t)MT * DM * 2 <= WS_Z, "ws map");
static_assert(WS_Z + (size_t)MT * ZP * 2 <= WS_PREP, "ws map");
static_assert(WS_H + (size_t)MT * DFF * 2 <= WS_END, "ws map");
static_assert(WS_END <= 512 * MiB, "ws map");
enum { PR_R = 0, PR_WF = 1, PR_WB = 2, PR_K = 3, PR_V = 4, PR_KK = 5, PR_B = 6 };

constexpr int LDS_BYTES = 147456;

__device__ __forceinline__ float bf2f(bf16_t v) { return __uint_as_float(((unsigned)v) << 16); }
__device__ __forceinline__ unsigned f2bf_u(float f) { unsigned u = __float_as_uint(f); return (u + 0x7fffu + ((u >> 16) & 1u)) >> 16; }
__device__ __forceinline__ bf16_t f2bf(float f) { return (bf16_t)f2bf_u(f); }
__device__ __forceinline__ unsigned pk2(float lo, float hi) { return f2bf_u(lo) | (f2bf_u(hi) << 16); }
__device__ __forceinline__ float sigmoidf_(float x) { return 1.0f / (1.0f + __expf(-x)); }
__device__ __forceinline__ float siluf_(float x) { return x / (1.0f + __expf(-x)); }
__device__ __forceinline__ float softplusf_(float x) { return fmaxf(x, 0.f) + log1pf(__expf(-fabsf(x))); }
__device__ __forceinline__ float wave_sum(float v) {
#pragma unroll
    for (int o = 1; o < 64; o <<= 1) v += __shfl_xor(v, o);
    return v;
}
template <int CTRL> __device__ __forceinline__ float dpp_mov(float x) { return __int_as_float(__builtin_amdgcn_update_dpp(0, __float_as_int(x), CTRL, 0xF, 0xF, true)); }
__device__ __forceinline__ float reduce16(float x) {
    x += dpp_mov<0xB1>(x);
    x += dpp_mov<0x4E>(x);
    x += dpp_mov<0x141>(x);
    x += dpp_mov<0x140>(x);
    return x;
}
#define LDS_WAIT() asm volatile("s_waitcnt lgkmcnt(0)" ::: "memory")


#define XB_TMO      128
#define XB_XCNT(j)  (256  + 64 * (j))
#define XB_XSUB(j)  (1280 + 64 * (j))
#define XB_XGEN(j)  (2304 + 64 * (j))
#define XB_TOP      3328
#define XB_TOPGEN   3392
#define XCD_BAR_WORDS 3456
#define XB_SPIN_CAP (1u << 18)

__device__ __forceinline__ unsigned xb_ld(unsigned* p)              { return __hip_atomic_load(p, __ATOMIC_RELAXED, __HIP_MEMORY_SCOPE_AGENT); }
__device__ __forceinline__ unsigned xb_add(unsigned* p, unsigned v) { return __hip_atomic_fetch_add(p, v, __ATOMIC_RELAXED, __HIP_MEMORY_SCOPE_AGENT); }
__device__ __forceinline__ unsigned xb_xcc_id() { return (unsigned)__builtin_amdgcn_s_getreg((3 << 11) | 20) & 0xFu; }
#define XB_SPIN(cond, bar) do { unsigned _sp = 0; while (cond) { __builtin_amdgcn_s_sleep(1); \
    if ((++_sp & 255u) == 0u) { if (xb_ld(&(bar)[XB_TMO])) break; if (_sp > XB_SPIN_CAP) { atomicAdd(&(bar)[XB_TMO], 1u); break; } } } } while (0)

struct XcdBarrier {
    unsigned* bar; unsigned x;
    volatile LAS unsigned* st;
};

__device__ __forceinline__ XcdBarrier xcd_barrier_post(unsigned* bar, volatile LAS unsigned* st) {
    XcdBarrier b; b.bar = bar; b.x = xb_xcc_id(); b.st = st;
    if (threadIdx.x == 0) (void)xb_add(&bar[XB_XCNT(b.x)], 1u);
    return b;
}
__device__ __forceinline__ void xcd_barrier_complete(unsigned* bar, unsigned x, unsigned& nloc, unsigned& nx) {
    const unsigned G = gridDim.x * gridDim.y * gridDim.z;
    unsigned sum, cnt, mine, sp = 0u;
    for (;;) {
        sum = 0u; cnt = 0u; mine = 0u;
#pragma unroll
        for (unsigned j = 0; j < 16; ++j) { const unsigned c = xb_ld(&bar[XB_XCNT(j)]); sum += c; cnt += (c > 0u) ? 1u : 0u; mine = (j == x) ? c : mine; }
        if (sum == G) break;
        __builtin_amdgcn_s_sleep(1);
        if ((++sp & 255u) == 0u) { if (xb_ld(&bar[XB_TMO])) break; if (sp > XB_SPIN_CAP) { atomicAdd(&bar[XB_TMO], 1u); break; } }
    }
    nloc = mine > 0u ? mine : 1u; nx = cnt > 0u ? cnt : 1u;
}

__device__ __forceinline__ void xcd_barrier(const XcdBarrier& b) {
    asm volatile("s_waitcnt vmcnt(0)" ::: "memory");
    __syncthreads();
    if (threadIdx.x == 0) {
        unsigned* bar = b.bar;
        __builtin_amdgcn_s_waitcnt(0);
        unsigned nloc = b.st[0], nx = b.st[1];
        if (nloc == 0u) { xcd_barrier_complete(bar, b.x, nloc, nx); b.st[0] = nloc; b.st[1] = nx; }
        const unsigned old = xb_add(&bar[XB_XSUB(b.x)], 1u);
        const unsigned gen = old / nloc;
        if (old + 1u == (gen + 1u) * nloc) {
            __builtin_amdgcn_fence(__ATOMIC_RELEASE, "agent");
            asm volatile("s_waitcnt vmcnt(0)" ::: "memory");
            const unsigned og = xb_add(&bar[XB_TOP], 1u);
            const unsigned tg = og / nx;
            if (og + 1u == (tg + 1u) * nx) xb_add(&bar[XB_TOPGEN], 1u);
            else XB_SPIN(xb_ld(&bar[XB_TOPGEN]) == tg, bar);
            __builtin_amdgcn_fence(__ATOMIC_ACQUIRE, "agent");
            xb_add(&bar[XB_XGEN(b.x)], 1u);
            asm volatile("s_waitcnt vmcnt(0)" ::: "memory");
        } else {
            XB_SPIN(xb_ld(&bar[XB_XGEN(b.x)]) == gen, bar);
            __builtin_amdgcn_fence(__ATOMIC_ACQUIRE, "agent");
            asm volatile("s_waitcnt vmcnt(0)" ::: "memory");
        }
    }
    __syncthreads();
}


namespace pg8 {
#define PG8_LAS __attribute__((address_space(3)))
typedef unsigned short bf16_t;
typedef short bf16x8 __attribute__((ext_vector_type(8)));
typedef float f32x4 __attribute__((ext_vector_type(4)));
typedef unsigned u32x4 __attribute__((ext_vector_type(4)));
constexpr int BM = 256, BK = 64, HALF = 128, HTB = HALF * BK * 2  , STAGE_BYTES = 8 * HTB, NXCD = 8, WGM = 8;

__host__ __device__ __forceinline__ int lds_byte(int r, int c) { const int st = (r >> 4) * 2 + (c >> 5), rr = r & 15, cc = c & 31, ob = rr * 64 + cc * 2; return st * 1024 + (ob ^ (((ob >> 9) & 1) << 5)); }
__host__ __device__ __forceinline__ void stage_rc(int b, int& R, int& C) { const int st = b / 1024, sb = b % 1024, swz = sb ^ (((sb >> 9) & 1) << 5); R = (st >> 1) * 16 + swz / 64; C = (st & 1) * 32 + (swz % 64) / 2; }
__host__ __device__ __forceinline__ int perm32(int rho) { const int n = rho >> 4, i = rho & 15; return 8 * (i >> 2) + 4 * n + (i & 3); }

struct Unit { int pm, pn; };
struct Gemm { const bf16_t* A; const bf16_t* Bt; int M, N, K; };

struct StaticOrder {
    int nM, nN, nwg, G, c;
    __host__ __device__ void init(int M, int N, int G_, int c_) { nM = M / BM; nN = N / BM; nwg = nM * nN; G = G_; c = c_; }
    __host__ __device__ bool next(int i, Unit& u) const {
        const long L = (long)i * G + c; if (L >= nwg) return false;
        int wgid = (int)L; { const int q = nwg / NXCD, r = nwg % NXCD, xcd = wgid % NXCD, off = wgid / NXCD; wgid = (xcd < r ? xcd * (q + 1) : r * (q + 1) + (xcd - r) * q) + off; }
        const int nig = WGM * nN, gid = wgid / nig, fm = gid * WGM, gsz = (nM - fm) < WGM ? (nM - fm) : WGM;
        u.pm = fm + ((wgid % nig) % gsz); u.pn = (wgid % nig) / gsz; return true;
    }
    __device__ __forceinline__ void a_ready(const Unit&) const {}
    __device__ __forceinline__ void done(const Unit&) const {}
};

template <class Epi, class Sched, bool ALIGN_EPI = false, bool SP2 = false>
__device__ __forceinline__ void gemm_phase(PG8_LAS unsigned char* lds, const Gemm g, const Sched& S, const Epi& E, const int tid) {
    const int wid = __builtin_amdgcn_readfirstlane(tid >> 6), lane = tid & 63, wr = wid >> 2, wc = wid & 3, fr = lane & 15, fq = lane >> 4;
    const int K = g.K, nt = K / BK;
    unsigned voffA[2], voffB[2];
#pragma unroll
    for (int i = 0; i < 2; ++i) { int R, C; stage_rc(tid * 16 + i * 8192, R, C); const int Rb = Epi::PERM ? ((R & ~31) + perm32(R & 31)) : R;
        voffA[i] = (unsigned)(R * K + C) * 2u; voffB[i] = (unsigned)(Rb * K + C) * 2u; }
    const size_t kstep = (size_t)(BK * 2);
    const size_t hstep = (size_t)HALF * K * 2;
    const size_t tstep = 2 * hstep;
    const unsigned ldsw = (unsigned)wid * 1024u;
    const int aoff = lds_byte(wr * 64 + fr, fq * 8), boff = lds_byte(wc * 32 + fr, fq * 8);
#define PG8_SA(b, h) (((b) * 2 + (h)) * HTB)
#define PG8_SB(b, h) ((4 + (b) * 2 + (h)) * HTB)
#define PG8_STAGE(bufoff, gbase, voff) do { _Pragma("unroll") for (int _i = 0; _i < 2; ++_i) \
        __builtin_amdgcn_global_load_lds((const unsigned*)((const char*)(gbase) + (voff)[_i]), (PG8_LAS unsigned*)(lds + (bufoff) + ldsw + _i * 8192), 16, 0, 0); } while (0)
#define PG8_LDA(dst, b, h) do { _Pragma("unroll") for (int m = 0; m < 4; ++m) _Pragma("unroll") for (int k = 0; k < 2; ++k) dst[m][k] = *(const PG8_LAS bf16x8*)(lds + PG8_SA(b, h) + aoff + m * 2048 + k * 1024); } while (0)
#define PG8_LDB(dst, b, h) do { _Pragma("unroll") for (int n = 0; n < 2; ++n) _Pragma("unroll") for (int k = 0; k < 2; ++k) dst[n][k] = *(const PG8_LAS bf16x8*)(lds + PG8_SB(b, h) + boff + n * 2048 + k * 1024); } while (0)
#define PG8_MMA(ai, bj, At, Bt) do { __builtin_amdgcn_s_setprio(1); _Pragma("unroll") for (int m = 0; m < 4; ++m) _Pragma("unroll") for (int n = 0; n < 2; ++n) _Pragma("unroll") for (int k = 0; k < 2; ++k) \
        acc[ai][bj][m][n] = __builtin_amdgcn_mfma_f32_16x16x32_bf16(Bt[n][k], At[m][k], acc[ai][bj][m][n], 0, 0, 0); __builtin_amdgcn_s_setprio(0); } while (0)
#define PG8_WAIT_V(n) asm volatile("s_waitcnt vmcnt(" #n ")" ::: "memory")
#define PG8_WAIT_L(n) asm volatile("s_waitcnt lgkmcnt(" #n ")" ::: "memory")
#define PG8_BAR __builtin_amdgcn_s_barrier()
#define PG8_SCHED __builtin_amdgcn_sched_barrier(0)
    Unit cur, nxt; int ui = 0;
    if (!S.next(0, cur)) return;
    f32x4 acc[2][2][4][2];
#pragma unroll
    for (int a = 0; a < 2; ++a)
#pragma unroll
        for (int b = 0; b < 2; ++b)
#pragma unroll
            for (int m = 0; m < 4; ++m)
#pragma unroll
                for (int n = 0; n < 2; ++n) acc[a][b][m][n] = (f32x4){0.f, 0.f, 0.f, 0.f};
    bf16x8 At[4][2], B0[2][2], B1[2][2];
    const char* cA = (const char*)g.A + (size_t)cur.pm * tstep; const char* cB = (const char*)g.Bt + (size_t)cur.pn * tstep;
    S.a_ready(cur);
    if constexpr (SP2) {
        PG8_STAGE(PG8_SB(0, 0), cB, voffB); PG8_STAGE(PG8_SB(0, 1), cB + hstep, voffB); PG8_STAGE(PG8_SA(0, 0), cA, voffA); PG8_STAGE(PG8_SA(0, 1), cA + hstep, voffA);
        if (wr == 1) PG8_BAR;
        PG8_WAIT_V(2); PG8_BAR;
        PG8_STAGE(PG8_SB(1, 0), cB + kstep, voffB); PG8_STAGE(PG8_SA(1, 0), cA + kstep, voffA); PG8_STAGE(PG8_SB(1, 1), cB + hstep + kstep, voffB);
        PG8_WAIT_V(6); PG8_BAR;
    } else {
        PG8_STAGE(PG8_SB(0, 0), cB, voffB); PG8_STAGE(PG8_SA(0, 0), cA, voffA); PG8_STAGE(PG8_SB(0, 1), cB + hstep, voffB); PG8_STAGE(PG8_SA(0, 1), cA + hstep, voffA);
        if (wr == 1) PG8_BAR;
        PG8_WAIT_V(4); PG8_BAR;
        PG8_STAGE(PG8_SB(1, 0), cB + kstep, voffB); PG8_STAGE(PG8_SA(1, 0), cA + kstep, voffA); PG8_STAGE(PG8_SB(1, 1), cB + hstep + kstep, voffB);
        PG8_WAIT_V(6); PG8_BAR;
    }
    for (;;) {
        const bool has_next = S.next(ui + 1, nxt);
        const char* nA = has_next ? (const char*)g.A + (size_t)nxt.pm * tstep : cA; const char* nB = has_next ? (const char*)g.Bt + (size_t)nxt.pn * tstep : cB;
        for (int t = 0; t < nt; t += 2) {
            const bool last = (t == nt - 2);
            const char* a1 = cA + (size_t)(t + 1) * kstep;
            const char* a2 = last ? nA : cA + (size_t)(t + 2) * kstep; const char* b2 = last ? nB : cB + (size_t)(t + 2) * kstep;
            const char* a3 = a2 + kstep; const char* b3 = b2 + kstep;
            if (last && has_next) S.a_ready(nxt);
            if constexpr (SP2) {
            PG8_LDB(B0, 0, 0); PG8_LDB(B1, 0, 1); PG8_SCHED; PG8_LDA(At, 0, 0); PG8_STAGE(PG8_SA(1, 1), a1 + hstep, voffA);
            PG8_WAIT_V(8); PG8_WAIT_L(0); PG8_BAR; PG8_MMA(0, 0, At, B0); PG8_MMA(0, 1, At, B1); PG8_BAR; PG8_SCHED;
            PG8_LDA(At, 0, 1); PG8_STAGE(PG8_SB(0, 0), b2, voffB); PG8_STAGE(PG8_SB(0, 1), b2 + hstep, voffB); PG8_STAGE(PG8_SA(0, 0), a2, voffA);
            PG8_WAIT_V(8); PG8_WAIT_L(0); PG8_BAR; PG8_MMA(1, 0, At, B0); PG8_MMA(1, 1, At, B1); PG8_BAR; PG8_SCHED;
            PG8_LDB(B0, 1, 0); PG8_LDB(B1, 1, 1); PG8_SCHED; PG8_LDA(At, 1, 0); PG8_STAGE(PG8_SA(0, 1), a2 + hstep, voffA);
            PG8_WAIT_V(8); PG8_WAIT_L(0); PG8_BAR; PG8_MMA(0, 0, At, B0); PG8_MMA(0, 1, At, B1); PG8_BAR; PG8_SCHED;
            PG8_LDA(At, 1, 1); PG8_STAGE(PG8_SB(1, 0), b3, voffB); PG8_STAGE(PG8_SB(1, 1), b3 + hstep, voffB); PG8_STAGE(PG8_SA(1, 0), a3, voffA);
            PG8_WAIT_V(8); PG8_WAIT_L(0); PG8_BAR; PG8_MMA(1, 0, At, B0); PG8_MMA(1, 1, At, B1); PG8_BAR; PG8_SCHED;
            } else {
            PG8_LDB(B0, 0, 0); PG8_SCHED; PG8_LDA(At, 0, 0); PG8_STAGE(PG8_SA(1, 1), a1 + hstep, voffA);
            PG8_WAIT_L(8); PG8_BAR; PG8_WAIT_L(0); PG8_MMA(0, 0, At, B0); PG8_BAR; PG8_SCHED;
            PG8_LDB(B1, 0, 1); PG8_STAGE(PG8_SB(0, 0), b2, voffB);
            PG8_BAR; PG8_WAIT_L(0); PG8_MMA(0, 1, At, B1); PG8_BAR;
            PG8_LDA(At, 0, 1); PG8_STAGE(PG8_SA(0, 0), a2, voffA);
            PG8_BAR; PG8_WAIT_L(0); PG8_MMA(1, 0, At, B0); PG8_BAR; PG8_SCHED;
            PG8_STAGE(PG8_SB(0, 1), b2 + hstep, voffB);
            PG8_WAIT_V(6); PG8_BAR; PG8_MMA(1, 1, At, B1); PG8_BAR;
            PG8_LDB(B0, 1, 0); PG8_SCHED; PG8_LDA(At, 1, 0); PG8_STAGE(PG8_SA(0, 1), a2 + hstep, voffA);
            PG8_WAIT_L(8); PG8_BAR; PG8_WAIT_L(0); PG8_MMA(0, 0, At, B0); PG8_BAR; PG8_SCHED;
            PG8_LDB(B1, 1, 1); PG8_STAGE(PG8_SB(1, 0), b3, voffB);
            PG8_BAR; PG8_WAIT_L(0); PG8_MMA(0, 1, At, B1); PG8_BAR;
            PG8_LDA(At, 1, 1); PG8_STAGE(PG8_SA(1, 0), a3, voffA);
            PG8_BAR; PG8_WAIT_L(0); PG8_MMA(1, 0, At, B0); PG8_BAR; PG8_SCHED;
            PG8_STAGE(PG8_SB(1, 1), b3 + hstep, voffB);
            PG8_WAIT_V(6); PG8_BAR; PG8_MMA(1, 1, At, B1); PG8_BAR;
            }
        }
        if constexpr (ALIGN_EPI) { if (wr == 0) PG8_BAR; }
        if constexpr (!Epi::AFTER_DRAIN) { E(acc, cur, wr, wc, fr, fq); S.done(cur); }
        if (!has_next) break;
#pragma unroll
        for (int a = 0; a < 2; ++a)
#pragma unroll
            for (int b = 0; b < 2; ++b)
#pragma unroll
                for (int m = 0; m < 4; ++m)
#pragma unroll
                    for (int n = 0; n < 2; ++n) acc[a][b][m][n] = (f32x4){0.f, 0.f, 0.f, 0.f};
        cur = nxt; cA = nA; cB = nB; ++ui;
        if constexpr (ALIGN_EPI) { if (wr == 1) PG8_BAR; }
    }
    PG8_WAIT_V(0);
    if constexpr (!ALIGN_EPI) { if (wr == 0) PG8_BAR; }
    PG8_BAR;
    if constexpr (Epi::AFTER_DRAIN) { E.fused(acc, cur, wr, wc, fr, fq, lds, wid, lane); S.done(cur); }
#undef PG8_SA
#undef PG8_SB
#undef PG8_STAGE
#undef PG8_LDA
#undef PG8_LDB
#undef PG8_MMA
#undef PG8_WAIT_V
#undef PG8_WAIT_L
#undef PG8_BAR
#undef PG8_SCHED
}
}

namespace pg8 {
template <int ACT> struct EpiBf16 {
    static constexpr bool PERM = true, AFTER_DRAIN = false;
    bf16_t* O; int ldc;
    __device__ __forceinline__ void operator()(const f32x4 (&acc)[2][2][4][2], const Unit& u, int wr, int wc, int fr, int fq) const {
        const int row0 = u.pm * BM + wr * 64 + fr; const int col0 = u.pn * BM + wc * 32 + 8 * fq;
#pragma unroll
        for (int ai = 0; ai < 2; ++ai)
#pragma unroll
            for (int m = 0; m < 4; ++m) { bf16_t* rowp = O + (size_t)(row0 + ai * HALF + m * 16) * ldc + col0;
#pragma unroll
                for (int bj = 0; bj < 2; ++bj) { f32x4 v0 = acc[ai][bj][m][0], v1 = acc[ai][bj][m][1];
                    if (ACT == 2) {
#pragma unroll
                        for (int e = 0; e < 4; ++e) { float a = fmaxf(v0[e], 0.f), b = fmaxf(v1[e], 0.f); v0[e] = a * a; v1[e] = b * b; } }
                    u32x4 w; w.x = ::pk2(v0[0], v0[1]); w.y = ::pk2(v0[2], v0[3]); w.z = ::pk2(v1[0], v1[1]); w.w = ::pk2(v1[2], v1[3]);
                    *(u32x4*)(rowp + bj * HALF) = w; } }
    }
};
struct EpiRes {
    static constexpr bool PERM = false, AFTER_DRAIN = false;
    const float* base_lat; const float* base_ctx; float* out_lat; float* out_ctx; const float* gate  ;
    __device__ __forceinline__ void operator()(const f32x4 (&acc)[2][2][4][2], const Unit& u, int wr, int wc, int fr, int fq) const {
        const bool lat = u.pm < (ML / BM); const int mi = lat ? (u.pm >> 5) : 4;
        const float* gv = gate + (size_t)mi * 6144;
        const size_t tile_off = lat ? (size_t)u.pm * BM * DM : (size_t)(u.pm - ML / BM) * BM * DM;
        const float* bp = (lat ? base_lat : base_ctx) + tile_off; float* op = (lat ? out_lat : out_ctx) + tile_off;
        const int col0 = u.pn * BM + wc * 32 + 4 * fq;
        f32x4 g4[2][2];
#pragma unroll
        for (int bj = 0; bj < 2; ++bj)
#pragma unroll
            for (int n = 0; n < 2; ++n) g4[bj][n] = *(const f32x4*)(gv + col0 + bj * HALF + n * 16);
#pragma unroll
        for (int ai = 0; ai < 2; ++ai)
#pragma unroll
            for (int m = 0; m < 4; ++m) { const size_t off = (size_t)(ai * HALF + wr * 64 + m * 16 + fr) * DM + col0;
#pragma unroll
                for (int bj = 0; bj < 2; ++bj)
#pragma unroll
                    for (int n = 0; n < 2; ++n) { const f32x4 bs = *(const f32x4*)(bp + off + bj * HALF + n * 16);
                        *(f32x4*)(op + off + bj * HALF + n * 16) = bs + g4[bj][n] * acc[ai][bj][m][n]; } }
    }
};
}

struct Args { const float* in[29]; float* out; unsigned char* ws; int ph_lo, ph_hi; };
enum { I_X = 0, I_C, I_CTX, I_CCTX, I_FNG, I_MODW, I_MODB, I_N1G, I_N2G, I_WIN, I_WOUT, I_W1, I_W2, I_GGW2, I_GGB, I_GNG, I_RMU, I_RW0, I_RW2, I_RA0, I_RA2, I_RG2,
       I_RKK, I_RKA, I_RRK, I_RLNG, I_RLNB, I_RETLR, I_RETNG };

typedef const __attribute__((address_space(4))) Args* CArgs;
struct Frame {
    LAS unsigned char* lds;
    int tid, lane, wave, bid, G;
    CArgs ap; float* out; unsigned char* ws;
    float* mod; bf16_t *Win_t, *Wout_t, *W1_t, *W2_t; float* xc; bf16_t *A, *Z, *PREP, *H;
};

__device__ __forceinline__ int mod_index(int m) { return m < ML ? (m >> 13) : 4; }
__device__ __forceinline__ int seq_row(int b, int dir, int s) {
    if (s < CTXL) { const int tc = dir ? (CTXL - 1 - s) : s; return ML + b * CTXL + tc; }
    const int tl = s - CTXL; const int t = dir ? (SEQ - 1 - tl) : tl; return b * SEQ + t;
}
__device__ __forceinline__ float zshift(const bf16_t* Z, int m, int col, float mu) {
    const bf16_t* p = Z + (size_t)m * ZP + col;
    const float z0 = bf2f(*p); float nb;
    if (m < ML) { const int t = m & (SEQ - 1), gr = t >> 6, gc = t & 63; float s = 0.f;
        if (gr > 0) s += bf2f(*(p - (ptrdiff_t)64 * ZP)); if (gr < 127) s += bf2f(*(p + (ptrdiff_t)64 * ZP));
        if (gc > 0) s += bf2f(*(p - (ptrdiff_t)ZP)); if (gc < 63) s += bf2f(*(p + (ptrdiff_t)ZP));
        nb = 0.25f * s;
    } else { const int t = (m - ML) & (CTXL - 1); float s = 0.f;
        if (t > 0) s += bf2f(*(p - (ptrdiff_t)ZP)); if (t < CTXL - 1) s += bf2f(*(p + (ptrdiff_t)ZP));
        nb = 0.5f * s; }
    return z0 + mu * (nb - z0);
}


struct ZNb { ptrdiff_t o[4]; float w[4]; };
__device__ __forceinline__ ZNb znb(int m) { ZNb n;
    if (m < ML) { const int t = m & (SEQ - 1), gr = t >> 6, gc = t & 63;
        n.o[0] = gr > 0 ? -(ptrdiff_t)64 * ZP : 0; n.o[1] = gr < 127 ? (ptrdiff_t)64 * ZP : 0; n.o[2] = gc > 0 ? -(ptrdiff_t)ZP : 0; n.o[3] = gc < 63 ? (ptrdiff_t)ZP : 0;
        n.w[0] = gr > 0 ? 0.25f : 0.f; n.w[1] = gr < 127 ? 0.25f : 0.f; n.w[2] = gc > 0 ? 0.25f : 0.f; n.w[3] = gc < 63 ? 0.25f : 0.f;
    } else { const int t = (m - ML) & (CTXL - 1);
        n.o[0] = 0; n.o[1] = 0; n.o[2] = t > 0 ? -(ptrdiff_t)ZP : 0; n.o[3] = t < CTXL - 1 ? (ptrdiff_t)ZP : 0;
        n.w[0] = 0.f; n.w[1] = 0.f; n.w[2] = t > 0 ? 0.5f : 0.f; n.w[3] = t < CTXL - 1 ? 0.5f : 0.f; }
    return n; }
struct ZRaw { bf16_t c, n0, n1, n2, n3; };
__device__ __forceinline__ ZRaw zload(const bf16_t* p, const ZNb& n) { ZRaw r; r.c = *p; r.n0 = *(p + n.o[0]); r.n1 = *(p + n.o[1]); r.n2 = *(p + n.o[2]); r.n3 = *(p + n.o[3]); return r; }
__device__ __forceinline__ float zmix(const ZRaw& r, const ZNb& n, float mu) { const float z0 = bf2f(r.c);
    const float nb = (bf2f(r.n0) * n.w[0] + bf2f(r.n1) * n.w[1]) + (bf2f(r.n2) * n.w[2] + bf2f(r.n3) * n.w[3]); return z0 + mu * (nb - z0); }
__device__ __forceinline__ float fast_tanh(float x) { const float e = __expf(2.0f * x); return 1.0f - 2.0f / (e + 1.0f); }

__device__ __forceinline__ void phase_mod(Frame& F) {
    LAS float* sc = (LAS float*)F.lds;
    LAS float* red = sc + 5 * 1024;
    for (int i = F.tid; i < 5 * 1024; i += NTHR) { const int j = i >> 10, k = i & 1023; const float v = j < 4 ? F.ap->in[I_C][j * 1024 + k] : F.ap->in[I_CCTX][k]; sc[i] = siluf_(v); }
    __syncthreads();
    const int kg = F.tid >> 6, c = F.tid & 63;
    for (int it = F.bid; it < DEPTH * 96; it += F.G) {
        const int l = it / 96, cgp = it % 96, col = cgp * 64 + c;
        const float* W = F.ap->in[I_MODW] + (size_t)l * DM * 6144 + col;
        float a0 = 0.f, a1 = 0.f, a2 = 0.f, a3 = 0.f, a4 = 0.f;
#pragma unroll 4
        for (int k = kg * 128; k < kg * 128 + 128; ++k) { const float w = W[(size_t)k * 6144];
            a0 += sc[k] * w; a1 += sc[1024 + k] * w; a2 += sc[2048 + k] * w; a3 += sc[3072 + k] * w; a4 += sc[4096 + k] * w; }
        red[(kg * 5 + 0) * 64 + c] = a0; red[(kg * 5 + 1) * 64 + c] = a1; red[(kg * 5 + 2) * 64 + c] = a2; red[(kg * 5 + 3) * 64 + c] = a3; red[(kg * 5 + 4) * 64 + c] = a4;
        __syncthreads();
        if (F.tid < 320) { const int j = F.tid >> 6; float s = 0.f;
#pragma unroll
            for (int g = 0; g < 8; ++g) s += red[(g * 5 + j) * 64 + c];
            F.mod[((size_t)l * 5 + j) * 6144 + col] = s + F.ap->in[I_MODB][l * 6144 + col]; }
        __syncthreads();
    }
}

__device__ __forceinline__ void transpose_item(const float* W, int K, int N, bf16_t* WT, LAS float* scr, int item, int lane) {
    const int nblk = N / 32, kb = item / nblk, nb = item % nblk, k0 = 64 * kb, n0 = 32 * nb;
#pragma unroll 8
    for (int i = 0; i < 32; ++i) { const int kk = 2 * i + (lane >> 5); scr[kk * 33 + (lane & 31)] = W[(size_t)(k0 + kk) * N + n0 + (lane & 31)]; }
    LDS_WAIT(); asm volatile("" ::: "memory");
    const int c = lane & 7;
#pragma unroll
    for (int j = 0; j < 4; ++j) { const int n = (lane >> 3) + 8 * j; const LAS float* s = scr + (8 * c) * 33 + n;
        u32x4 o; o.x = pk2(s[0 * 33], s[1 * 33]); o.y = pk2(s[2 * 33], s[3 * 33]); o.z = pk2(s[4 * 33], s[5 * 33]); o.w = pk2(s[6 * 33], s[7 * 33]);
        *(u32x4*)(WT + (size_t)(n0 + n) * K + k0 + 8 * c) = o; }
    LDS_WAIT(); asm volatile("" ::: "memory");
}
__device__ __forceinline__ void phase_wconv(Frame& F, int l) {
    LAS float* scr = (LAS float*)(F.lds + F.wave * 16384);
    const int gw = F.bid * NWAVES + F.wave, NGW = F.G * NWAVES;
    constexpr int I_IN = (DM / 64) * (INC / 32), I_O = (DM / 64) * (DM / 32), I_1 = (DM / 64) * (DFF / 32), I_2 = (DFF / 64) * (DM / 32);
    const float* Win = F.ap->in[I_WIN] + (size_t)l * DM * INC; const float* Wout = F.ap->in[I_WOUT] + (size_t)l * DM * DM;
    const float* W1 = F.ap->in[I_W1] + (size_t)l * DM * DFF; const float* W2 = F.ap->in[I_W2] + (size_t)l * DFF * DM;
    for (int it = gw; it < I_IN + I_O + I_1 + I_2; it += NGW) {
        int r = it;
        if (r < I_IN) { transpose_item(Win, DM, INC, F.Win_t, scr, r, F.lane); continue; } r -= I_IN;
        if (r < I_O) { transpose_item(Wout, DM, DM, F.Wout_t, scr, r, F.lane); continue; } r -= I_O;
        if (r < I_1) { transpose_item(W1, DM, DFF, F.W1_t, scr, r, F.lane); continue; } r -= I_1;
        transpose_item(W2, DFF, DM, F.W2_t, scr, r, F.lane);
    }
    { u32x4* zp = (u32x4*)(F.Win_t + (size_t)INC * DM); const int n16 = (ZP - INC) * DM * 2 / 16;
      for (int i = F.bid * NTHR + F.tid; i < n16; i += F.G * NTHR) zp[i] = (u32x4){0u, 0u, 0u, 0u}; }
}

__device__ __forceinline__ void phase_norm(Frame& F, const float* src_lat, const float* src_ctx, const float* g, const float* modl, int shift_idx, int scale_idx, int Mrows) {
    const int gw = F.bid * NWAVES + F.wave, NGW = F.G * NWAVES;
    for (int m = gw; m < Mrows; m += NGW) {
        const float* xrow = m < ML ? src_lat + (size_t)m * DM : src_ctx + (size_t)(m - ML) * DM;
        const float* mv = modl + (size_t)mod_index(m) * 6144;
        const f32x4* xr = (const f32x4*)xrow + F.lane;
        f32x4 v[4]; float ss = 0.f;
#pragma unroll
        for (int j = 0; j < 4; ++j) { v[j] = xr[64 * j]; ss += (v[j].x * v[j].x + v[j].y * v[j].y) + (v[j].z * v[j].z + v[j].w * v[j].w); }
        const float r = rsqrtf(wave_sum(ss) * (1.f / DM) + 1e-6f);
        u32x2* o8 = (u32x2*)(F.A + (size_t)m * DM) + F.lane;
#pragma unroll
        for (int j = 0; j < 4; ++j) { const int col = 4 * F.lane + 256 * j;
            const f32x4 gg = *(const f32x4*)(g + col), sh = *(const f32x4*)(mv + shift_idx * 1024 + col), sc = *(const f32x4*)(mv + scale_idx * 1024 + col);
            const f32x4 y = v[j] * r * gg * (sc + 1.0f) + sh;
            u32x2 w; w.x = pk2(y.x, y.y); w.y = pk2(y.z, y.w); o8[64 * j] = w; }
    }
}
__device__ __forceinline__ void phase_final(Frame& F) {
    const int gw = F.bid * NWAVES + F.wave, NGW = F.G * NWAVES; const float* g = F.ap->in[I_FNG];
    for (int m = gw; m < ML; m += NGW) {
        f32x4* xr = (f32x4*)(F.out + (size_t)m * DM) + F.lane;
        f32x4 v[4]; float ss = 0.f;
#pragma unroll
        for (int j = 0; j < 4; ++j) { v[j] = xr[64 * j]; ss += (v[j].x * v[j].x + v[j].y * v[j].y) + (v[j].z * v[j].z + v[j].w * v[j].w); }
        const float r = rsqrtf(wave_sum(ss) * (1.f / DM) + 1e-6f);
#pragma unroll
        for (int j = 0; j < 4; ++j) { const f32x4 gg = *(const f32x4*)(g + 4 * F.lane + 256 * j); xr[64 * j] = v[j] * r * gg; }
    }
}

#ifndef SCAN_GLA_V0
#define SCAN_GLA_V0 0
#endif
__device__ __forceinline__ void gla_scan_block(Frame& F, int l, int chain) {
    constexpr int TS = 64;
    const int dir = chain & 1, h = (chain >> 1) & 3, b = chain >> 3;
    LAS float* q = (LAS float*)F.lds;
    LAS float* k = q + TS * 48; LAS float* g = k + TS * 48;
    LAS float* v = g + TS * 48;
    LAS float* y = v + TS * 96;
    const float* W2 = F.ap->in[I_GGW2] + (size_t)(l * 2 + dir) * 16 * 192 + h * 48; const float* Bg = F.ap->in[I_GGB] + (l * 2 + dir) * 192 + h * 48;
    const float qs = 0.14433756729740643f;
    float S[48];
#pragma unroll
    for (int j = 0; j < 48; ++j) S[j] = 0.f;
    for (int tile = 0; tile < SEQT / TS; ++tile) {
        const int sbase = tile * TS;
        for (int i = F.tid; i < TS * 48; i += NTHR) { const int st = i / 48, j = i % 48; const int m = seq_row(b, dir, sbase + st); const bf16_t* zr = F.Z + (size_t)m * ZP;
            q[i] = bf2f(zr[GLA_OFF + h * 48 + j]) * qs; k[i] = bf2f(zr[GLA_OFF + 192 + h * 48 + j]);
            float x = Bg[j];
#pragma unroll
            for (int r = 0; r < 16; ++r) x += bf2f(zr[GLA_OFF + 1152 + dir * 16 + r]) * W2[r * 192 + j];
            const float ls = fminf(x, 0.f) - log1pf(__expf(-fabsf(x)));
            g[i] = __expf(ls * (1.0f / 16.0f)); }
        for (int i = F.tid; i < TS * 96; i += NTHR) { const int st = i / 96, n = i % 96; const int m = seq_row(b, dir, sbase + st); v[i] = bf2f(F.Z[(size_t)m * ZP + GLA_OFF + 384 + h * 96 + n]); }
        __syncthreads();
        if (F.tid < 96) {
            for (int st = 0; st < TS; ++st) { const float vn = v[st * 96 + F.tid]; float o = 0.f;
#pragma unroll
                for (int j = 0; j < 48; ++j) { S[j] = S[j] * g[st * 48 + j] + k[st * 48 + j] * vn; o += q[st * 48 + j] * S[j]; }
                y[st * 96 + F.tid] = o; }
        }
        __syncthreads();
        for (int i = F.tid; i < TS * 96; i += NTHR) { const int st = i / 96, n = i % 96; const int m = seq_row(b, dir, sbase + st); const bf16_t o = f2bf(y[i]);
            if (dir == 0) F.A[(size_t)m * DM + h * 96 + n] = o; else F.Z[(size_t)m * ZP + YB_OFF + h * 96 + n] = o; }
        __syncthreads();
    }
}
typedef short bf16x8 __attribute__((ext_vector_type(8)));
__device__ __forceinline__ void rwkv_stage(const bf16_t* PREP, LAS float* vecb, LAS float* vvb, int b, int dir, int h, int quarter, int wsel, int sbase, int lt) {
    constexpr int TS = 32;
    const int st = lt >> 3, part = lt & 7; const int m = seq_row(b, dir, sbase + st);
    const bf16_t* src = PREP + (size_t)m * 384 + h * 64 + part * 8;
    u32x4 raw[5];
    raw[0] = *(const u32x4*)(src + (size_t)PR_KK * PREP_STRIDE); raw[1] = *(const u32x4*)(src + (size_t)wsel * PREP_STRIDE); raw[2] = *(const u32x4*)(src + (size_t)PR_B * PREP_STRIDE);
    raw[3] = *(const u32x4*)(src + (size_t)PR_K * PREP_STRIDE); raw[4] = *(const u32x4*)(src + (size_t)PR_R * PREP_STRIDE);
    bf16_t vraw[2];
#pragma unroll
    for (int q = 0; q < 2; ++q) { const int idx = lt + 256 * q, s2 = idx >> 4, rr = idx & 15; const int m2 = seq_row(b, dir, sbase + s2);
        vraw[q] = PREP[(size_t)PR_V * PREP_STRIDE + (size_t)m2 * 384 + h * 64 + quarter * 16 + rr]; }
#pragma unroll
    for (int vi = 0; vi < 5; ++vi) { const u32x4 r = raw[vi]; f32x4 lo, hi;
        lo.x = __uint_as_float(r.x << 16); lo.y = __uint_as_float(r.x & 0xffff0000u); lo.z = __uint_as_float(r.y << 16); lo.w = __uint_as_float(r.y & 0xffff0000u);
        hi.x = __uint_as_float(r.z << 16); hi.y = __uint_as_float(r.z & 0xffff0000u); hi.z = __uint_as_float(r.w << 16); hi.w = __uint_as_float(r.w & 0xffff0000u);
        if (vi == 1) { lo = 1.0f - lo; hi = 1.0f - hi; }
        LAS float* dst = vecb + (vi * TS + st) * 64 + part * 8; *(LAS f32x4*)dst = lo; *(LAS f32x4*)(dst + 4) = hi; }
#pragma unroll
    for (int q = 0; q < 2; ++q) { const int idx = lt + 256 * q; vvb[idx] = bf2f(vraw[q]); }
}
__device__ __forceinline__ void rwkv_flush(bf16_t* A, bf16_t* Z, const LAS float* ybb, int b, int dir, int h, int quarter, int sbase, int lt) {
#pragma unroll
    for (int q = 0; q < 2; ++q) { const int idx = lt + 256 * q, st = idx >> 4, rr = idx & 15; const int m = seq_row(b, dir, sbase + st);
        const bf16_t o = f2bf(ybb[idx]);
        if (dir == 0) A[(size_t)m * DM + 384 + h * 64 + quarter * 16 + rr] = o; else Z[(size_t)m * ZP + YB_OFF + 384 + h * 64 + quarter * 16 + rr] = o; }
}
__device__ __forceinline__ void rwkv_scan_block(Frame& F, int chain, int quarter) {
    constexpr int TS = 32, NT = SEQT / TS;
    const int dir = chain & 1, h = (chain >> 1) % 6, b = (chain >> 1) / 6;
    LAS float* vec = (LAS float*)F.lds;
    LAS float* vv = vec + 2 * 5 * TS * 64;
    LAS float* yb = vv + 2 * TS * 16;
    const bool comp = F.wave < 4;
    const int rg = F.lane >> 4, lrow = (F.wave & 3) * 4 + rg, lt = F.tid - 256; int cgp = F.lane & 15;
    const int wsel = dir ? PR_WB : PR_WF;
    f32x2 sA = {0.f, 0.f}, sB = {0.f, 0.f};
    if (!comp) rwkv_stage(F.PREP, vec, vv, b, dir, h, quarter, wsel, 0, lt);
    __syncthreads();
    for (int tile = 0; tile < NT; ++tile) {
        const int cur = tile & 1;
        if (comp) {
            asm volatile("" : "+v"(cgp));
            const LAS float* vb = vec + cur * 5 * TS * 64 + cgp * 4; const LAS float* vvb = vv + cur * TS * 16 + lrow; LAS float* ybb = yb + cur * TS * 16;
            f32x4 kk_n = *(const LAS f32x4*)(vb + (0 * TS) * 64), w_n = *(const LAS f32x4*)(vb + (1 * TS) * 64), b_n = *(const LAS f32x4*)(vb + (2 * TS) * 64);
            f32x4 k_n = *(const LAS f32x4*)(vb + (3 * TS) * 64), r_n = *(const LAS f32x4*)(vb + (4 * TS) * 64); float v_n = vvb[0];
            float ypart = 0.f, yacc = 0.f;
#pragma unroll
            for (int st = 0; st < TS; ++st) {
                const f32x4 kk4 = kk_n, w4 = w_n, b4 = b_n, k4 = k_n, r4 = r_n; const float vr = v_n;
                if (st + 1 < TS) { kk_n = *(const LAS f32x4*)(vb + (0 * TS + st + 1) * 64); w_n = *(const LAS f32x4*)(vb + (1 * TS + st + 1) * 64); b_n = *(const LAS f32x4*)(vb + (2 * TS + st + 1) * 64);
                    k_n = *(const LAS f32x4*)(vb + (3 * TS + st + 1) * 64); r_n = *(const LAS f32x4*)(vb + (4 * TS + st + 1) * 64); v_n = vvb[(st + 1) * 16]; }
                const f32x2 p2 = sA * kk4.xy + sB * kk4.zw; float p = p2.x + p2.y;
                sA = sA * w4.xy + k4.xy * vr; sB = sB * w4.zw + k4.zw * vr;
                float yq = ypart;
                p += dpp_mov<0xB1>(p); yq += dpp_mov<0xB1>(yq);
                p += dpp_mov<0x4E>(p); yq += dpp_mov<0x4E>(yq);
                p += dpp_mov<0x141>(p); yq += dpp_mov<0x141>(yq);
                p += dpp_mov<0x140>(p); yq += dpp_mov<0x140>(yq);
                if (st > 0) { if (((st - 1) & 15) == 0) yacc = 0.f; yacc = (cgp == ((st - 1) & 15)) ? yq : yacc; if (((st - 1) & 15) == 15) ybb[((st - 1) & ~15) * 16 + cgp * 16 + lrow] = yacc; }
                sA = sA - b4.xy * p; sB = sB - b4.zw * p;
                const f32x2 y2 = sA * r4.xy + sB * r4.zw; ypart = y2.x + y2.y;
            }
            { float yq = reduce16(ypart); yacc = (cgp == 15) ? yq : yacc; ybb[16 * 16 + cgp * 16 + lrow] = yacc; }
        } else {
            if (tile + 1 < NT) rwkv_stage(F.PREP, vec + (cur ^ 1) * 5 * TS * 64, vv + (cur ^ 1) * TS * 16, b, dir, h, quarter, wsel, (tile + 1) * TS, lt);
            if (tile > 0) rwkv_flush(F.A, F.Z, yb + (cur ^ 1) * TS * 16, b, dir, h, quarter, (tile - 1) * TS, lt);
        }
        __syncthreads();
    }
    if (!comp) rwkv_flush(F.A, F.Z, yb + ((NT - 1) & 1) * TS * 16, b, dir, h, quarter, (NT - 1) * TS, lt);
}

namespace ce {
constexpr int PITCH = 72, IMG = 64 * PITCH * 2;
constexpr int VTB = 96 * PITCH * 2;
constexpr int O_QG = 0, O_KG = 2 * IMG, O_KET = 4 * IMG, O_VT = 6 * IMG, O_PB = O_VT + 2 * VTB, O_ST = O_PB + IMG, O_DEC = O_ST + 2 * VTB, O_WSUM = O_DEC + 512, O_END = O_WSUM + 8 * 48 * 4, O_W2 = O_END, O_END2 = O_W2 + 17 * 48 * 4;
static_assert(O_END2 <= 131072, "chunk engine LDS");
__device__ __forceinline__ bf16x8 frag(const LAS unsigned char* img, int row, int col) { return *(const LAS bf16x8*)(img + (row * PITCH + col) * 2); }
__device__ __forceinline__ void st4(LAS unsigned char* img, int row, int col, f32x4 v) { u32x2 w; w.x = pk2(v.x, v.y); w.y = pk2(v.z, v.w); *(LAS u32x2*)(img + (row * PITCH + col) * 2) = w; }
__device__ __forceinline__ f32x2 up2(unsigned u) { f32x2 r; r.x = __uint_as_float(u << 16); r.y = __uint_as_float(u & 0xffff0000u); return r; }

template <int DV> __device__ __forceinline__ void chunk_mma(Frame& F, LAS unsigned char* L, int cb, int sb, f32x4 (&acc_s)[DV / 32], int b, int dir, int cs, int ycol0) {
    constexpr int NQ = DV / 32;
    const int lane = F.lane, w = F.wave, lr = lane & 15, lq = lane >> 4;
    LAS unsigned char* Qg = L + O_QG + cb * IMG; LAS unsigned char* Kg = L + O_KG + cb * IMG; LAS unsigned char* KeT = L + O_KET + cb * IMG;
    LAS unsigned char* Vt = L + O_VT + cb * VTB; LAS unsigned char* Pb = L + O_PB; LAS unsigned char* St = L + O_ST + sb * VTB; LAS unsigned char* Sn = L + O_ST + (sb ^ 1) * VTB;
    const LAS float* dec = (const LAS float*)(L + O_DEC + cb * 256);
#pragma unroll
    for (int q = 0; q < 2; ++q) { const int idx = w + 8 * q; if (idx < 10) {
            const int jt = idx < 4 ? 0 : idx < 7 ? 1 : idx < 9 ? 2 : 3; const int it = idx < 4 ? idx : idx < 7 ? idx - 3 : idx < 9 ? idx - 5 : 3;
            f32x4 acc = {0.f, 0.f, 0.f, 0.f};
#pragma unroll
            for (int ks = 0; ks < 2; ++ks) acc = __builtin_amdgcn_mfma_f32_16x16x32_bf16(frag(Kg, jt * 16 + lr, 32 * ks + 8 * lq), frag(Qg, it * 16 + lr, 32 * ks + 8 * lq), acc, 0, 0, 0);
            if (jt == it) {
#pragma unroll
                for (int r = 0; r < 4; ++r) if (4 * lq + r > lr) acc[r] = 0.f; }
            st4(Pb, it * 16 + lr, jt * 16 + 4 * lq, acc); } }
    __syncthreads();
#pragma unroll
    for (int q = 0; q < NQ; ++q) { const int id = w + 8 * q, nt = id >> 2, it = id & 3;
        f32x4 acc = {0.f, 0.f, 0.f, 0.f};
#pragma unroll
        for (int ks = 0; ks < 2; ++ks) acc = __builtin_amdgcn_mfma_f32_16x16x32_bf16(frag(St, nt * 16 + lr, 32 * ks + 8 * lq), frag(Qg, it * 16 + lr, 32 * ks + 8 * lq), acc, 0, 0, 0);
#pragma unroll
        for (int ks = 0; ks < 2; ++ks) acc = __builtin_amdgcn_mfma_f32_16x16x32_bf16(frag(Vt, nt * 16 + lr, 32 * ks + 8 * lq), frag(Pb, it * 16 + lr, 32 * ks + 8 * lq), acc, 0, 0, 0);
        const int m = seq_row(b, dir, cs * 64 + it * 16 + lr); const int col = ycol0 + nt * 16 + 4 * lq;
        u32x2 o; o.x = pk2(acc.x, acc.y); o.y = pk2(acc.z, acc.w);
        if (dir == 0) *(u32x2*)(F.A + (size_t)m * DM + col) = o; else *(u32x2*)(F.Z + (size_t)m * ZP + YB_OFF + col) = o; }
#pragma unroll
    for (int q = 0; q < NQ; ++q) { const int id = w + 8 * q, kt = id & 3, nt = id >> 2;
        const f32x4 d4 = *(const LAS f32x4*)(dec + kt * 16 + 4 * lq);
        f32x4 acc = acc_s[q] * d4;
#pragma unroll
        for (int ks = 0; ks < 2; ++ks) acc = __builtin_amdgcn_mfma_f32_16x16x32_bf16(frag(KeT, kt * 16 + lr, 32 * ks + 8 * lq), frag(Vt, nt * 16 + lr, 32 * ks + 8 * lq), acc, 0, 0, 0);
        acc_s[q] = acc;
        st4(Sn, nt * 16 + lr, kt * 16 + 4 * lq, acc); }
}

__device__ __forceinline__ void ret_chain(Frame& F, int l, int chain) {
    constexpr int DV = 64, NCH = SEQT / 64;
    const int dir = chain & 1, h = (chain >> 1) & 3, b = chain >> 3;
    LAS unsigned char* L = F.lds;
    const int tp = F.tid >> 4, jj = F.tid & 15, t0 = 2 * tp, t1 = t0 + 1;
    const float lgam = -__expf(F.ap->in[I_RETLR][(l * 2 + dir) * 4 + h]);
    float eq[2], ek[2], ee[2];
#pragma unroll
    for (int e = 0; e < 2; ++e) { const float G = (float)(t0 + e + 1) * lgam; eq[e] = __expf(G); ek[e] = 0.125f * __expf(-G); ee[e] = 0.125f * __expf(64.0f * lgam - G); }
    const int d0 = 2 * jj;
    const bool rowb = d0 < 16; float inv[2];
#pragma unroll
    for (int e = 0; e < 2; ++e) inv[e] = powf(10000.0f, -(float)((d0 + e) & 15) * (1.0f / 16.0f));
    float ccs[2][2], csn[2][2];
#pragma unroll
    for (int tk = 0; tk < 2; ++tk)
#pragma unroll
        for (int e = 0; e < 2; ++e) { const float pos = (float)(dir ? 63 - (t0 + tk) : (t0 + tk)); sincosf(pos * inv[e], &csn[tk][e], &ccs[tk][e]); }
    for (int i = F.tid; i < IMG / 4; i += NTHR) ((LAS unsigned*)(L + O_PB))[i] = 0u;
    for (int i = F.tid; i < VTB / 4; i += NTHR) ((LAS unsigned*)(L + O_ST))[i] = 0u;
    if (F.tid < 128) ((LAS float*)(L + O_DEC))[F.tid] = __expf(64.0f * lgam);
    f32x4 acc_s[DV / 32];
#pragma unroll
    for (int q = 0; q < DV / 32; ++q) acc_s[q] = (f32x4){0.f, 0.f, 0.f, 0.f};
    unsigned rq[2][2], rk[2][2], rv[2][2];
    const bf16_t* Zc = F.Z + RET_OFF + h * 64 + d0;
#define RET_LOAD(cs_) do { _Pragma("unroll") for (int tk = 0; tk < 2; ++tk) { const int m = seq_row(b, dir, (cs_) * 64 + t0 + tk); const bf16_t* zr = Zc + (size_t)m * ZP; \
        rq[tk][0] = *(const unsigned*)(zr); rq[tk][1] = *(const unsigned*)(zr + 32); rk[tk][0] = *(const unsigned*)(zr + 256); rk[tk][1] = *(const unsigned*)(zr + 288); \
        rv[tk][0] = *(const unsigned*)(zr + 512); rv[tk][1] = *(const unsigned*)(zr + 544); } } while (0)
#define RET_STAGE(cs_, cb_) do { \
        LAS unsigned char* Qg = L + O_QG + (cb_) * IMG; LAS unsigned char* Kg = L + O_KG + (cb_) * IMG; LAS unsigned char* KeT = L + O_KET + (cb_) * IMG; LAS unsigned char* Vt = L + O_VT + (cb_) * VTB; \
        const bool lat = (cs_) >= 4; float rc[2] = {1.f, 1.f}, rs[2] = {0.f, 0.f}; \
        if (lat && rowb) { const float row = (float)(dir ? 127 - ((cs_) - 4) : (cs_) - 4); _Pragma("unroll") for (int e = 0; e < 2; ++e) { rs[e] = __sinf(row * inv[e]); rc[e] = __cosf(row * inv[e]); } } \
        f32x2 ke_lo[2], ke_hi[2], v_lo[2], v_hi[2]; \
        _Pragma("unroll") for (int tk = 0; tk < 2; ++tk) { \
            f32x2 q1 = up2(rq[tk][0]), q2 = up2(rq[tk][1]), k1 = up2(rk[tk][0]), k2 = up2(rk[tk][1]); \
            f32x2 c, s; if (rowb) { c.x = rc[0]; c.y = rc[1]; s.x = rs[0]; s.y = rs[1]; } else { c.x = lat ? ccs[tk][0] : 1.f; c.y = lat ? ccs[tk][1] : 1.f; s.x = lat ? csn[tk][0] : 0.f; s.y = lat ? csn[tk][1] : 0.f; } \
            const f32x2 qa = q1 * c - q2 * s, qb = q1 * s + q2 * c, ka = k1 * c - k2 * s, kb = k1 * s + k2 * c; \
            const int t = t0 + tk; \
            *(LAS unsigned*)(Qg + (t * PITCH + d0) * 2) = pk2(qa.x * eq[tk], qa.y * eq[tk]); *(LAS unsigned*)(Qg + (t * PITCH + d0 + 32) * 2) = pk2(qb.x * eq[tk], qb.y * eq[tk]); \
            *(LAS unsigned*)(Kg + (t * PITCH + d0) * 2) = pk2(ka.x * ek[tk], ka.y * ek[tk]); *(LAS unsigned*)(Kg + (t * PITCH + d0 + 32) * 2) = pk2(kb.x * ek[tk], kb.y * ek[tk]); \
            ke_lo[tk] = ka * ee[tk]; ke_hi[tk] = kb * ee[tk]; v_lo[tk] = up2(rv[tk][0]); v_hi[tk] = up2(rv[tk][1]); } \
        *(LAS unsigned*)(KeT + ((d0) * PITCH + t0) * 2) = pk2(ke_lo[0].x, ke_lo[1].x); *(LAS unsigned*)(KeT + ((d0 + 1) * PITCH + t0) * 2) = pk2(ke_lo[0].y, ke_lo[1].y); \
        *(LAS unsigned*)(KeT + ((d0 + 32) * PITCH + t0) * 2) = pk2(ke_hi[0].x, ke_hi[1].x); *(LAS unsigned*)(KeT + ((d0 + 33) * PITCH + t0) * 2) = pk2(ke_hi[0].y, ke_hi[1].y); \
        *(LAS unsigned*)(Vt + ((d0) * PITCH + t0) * 2) = pk2(v_lo[0].x, v_lo[1].x); *(LAS unsigned*)(Vt + ((d0 + 1) * PITCH + t0) * 2) = pk2(v_lo[0].y, v_lo[1].y); \
        *(LAS unsigned*)(Vt + ((d0 + 32) * PITCH + t0) * 2) = pk2(v_hi[0].x, v_hi[1].x); *(LAS unsigned*)(Vt + ((d0 + 33) * PITCH + t0) * 2) = pk2(v_hi[0].y, v_hi[1].y); \
    } while (0)
    RET_LOAD(0); RET_STAGE(0, 0);
    __syncthreads();
    for (int cs = 0; cs < NCH; ++cs) { const int cb = cs & 1;
        if (cs + 1 < NCH) RET_LOAD(cs + 1);
        chunk_mma<DV>(F, L, cb, cb, acc_s, b, dir, cs, 768 + h * 64);
        if (cs + 1 < NCH) RET_STAGE(cs + 1, cb ^ 1);
        __syncthreads();
    }
#undef RET_LOAD
#undef RET_STAGE
}

__device__ __forceinline__ void gla_chain(Frame& F, int l, int chain) {
    constexpr int DV = 96, NCH = SEQT / 64;
    const int dir = chain & 1, h = (chain >> 1) & 3, b = chain >> 3;
    LAS unsigned char* L = F.lds;
    const int t = F.tid >> 3, j8 = F.tid & 7, d0 = 2 * j8;
    const float qs = 0.14433756729740643f;
    for (int i = F.tid; i < O_END / 4; i += NTHR) ((LAS unsigned*)L)[i] = 0u;
    f32x4 acc_s[DV / 32];
#pragma unroll
    for (int q = 0; q < DV / 32; ++q) acc_s[q] = (f32x4){0.f, 0.f, 0.f, 0.f};
    unsigned rq[3], rk[3], rv[6]; f32x2 rg[3], rge[3];
    const bf16_t* Zc = F.Z + GLA_OFF + h * 48 + d0;
#define GLA_GP(m_) ((dir == 0 ? (const float*)(F.A + (size_t)(m_) * DM) : (const float*)(F.Z + (size_t)(m_) * ZP + YB_OFF)) + h * 48 + d0)
#define GLA_LOAD(cs_) do { const int m = seq_row(b, dir, (cs_) * 64 + t); const bf16_t* zr = Zc + (size_t)m * ZP; const bf16_t* zv = F.Z + (size_t)m * ZP + GLA_OFF + 384 + h * 96 + d0; \
        _Pragma("unroll") for (int q = 0; q < 3; ++q) { rq[q] = *(const unsigned*)(zr + 16 * q); rk[q] = *(const unsigned*)(zr + 192 + 16 * q); } \
        _Pragma("unroll") for (int q = 0; q < 6; ++q) rv[q] = *(const unsigned*)(zv + 16 * q); \
        const float* gp = GLA_GP(m); const float* ge = GLA_GP(seq_row(b, dir, (cs_) * 64 + 63)); \
        _Pragma("unroll") for (int q = 0; q < 3; ++q) { rg[q] = *(const f32x2*)(gp + 16 * q); rge[q] = *(const f32x2*)(ge + 16 * q); } } while (0)
#define GLA_STAGE(cs_, cb_) do { \
        LAS unsigned char* Qg = L + O_QG + (cb_) * IMG; LAS unsigned char* Kg = L + O_KG + (cb_) * IMG; LAS unsigned char* KeT = L + O_KET + (cb_) * IMG; LAS unsigned char* Vt = L + O_VT + (cb_) * VTB; \
        if (t == 0) { _Pragma("unroll") for (int q = 0; q < 3; ++q) *(LAS f32x2*)((LAS float*)(L + O_DEC + (cb_) * 256) + d0 + 16 * q) = (f32x2){__expf(rge[q].x), __expf(rge[q].y)}; } \
        _Pragma("unroll") for (int q = 0; q < 3; ++q) { const f32x2 qv = up2(rq[q]), kv = up2(rk[q]); const int d = d0 + 16 * q; const float g0 = rg[q].x, g1 = rg[q].y; \
            const float eq0 = __expf(g0) * qs, eq1 = __expf(g1) * qs, ek0 = __expf(-g0), ek1 = __expf(-g1), ee0 = __expf(rge[q].x - g0), ee1 = __expf(rge[q].y - g1); \
            *(LAS unsigned*)(Qg + (t * PITCH + d) * 2) = pk2(qv.x * eq0, qv.y * eq1); *(LAS unsigned*)(Kg + (t * PITCH + d) * 2) = pk2(kv.x * ek0, kv.y * ek1); \
            *(LAS bf16_t*)(KeT + (d * PITCH + t) * 2) = f2bf(kv.x * ee0); *(LAS bf16_t*)(KeT + ((d + 1) * PITCH + t) * 2) = f2bf(kv.y * ee1); } \
        _Pragma("unroll") for (int q = 0; q < 6; ++q) { const int d = d0 + 16 * q; *(LAS bf16_t*)(Vt + (d * PITCH + t) * 2) = (bf16_t)(rv[q] & 0xffffu); *(LAS bf16_t*)(Vt + ((d + 1) * PITCH + t) * 2) = (bf16_t)(rv[q] >> 16); } \
    } while (0)
    __syncthreads();
    GLA_LOAD(0); GLA_STAGE(0, 0);
    __syncthreads();
    for (int cs = 0; cs < NCH; ++cs) { const int cb = cs & 1;
        if (cs + 1 < NCH) GLA_LOAD(cs + 1);
        chunk_mma<DV>(F, L, cb, cb, acc_s, b, dir, cs, h * 96);
        if (cs + 1 < NCH) GLA_STAGE(cs + 1, cb ^ 1);
        __syncthreads();
    }
#undef GLA_LOAD
#undef GLA_STAGE
#undef GLA_GP
}
}

#ifndef PROBE_DUP
#define PROBE_DUP 0
#endif
__device__ __forceinline__ void phase_scan(Frame& F, int l) {
    for (int task = F.bid; task < 256; task += F.G) {
        if ((PROBE_DUP & 32) && task < 192) { rwkv_scan_block(F, task >> 2, task & 3); __syncthreads(); }
        if ((PROBE_DUP & 64) && task >= 192 && task < 224) { ce::gla_chain(F, l, task - 192); __syncthreads(); }
        if ((PROBE_DUP & 128) && task >= 224) { ce::ret_chain(F, l, task - 224); __syncthreads(); }
        if (task < 192) rwkv_scan_block(F, task >> 2, task & 3);
        else if (task < 224) {
#if SCAN_GLA_V0
            gla_scan_block(F, l, task - 192);
#else
            ce::gla_chain(F, l, task - 192);
#endif
        } else ce::ret_chain(F, l, task - 224);
        __syncthreads();
    }
}
namespace pp {
constexpr int OSP = 392;
__device__ __forceinline__ bf16x8 pack8(const float (&w)[8]) { u32x4 u; u.x = pk2(w[0], w[1]); u.y = pk2(w[2], w[3]); u.z = pk2(w[4], w[5]); u.w = pk2(w[6], w[7]); return __builtin_bit_cast(bf16x8, u); }
__device__ __forceinline__ void unpack8(u32x4 r, float (&o)[8]) {
    o[0] = __uint_as_float(r.x << 16); o[1] = __uint_as_float(r.x & 0xffff0000u); o[2] = __uint_as_float(r.y << 16); o[3] = __uint_as_float(r.y & 0xffff0000u);
    o[4] = __uint_as_float(r.z << 16); o[5] = __uint_as_float(r.z & 0xffff0000u); o[6] = __uint_as_float(r.w << 16); o[7] = __uint_as_float(r.w & 0xffff0000u); }
__device__ __forceinline__ u32x4 pack8u(const float (&w)[8]) { u32x4 u; u.x = pk2(w[0], w[1]); u.y = pk2(w[2], w[3]); u.z = pk2(w[4], w[5]); u.w = pk2(w[6], w[7]); return u; }
__device__ __forceinline__ void shift8(const bf16_t* p, const ZNb& n, const float* mu8  , float (&o)[8]) {
    const u32x4 c = *(const u32x4*)p, n0 = *(const u32x4*)(p + n.o[0]), n1 = *(const u32x4*)(p + n.o[1]), n2 = *(const u32x4*)(p + n.o[2]), n3 = *(const u32x4*)(p + n.o[3]);
    float zc[8], a0[8], a1[8], a2[8], a3[8]; unpack8(c, zc); unpack8(n0, a0); unpack8(n1, a1); unpack8(n2, a2); unpack8(n3, a3);
#pragma unroll
    for (int e = 0; e < 8; ++e) { const float nb = (a0[e] * n.w[0] + a1[e] * n.w[1]) + (a2[e] * n.w[2] + a3[e] * n.w[3]); o[e] = zc[e] + mu8[e] * (nb - zc[e]); }
}

__device__ __forceinline__ void phase_prep(Frame& F, int l) {
    constexpr int ZSP = 488;
    LAS unsigned char* L = F.lds;
    LAS bf16_t* zs = (LAS bf16_t*)L;
    LAS bf16_t* os = (LAS bf16_t*)(L + 16 * ZSP * 2);
    LAS float* mus = (LAS float*)(L + 16 * ZSP * 2 + 5 * 16 * OSP * 2);
    const float* mu = F.ap->in[I_RMU] + l * 1312;
    for (int i = F.tid; i < 1248; i += NTHR) mus[i] = mu[i];
    const int lr = F.lane & 15, lq = F.lane >> 4, h = F.wave;
    bf16x8 Bf[4], Bb[4], Ba[4]; float w0f[4], w0b[4], a0[4], kk_[4], ka_[4];
    if (h < 6) {
#pragma unroll
        for (int nt = 0; nt < 4; ++nt) { const int col = h * 64 + 16 * nt + lr; float t0[8], t1[8], t2[8];
#pragma unroll
            for (int j = 0; j < 8; ++j) { const int k = 8 * lq + j; t0[j] = F.ap->in[I_RW2][((size_t)(l * 2 + 0) * 32 + k) * 384 + col]; t1[j] = F.ap->in[I_RW2][((size_t)(l * 2 + 1) * 32 + k) * 384 + col]; t2[j] = F.ap->in[I_RA2][((size_t)l * 32 + k) * 384 + col]; }
            Bf[nt] = pack8(t0); Bb[nt] = pack8(t1); Ba[nt] = pack8(t2);
            w0f[nt] = F.ap->in[I_RW0][(l * 2 + 0) * 384 + col]; w0b[nt] = F.ap->in[I_RW0][(l * 2 + 1) * 384 + col]; a0[nt] = F.ap->in[I_RA0][l * 384 + col];
            kk_[nt] = F.ap->in[I_RKK][l * 384 + col]; ka_[nt] = F.ap->in[I_RKA][l * 384 + col]; }
    }
    __syncthreads();
    for (int it = F.bid; it < MT / 16; it += F.G) {
        const int m0 = it * 16;
        for (int p = F.tid; p < 16 * 156; p += NTHR) { const int tok = p / 156, gi = p - tok * 156, col0 = gi * 8, m = m0 + tok;
            const ZNb nbv = znb(m); float o[8]; float mu8[8];
#pragma unroll
            for (int e = 0; e < 8; ++e) mu8[e] = mus[col0 + e];
            shift8(F.Z + (size_t)m * ZP + RW_OFF + col0, nbv, mu8, o);
            if (col0 < 384) *(u32x4*)(F.PREP + PR_R * PREP_STRIDE + (size_t)m * 384 + col0) = pack8u(o);
            else if (col0 < 768) *(LAS u32x4*)(zs + tok * ZSP + (col0 - 384)) = pack8u(o);
            else if (col0 < 1152) *(u32x4*)(F.PREP + PR_V * PREP_STRIDE + (size_t)m * 384 + (col0 - 768)) = pack8u(o);
            else { if (col0 < 1216) {
#pragma unroll
                    for (int e = 0; e < 8; ++e) o[e] = fast_tanh(o[e]); }
                *(LAS u32x4*)(zs + tok * ZSP + 384 + (col0 - 1152)) = pack8u(o); }
        }
        __syncthreads();
        if (h < 6) {
            const bf16x8 af = *(const LAS bf16x8*)(zs + lr * ZSP + 384 + 8 * lq), ab = *(const LAS bf16x8*)(zs + lr * ZSP + 416 + 8 * lq), aa = *(const LAS bf16x8*)(zs + lr * ZSP + 448 + 8 * lq);
            float kv[4][4], kkv[4][4], av[4][4]; float ss[4] = {0.f, 0.f, 0.f, 0.f};
#pragma unroll
            for (int nt = 0; nt < 4; ++nt) { const f32x4 z4 = {0.f, 0.f, 0.f, 0.f};
                const f32x4 xf = __builtin_amdgcn_mfma_f32_16x16x32_bf16(af, Bf[nt], z4, 0, 0, 0), xb = __builtin_amdgcn_mfma_f32_16x16x32_bf16(ab, Bb[nt], z4, 0, 0, 0), xa = __builtin_amdgcn_mfma_f32_16x16x32_bf16(aa, Ba[nt], z4, 0, 0, 0);
                const int cl = h * 64 + 16 * nt + lr;
#pragma unroll
                for (int r = 0; r < 4; ++r) { const int tok = 4 * lq + r;
                    const float k = bf2f(zs[tok * ZSP + cl]);
                    const float ef = sigmoidf_(xf[r] + w0f[nt]) * 0.6065306597f, eb = sigmoidf_(xb[r] + w0b[nt]) * 0.6065306597f;
                    os[(0 * 16 + tok) * OSP + cl] = f2bf(1.0f - __expf(-ef)); os[(1 * 16 + tok) * OSP + cl] = f2bf(1.0f - __expf(-eb));
                    const float a = sigmoidf_(xa[r] + a0[nt]); const float kx = k * kk_[nt];
                    kv[nt][r] = k; kkv[nt][r] = kx; av[nt][r] = a; ss[r] += kx * kx; } }
#pragma unroll
            for (int r = 0; r < 4; ++r) ss[r] = rsqrtf(reduce16(ss[r]) + 1e-12f);
#pragma unroll
            for (int nt = 0; nt < 4; ++nt) { const int cl = h * 64 + 16 * nt + lr;
#pragma unroll
                for (int r = 0; r < 4; ++r) { const int tok = 4 * lq + r; const float kk = kkv[nt][r] * ss[r], a = av[nt][r];
                    os[(2 * 16 + tok) * OSP + cl] = f2bf(kv[nt][r] * (1.f + (a - 1.f) * ka_[nt])); os[(3 * 16 + tok) * OSP + cl] = f2bf(kk); os[(4 * 16 + tok) * OSP + cl] = f2bf(kk * a); } }
        }
        __syncthreads();
        for (int p = F.tid; p < 5 * 16 * 48; p += NTHR) { const int t = p / 768, rem = p - t * 768, tok = rem / 48, pc = rem - tok * 48;
            const int ts = t == 0 ? PR_WF : t == 1 ? PR_WB : t == 2 ? PR_K : t == 3 ? PR_KK : PR_B;
            *(u32x4*)(F.PREP + (size_t)ts * PREP_STRIDE + (size_t)(m0 + tok) * 384 + pc * 8) = *(const LAS u32x4*)(os + (t * 16 + tok) * OSP + pc * 8); }
    }
}

__device__ __forceinline__ void gla_gate_units(Frame& F, int l) {
    LAS float* lrs = (LAS float*)F.lds;
    LAS float* qsum = lrs + 64 * 16;
    const int dp = F.tid % 96, tq = F.tid / 96;
    for (int it = F.bid; it < NB * 2 * (SEQT / 64); it += F.G) {
        const int b = it / (2 * (SEQT / 64)), rem = it - b * (2 * (SEQT / 64)), dir = rem / (SEQT / 64), cs = rem - dir * (SEQT / 64);
#pragma unroll
        for (int q = 0; q < 2; ++q) { const int idx = F.tid + NTHR * q, tok = idx >> 4, r = idx & 15; const int m = seq_row(b, dir, cs * 64 + tok);
            lrs[idx] = bf2f(F.Z[(size_t)m * ZP + GLA_OFF + 1152 + dir * 16 + r]); }
        f32x2 w[16], bias = {0.f, 0.f};
        if (tq < 4) { const float* W2 = F.ap->in[I_GGW2] + (size_t)(l * 2 + dir) * 16 * 192 + 2 * dp;
#pragma unroll
            for (int r = 0; r < 16; ++r) w[r] = *(const f32x2*)(W2 + r * 192);
            bias = *(const f32x2*)(F.ap->in[I_GGB] + (l * 2 + dir) * 192 + 2 * dp); }
        __syncthreads();
        f32x2 Gv[16]; f32x2 run = {0.f, 0.f};
        if (tq < 4) {
#pragma unroll
            for (int i = 0; i < 16; ++i) { const LAS float* lp = lrs + (tq * 16 + i) * 16; f32x2 x = bias;
#pragma unroll
                for (int r = 0; r < 16; ++r) x += w[r] * lp[r];
                f32x2 ls; ls.x = (fminf(x.x, 0.f) - __logf(1.0f + __expf(-fabsf(x.x)))) * (1.0f / 16.0f); ls.y = (fminf(x.y, 0.f) - __logf(1.0f + __expf(-fabsf(x.y)))) * (1.0f / 16.0f);
                run += ls; Gv[i] = run; }
            *(LAS f32x2*)(qsum + tq * 192 + 2 * dp) = run;
        }
        __syncthreads();
        if (tq < 4) { f32x2 off = {0.f, 0.f};
#pragma unroll
            for (int q = 0; q < 3; ++q) if (q < tq) off += *(const LAS f32x2*)(qsum + q * 192 + 2 * dp);
#pragma unroll
            for (int i = 0; i < 16; ++i) { const int m = seq_row(b, dir, cs * 64 + tq * 16 + i);
                float* dst = (dir == 0 ? (float*)(F.A + (size_t)m * DM) : (float*)(F.Z + (size_t)m * ZP + YB_OFF)) + 2 * dp;
                *(f32x2*)dst = Gv[i] + off; }
        }
    }
}

__device__ __forceinline__ void phase_post(Frame& F, int l, int Mrows) {
    constexpr int SGP = 72;
    LAS unsigned char* L = F.lds;
    LAS bf16_t* in5 = (LAS bf16_t*)L;
    LAS bf16_t* sgs = (LAS bf16_t*)(L + 5 * 16 * OSP * 2);
    LAS bf16_t* outs = (LAS bf16_t*)(L + 5 * 16 * OSP * 2 + 16 * SGP * 2);
    const float* mu = F.ap->in[I_RMU] + l * 1312 + 1248;
    const int lr = F.lane & 15, lq = F.lane >> 4, h = F.wave;
    bf16x8 Bg[4][2]; float lng[4], lnb[4], rk[4];
    if (h < 6) {
#pragma unroll
        for (int nt = 0; nt < 4; ++nt) { const int col = h * 64 + 16 * nt + lr;
#pragma unroll
            for (int ks = 0; ks < 2; ++ks) { float t0[8];
#pragma unroll
                for (int j = 0; j < 8; ++j) t0[j] = F.ap->in[I_RG2][((size_t)l * 64 + 32 * ks + 8 * lq + j) * 384 + col];
                Bg[nt][ks] = pack8(t0); }
            lng[nt] = F.ap->in[I_RLNG][l * 384 + col]; lnb[nt] = F.ap->in[I_RLNB][l * 384 + col]; rk[nt] = F.ap->in[I_RRK][l * 384 + col]; }
    }
    for (int it = F.bid; it < Mrows / 16; it += F.G) {
        const int m0 = it * 16;
        for (int p = F.tid; p < 5 * 16 * 48; p += NTHR) { const int t = p / 768, rem = p - t * 768, tok = rem / 48, pc = rem - tok * 48; const int m = m0 + tok;
            const bf16_t* src = t == 0 ? F.A + (size_t)m * DM + 384 + pc * 8 : t == 1 ? F.Z + (size_t)m * ZP + YB_OFF + 384 + pc * 8
                              : F.PREP + (size_t)(t == 2 ? PR_R : t == 3 ? PR_K : PR_V) * PREP_STRIDE + (size_t)m * 384 + pc * 8;
            *(LAS u32x4*)(in5 + (t * 16 + tok) * OSP + pc * 8) = *(const u32x4*)src; }
        if (F.tid < 128) { const int tok = F.tid >> 3, gi = F.tid & 7, m = m0 + tok; const ZNb nbv = znb(m); float o[8], mu8[8];
#pragma unroll
            for (int e = 0; e < 8; ++e) mu8[e] = mu[gi * 8 + e];
            shift8(F.Z + (size_t)m * ZP + RW_OFF + 1248 + gi * 8, nbv, mu8, o);
#pragma unroll
            for (int e = 0; e < 8; ++e) o[e] = sigmoidf_(o[e]);
            *(LAS u32x4*)(sgs + tok * SGP + gi * 8) = pack8u(o); }
        __syncthreads();
        if (h < 6) {
            const bf16x8 a0 = *(const LAS bf16x8*)(sgs + lr * SGP + 8 * lq), a1 = *(const LAS bf16x8*)(sgs + lr * SGP + 32 + 8 * lq);
            float yv[4][4], gt[4][4]; float s1[4] = {0.f, 0.f, 0.f, 0.f}, s2[4] = {0.f, 0.f, 0.f, 0.f}, s3[4] = {0.f, 0.f, 0.f, 0.f};
#pragma unroll
            for (int nt = 0; nt < 4; ++nt) { f32x4 g4 = {0.f, 0.f, 0.f, 0.f};
                g4 = __builtin_amdgcn_mfma_f32_16x16x32_bf16(a0, Bg[nt][0], g4, 0, 0, 0); g4 = __builtin_amdgcn_mfma_f32_16x16x32_bf16(a1, Bg[nt][1], g4, 0, 0, 0);
                const int cl = h * 64 + 16 * nt + lr;
#pragma unroll
                for (int r = 0; r < 4; ++r) { const int tok = 4 * lq + r;
                    const float y = bf2f(in5[(0 * 16 + tok) * OSP + cl]) + bf2f(in5[(1 * 16 + tok) * OSP + cl]);
                    yv[nt][r] = y; gt[nt][r] = g4[r]; s1[r] += y; s2[r] += y * y;
                    s3[r] += bf2f(in5[(2 * 16 + tok) * OSP + cl]) * bf2f(in5[(3 * 16 + tok) * OSP + cl]) * rk[nt]; } }
#pragma unroll
            for (int r = 0; r < 4; ++r) { s1[r] = reduce16(s1[r]) * (1.f / 64.f); s2[r] = reduce16(s2[r]) * (1.f / 64.f); s3[r] = reduce16(s3[r]);
                s2[r] = rsqrtf(fmaxf(s2[r] - s1[r] * s1[r], 0.f) + 64e-5f); }
#pragma unroll
            for (int nt = 0; nt < 4; ++nt) { const int cl = h * 64 + 16 * nt + lr;
#pragma unroll
                for (int r = 0; r < 4; ++r) { const int tok = 4 * lq + r;
                    const float yn = (yv[nt][r] - s1[r]) * s2[r] * lng[nt] + lnb[nt]; const float bon = s3[r] * bf2f(in5[(4 * 16 + tok) * OSP + cl]);
                    outs[tok * OSP + cl] = f2bf((yn + bon) * gt[nt][r]); } }
        } else {
            const int u = F.tid - 384, tok = u >> 3, hu = u & 7, m = m0 + tok; const bool gla = hu < 4;
            const int ycol = gla ? hu * 96 : 768 + (hu - 4) * 64, gcol = gla ? GLA_OFF + 768 + hu * 96 : RET_OFF + 768 + (hu - 4) * 64, npc = gla ? 12 : 8;
            const float* gain = gla ? F.ap->in[I_GNG] + l * 384 + hu * 96 : F.ap->in[I_RETNG] + l * 256 + (hu - 4) * 64;
            bf16_t* ar = F.A + (size_t)m * DM + ycol; const bf16_t* zb = F.Z + (size_t)m * ZP + YB_OFF + ycol; const bf16_t* zg = F.Z + (size_t)m * ZP + gcol;
            u32x4 ypk[12]; float ssq = 0.f;
#pragma unroll
            for (int pc = 0; pc < 12; ++pc) { if (pc < npc) { float a[8], b[8]; unpack8(*(const u32x4*)(ar + pc * 8), a); unpack8(*(const u32x4*)(zb + pc * 8), b);
#pragma unroll
                    for (int e = 0; e < 8; ++e) { a[e] += b[e]; ssq += a[e] * a[e]; }
                    ypk[pc] = pack8u(a); } }
            const float rn = rsqrtf(ssq / (float)(npc * 8) + 1e-6f);
#pragma unroll
            for (int pc = 0; pc < 12; ++pc) { if (pc < npc) { float y[8], g[8]; unpack8(ypk[pc], y); unpack8(*(const u32x4*)(zg + pc * 8), g);
                    const f32x4 g0 = *(const f32x4*)(gain + pc * 8), g1 = *(const f32x4*)(gain + pc * 8 + 4); const float gg[8] = {g0.x, g0.y, g0.z, g0.w, g1.x, g1.y, g1.z, g1.w};
#pragma unroll
                    for (int e = 0; e < 8; ++e) y[e] = siluf_(g[e]) * y[e] * rn * gg[e];
                    *(u32x4*)(ar + pc * 8) = pack8u(y); } }
        }
        __syncthreads();
        for (int p = F.tid; p < 16 * 48; p += NTHR) { const int tok = p / 48, pc = p - tok * 48;
            *(u32x4*)(F.A + (size_t)(m0 + tok) * DM + 384 + pc * 8) = *(const LAS u32x4*)(outs + tok * OSP + pc * 8); }
    }
}
}
using pp::phase_prep;
using pp::phase_post;
constexpr int PH_PER_LAYER = 9, N_PHASES = 1 + DEPTH * PH_PER_LAYER + 1;
#define PHASE_ENTER() \
    CArgs ap = (CArgs)__builtin_amdgcn_kernarg_segment_ptr(); asm volatile("" : "+s"(ap)); \
    int tid = threadIdx.x; asm volatile("" : "+v"(tid)); \
    Frame F; F.lds = lds; F.ap = ap; F.tid = tid; F.lane = tid & 63; F.wave = __builtin_amdgcn_readfirstlane(tid >> 6); F.bid = blockIdx.x; F.G = gridDim.x; \
    unsigned char* ws = ap->ws; F.out = ap->out; F.ws = ws; \
    F.mod = (float*)(ws + WS_MOD); F.Win_t = (bf16_t*)(ws + WS_WIN); F.Wout_t = (bf16_t*)(ws + WS_WOUT); F.W1_t = (bf16_t*)(ws + WS_W1); F.W2_t = (bf16_t*)(ws + WS_W2); \
    F.xc = (float*)(ws + WS_XC); F.A = (bf16_t*)(ws + WS_ABUF); F.Z = (bf16_t*)(ws + WS_Z); F.PREP = (bf16_t*)(ws + WS_PREP); F.H = (bf16_t*)(ws + WS_H); \
    const float* modl = F.mod + (size_t)L * 5 * 6144; (void)modl; \
    const float* xl_in = L == 0 ? F.ap->in[I_X] : F.out; const float* xc_in = L == 0 ? F.ap->in[I_CTX] : F.xc; (void)xl_in; (void)xc_in;

#ifndef PROBE_DUP
#define PROBE_DUP 0
#endif
#define IN(k) (lo <= (k) && (k) < hi)
#define SEAM(k) do { if (IN(k) && IN((k) + 1)) { if ((k) == 0) grid.sync(); else xcd_barrier(bar); if (PROBE_DUP & 16) xcd_barrier(bar); } } while (0)
template <int L> __device__ __forceinline__ void run_layer(int lo, int hi, LAS unsigned char* lds, cg::grid_group& grid, const XcdBarrier& bar) {
    constexpr int p0 = 1 + L * PH_PER_LAYER; constexpr bool last = (L == DEPTH - 1); constexpr int Mo = last ? ML : MT;
    if (IN(p0 + 0)) { PHASE_ENTER(); phase_wconv(F, L); phase_norm(F, xl_in, xc_in, F.ap->in[I_N1G] + L * DM, modl, 0, 1, MT); } SEAM(p0 + 0);
    if (PROBE_DUP & 4) { if (IN(p0 + 0)) { PHASE_ENTER(); phase_wconv(F, L); phase_norm(F, xl_in, xc_in, F.ap->in[I_N1G] + L * DM, modl, 0, 1, MT); } SEAM(p0 + 0); }
    if (IN(p0 + 1)) { PHASE_ENTER(); pg8::Gemm g{F.A, F.Win_t, MT, ZP, DM}; pg8::StaticOrder S; S.init(MT, ZP, F.G, F.bid); pg8::EpiBf16<0> E{F.Z, ZP};
        pg8::gemm_phase<pg8::EpiBf16<0>, pg8::StaticOrder, true, true>(F.lds, g, S, E, tid); if (PROBE_DUP & 8) { grid.sync(); pg8::gemm_phase<pg8::EpiBf16<0>, pg8::StaticOrder, true, true>(F.lds, g, S, E, tid); } } SEAM(p0 + 1);
    if (IN(p0 + 2)) { PHASE_ENTER(); phase_prep(F, L); xcd_barrier(bar);   pp::gla_gate_units(F, L); } SEAM(p0 + 2);
    if (IN(p0 + 3)) { PHASE_ENTER(); phase_scan(F, L); if (PROBE_DUP & 1) { grid.sync(); phase_scan(F, L); } } SEAM(p0 + 3);
    if (IN(p0 + 4)) { PHASE_ENTER(); phase_post(F, L, Mo); } SEAM(p0 + 4);
    if (IN(p0 + 5)) { PHASE_ENTER(); pg8::Gemm g{F.A, F.Wout_t, Mo, DM, DM}; pg8::StaticOrder S; S.init(Mo, DM, F.G, F.bid); pg8::EpiRes E{xl_in, xc_in, F.out, F.xc, modl + 2 * 1024};
        pg8::gemm_phase<pg8::EpiRes, pg8::StaticOrder, true, true>(F.lds, g, S, E, tid); } SEAM(p0 + 5);
    if (IN(p0 + 6)) { PHASE_ENTER(); phase_norm(F, F.out, F.xc, F.ap->in[I_N2G] + L * DM, modl, 3, 4, Mo); if (PROBE_DUP & 4) { grid.sync(); phase_norm(F, F.out, F.xc, F.ap->in[I_N2G] + L * DM, modl, 3, 4, Mo); } } SEAM(p0 + 6);
    if (IN(p0 + 7)) { PHASE_ENTER(); pg8::Gemm g{F.A, F.W1_t, Mo, DFF, DM}; pg8::StaticOrder S; S.init(Mo, DFF, F.G, F.bid); pg8::EpiBf16<2> E{F.H, DFF};
        pg8::gemm_phase<pg8::EpiBf16<2>, pg8::StaticOrder, true, true>(F.lds, g, S, E, tid); if (PROBE_DUP & 8) { grid.sync(); pg8::gemm_phase<pg8::EpiBf16<2>, pg8::StaticOrder, true, true>(F.lds, g, S, E, tid); } } SEAM(p0 + 7);
    if (IN(p0 + 8)) { PHASE_ENTER(); pg8::Gemm g{F.H, F.W2_t, Mo, DM, DFF}; pg8::StaticOrder S; S.init(Mo, DM, F.G, F.bid); pg8::EpiRes E{F.out, F.xc, F.out, F.xc, modl + 5 * 1024};
        pg8::gemm_phase<pg8::EpiRes, pg8::StaticOrder, true, true>(F.lds, g, S, E, tid); } SEAM(p0 + 8);
}
__global__ void __launch_bounds__(NTHR, 2) mega_fwd(Args args) {
    extern __shared__ __attribute__((aligned(16))) unsigned char lds_raw[];
    LAS unsigned char* lds = (LAS unsigned char*)lds_raw;
    const int lo = args.ph_lo, hi = args.ph_hi;
    cg::grid_group grid = cg::this_grid();
    volatile LAS unsigned* misc = (volatile LAS unsigned*)(lds + LDS_BYTES - 256);
    if (threadIdx.x < 4) misc[threadIdx.x] = 0u;
    __syncthreads();
    const XcdBarrier bar = xcd_barrier_post((unsigned*)(args.ws + WS_CTL) + 1024, misc);
    { constexpr int L = 0; if (IN(0)) { PHASE_ENTER(); phase_mod(F); } SEAM(0); }
    run_layer<0>(lo, hi, lds, grid, bar);
    run_layer<1>(lo, hi, lds, grid, bar);
    { constexpr int L = 0; if (IN(N_PHASES - 1)) { PHASE_ENTER(); phase_final(F); } }
}
#undef IN
#undef SEAM

extern "C" void kernel_launch(void* const* d_in, const int* in_sizes, int n_in, void* d_out, int out_size, void* d_ws, size_t ws_size, hipStream_t stream) {
    static int grid = 0;
    if (grid == 0) {
        int dev = 0, cus = 0, per_cu = 0;
        hipGetDevice(&dev); hipDeviceGetAttribute(&cus, hipDeviceAttributeMultiprocessorCount, dev);
        hipFuncSetAttribute((const void*)mega_fwd, hipFuncAttributeMaxDynamicSharedMemorySize, LDS_BYTES);
        hipOccupancyMaxActiveBlocksPerMultiprocessor(&per_cu, (const void*)mega_fwd, NTHR, LDS_BYTES);
        if (per_cu < 1) { fprintf(stderr, "kernel_launch: occupancy query says %d blocks per CU\n", per_cu); per_cu = 1; }
        (void)hipGetLastError();
        grid = cus * per_cu;
        if (n_in != 29 || ws_size < WS_END) fprintf(stderr, "kernel_launch: unexpected n_in %d / ws_size %zu (need %zu)\n", n_in, ws_size, (size_t)WS_END);
    }
    Args a{};
    for (int i = 0; i < 29; ++i) a.in[i] = (const float*)d_in[i];
    a.out = (float*)d_out; a.ws = (unsigned char*)d_ws;
#if MK_ONE_LAUNCH
    (void)hipMemsetAsync((char*)d_ws + WS_CTL, 0, 65536, stream);
    a.ph_lo = 0; a.ph_hi = N_PHASES;
    void* kargs[] = {&a};
    hipError_t e = hipLaunchCooperativeKernel((const void*)mega_fwd, dim3(grid), dim3(NTHR), kargs, LDS_BYTES, stream);
    if (e != hipSuccess) fprintf(stderr, "cooperative launch failed: %s (grid %d)\n", hipGetErrorString(e), grid);
#else
    for (int ph = 0; ph < N_PHASES; ++ph) { a.ph_lo = ph; a.ph_hi = ph + 1;
        hipLaunchKernelGGL(mega_fwd, dim3(grid), dim3(NTHR), LDS_BYTES, stream, a); }
#endif
}
```

```cpp
#include <hip/hip_runtime.h>
#include <hip/hip_cooperative_groups.h>
#include <cstdio>
#include <cstdint>
namespace cg = cooperative_groups;

#ifndef MK_ONE_LAUNCH
#define MK_ONE_LAUNCH 1
#endif

#define LAS __attribute__((address_space(3)))
#define GAS __attribute__((address_space(1)))
typedef unsigned short bf16_t;
typedef float f32x4 __attribute__((ext_vector_type(4)));
typedef float f32x2 __attribute__((ext_vector_type(2)));
typedef unsigned u32x4 __attribute__((ext_vector_type(4)));
typedef unsigned u32x2 __attribute__((ext_vector_type(2)));

constexpr int DM = 1024, NB = 4, SEQ = 8192, CTXL = 256, DEPTH = 2, DFF = 4096;
constexpr int ML = NB * SEQ, MC = NB * CTXL, MT = ML + MC;
constexpr int INC = 3520, ZP = 3584;
constexpr int GLA_OFF = 0, RW_OFF = 1184, RET_OFF = 2496;
constexpr int YB_OFF = RW_OFF;
constexpr int SEQT = CTXL + SEQ;
constexpr int NTHR = 512, NWAVES = 8;

constexpr size_t MiB = 1u << 20;
constexpr size_t WS_CTL = 0, CTL_BYTES = 1 * MiB;
constexpr size_t WS_MOD = 1 * MiB;
constexpr size_t WS_WIN = 2 * MiB, WS_WOUT = 9 * MiB, WS_W1 = 11 * MiB, WS_W2 = 19 * MiB;
constexpr size_t WS_XC = 27 * MiB;
constexpr size_t WS_ABUF = 32 * MiB;
constexpr size_t WS_Z = 98 * MiB;
constexpr size_t WS_PREP = 329 * MiB;
constexpr size_t PREP_STRIDE = (size_t)MT * 384;
constexpr size_t WS_H = 98 * MiB;
constexpr size_t WS_END = WS_PREP + 7 * PREP_STRIDE * 2;
static_assert(WS_ABUF + (size_t)MT * DM * 2 <= WS_Z, "ws map");
static_assert(WS_Z + (size_t)MT * ZP * 2 <= WS_PREP, "ws map");
static_assert(WS_H + (size_t)MT * DFF * 2 <= WS_END, "ws map");
static_assert(WS_END <= 512 * MiB, "ws map");
enum { PR_R = 0, PR_WF = 1, PR_WB = 2, PR_K = 3, PR_V = 4, PR_KK = 5, PR_B = 6 };

constexpr int LDS_BYTES = 147456;

__device__ __forceinline__ float bf2f(bf16_t v) { return __uint_as_float(((unsigned)v) << 16); }
__device__ __forceinline__ unsigned f2bf_u(float f) { unsigned u = __float_as_uint(f); return (u + 0x7fffu + ((u >> 16) & 1u)) >> 16; }
__device__ __forceinline__ bf16_t f2bf(float f) { return (bf16_t)f2bf_u(f); }
__device__ __forceinline__ unsigned pk2(float lo, float hi) { return f2bf_u(lo) | (f2bf_u(hi) << 16); }
__device__ __forceinline__ float sigmoidf_(float x) { return 1.0f / (1.0f + __expf(-x)); }
__device__ __forceinline__ float siluf_(float x) { return x / (1.0f + __expf(-x)); }
__device__ __forceinline__ float softplusf_(float x) { return fmaxf(x, 0.f) + log1pf(__expf(-fabsf(x))); }
__device__ __forceinline__ float wave_sum(float v) {
#pragma unroll
    for (int o = 1; o < 64; o <<= 1) v += __shfl_xor(v, o);
    return v;
}
template <int CTRL> __device__ __forceinline__ float dpp_mov(float x) { return __int_as_float(__builtin_amdgcn_update_dpp(0, __float_as_int(x), CTRL, 0xF, 0xF, true)); }
__device__ __forceinline__ float reduce16(float x) {
    x += dpp_mov<0xB1>(x);
    x += dpp_mov<0x4E>(x);
    x += dpp_mov<0x141>(x);
    x += dpp_mov<0x140>(x);
    return x;
}
#define LDS_WAIT() asm volatile("s_waitcnt lgkmcnt(0)" ::: "memory")


#define XB_TMO      128
#define XB_XCNT(j)  (256  + 64 * (j))
#define XB_XSUB(j)  (1280 + 64 * (j))
#define XB_XGEN(j)  (2304 + 64 * (j))
#define XB_TOP      3328
#define XB_TOPGEN   3392
#define XCD_BAR_WORDS 3456
#define XB_SPIN_CAP (1u << 18)

__device__ __forceinline__ unsigned xb_ld(unsigned* p)              { return __hip_atomic_load(p, __ATOMIC_RELAXED, __HIP_MEMORY_SCOPE_AGENT); }
__device__ __forceinline__ unsigned xb_add(unsigned* p, unsigned v) { return __hip_atomic_fetch_add(p, v, __ATOMIC_RELAXED, __HIP_MEMORY_SCOPE_AGENT); }
__device__ __forceinline__ unsigned xb_xcc_id() { return (unsigned)__builtin_amdgcn_s_getreg((3 << 11) | 20) & 0xFu; }
#define XB_SPIN(cond, bar) do { unsigned _sp = 0; while (cond) { __builtin_amdgcn_s_sleep(1); \
    if ((++_sp & 255u) == 0u) { if (xb_ld(&(bar)[XB_TMO])) break; if (_sp > XB_SPIN_CAP) { atomicAdd(&(bar)[XB_TMO], 1u); break; } } } } while (0)

struct XcdBarrier {
    unsigned* bar; unsigned x;
    volatile LAS unsigned* st;
};

__device__ __forceinline__ XcdBarrier xcd_barrier_post(unsigned* bar, volatile LAS unsigned* st) {
    XcdBarrier b; b.bar = bar; b.x = xb_xcc_id(); b.st = st;
    if (threadIdx.x == 0) (void)xb_add(&bar[XB_XCNT(b.x)], 1u);
    return b;
}
__device__ __forceinline__ void xcd_barrier_complete(unsigned* bar, unsigned x, unsigned& nloc, unsigned& nx) {
    const unsigned G = gridDim.x * gridDim.y * gridDim.z;
    unsigned sum, cnt, mine, sp = 0u;
    for (;;) {
        sum = 0u; cnt = 0u; mine = 0u;
#pragma unroll
        for (unsigned j = 0; j < 16; ++j) { const unsigned c = xb_ld(&bar[XB_XCNT(j)]); sum += c; cnt += (c > 0u) ? 1u : 0u; mine = (j == x) ? c : mine; }
        if (sum == G) break;
        __builtin_amdgcn_s_sleep(1);
        if ((++sp & 255u) == 0u) { if (xb_ld(&bar[XB_TMO])) break; if (sp > XB_SPIN_CAP) { atomicAdd(&bar[XB_TMO], 1u); break; } }
    }
    nloc = mine > 0u ? mine : 1u; nx = cnt > 0u ? cnt : 1u;
}

__device__ __forceinline__ void xcd_barrier(const XcdBarrier& b) {
    asm volatile("s_waitcnt vmcnt(0)" ::: "memory");
    __syncthreads();
    if (threadIdx.x == 0) {
        unsigned* bar = b.bar;
        __builtin_amdgcn_s_waitcnt(0);
        unsigned nloc = b.st[0], nx = b.st[1];
        if (nloc == 0u) { xcd_barrier_complete(bar, b.x, nloc, nx); b.st[0] = nloc; b.st[1] = nx; }
        const unsigned old = xb_add(&bar[XB_XSUB(b.x)], 1u);
        const unsigned gen = old / nloc;
        if (old + 1u == (gen + 1u) * nloc) {
            __builtin_amdgcn_fence(__ATOMIC_RELEASE, "agent");
            asm volatile("s_waitcnt vmcnt(0)" ::: "memory");
            const unsigned og = xb_add(&bar[XB_TOP], 1u);
            const unsigned tg = og / nx;
            if (og + 1u == (tg + 1u) * nx) xb_add(&bar[XB_TOPGEN], 1u);
            else XB_SPIN(xb_ld(&bar[XB_TOPGEN]) == tg, bar);
            __builtin_amdgcn_fence(__ATOMIC_ACQUIRE, "agent");
            xb_add(&bar[XB_XGEN(b.x)], 1u);
            asm volatile("s_waitcnt vmcnt(0)" ::: "memory");
        } else {
            XB_SPIN(xb_ld(&bar[XB_XGEN(b.x)]) == gen, bar);
            __builtin_amdgcn_fence(__ATOMIC_ACQUIRE, "agent");
            asm volatile("s_waitcnt vmcnt(0)" ::: "memory");
        }
    }
    __syncthreads();
}


namespace pg8 {
#define PG8_LAS __attribute__((address_space(3)))
typedef unsigned short bf16_t;
typedef short bf16x8 __attribute__((ext_vector_type(8)));
typedef float f32x4 __attribute__((ext_vector_type(4)));
typedef unsigned u32x4 __attribute__((ext_vector_type(4)));
constexpr int BM = 256, BK = 64, HALF = 128, HTB = HALF * BK * 2  , STAGE_BYTES = 8 * HTB, NXCD = 8, WGM = 8;

__host__ __device__ __forceinline__ int lds_byte(int r, int c) { const int st = (r >> 4) * 2 + (c >> 5), rr = r & 15, cc = c & 31, ob = rr * 64 + cc * 2; return st * 1024 + (ob ^ (((ob >> 9) & 1) << 5)); }
__host__ __device__ __forceinline__ void stage_rc(int b, int& R, int& C) { const int st = b / 1024, sb = b % 1024, swz = sb ^ (((sb >> 9) & 1) << 5); R = (st >> 1) * 16 + swz / 64; C = (st & 1) * 32 + (swz % 64) / 2; }
__host__ __device__ __forceinline__ int perm32(int rho) { const int n = rho >> 4, i = rho & 15; return 8 * (i >> 2) + 4 * n + (i & 3); }

struct Unit { int pm, pn; };
struct Gemm { const bf16_t* A; const bf16_t* Bt; int M, N, K; };

struct StaticOrder {
    int nM, nN, nwg, G, c;
    __host__ __device__ void init(int M, int N, int G_, int c_) { nM = M / BM; nN = N / BM; nwg = nM * nN; G = G_; c = c_; }
    __host__ __device__ bool next(int i, Unit& u) const {
        const long L = (long)i * G + c; if (L >= nwg) return false;
        int wgid = (int)L; { const int q = nwg / NXCD, r = nwg % NXCD, xcd = wgid % NXCD, off = wgid / NXCD; wgid = (xcd < r ? xcd * (q + 1) : r * (q + 1) + (xcd - r) * q) + off; }
        const int nig = WGM * nN, gid = wgid / nig, fm = gid * WGM, gsz = (nM - fm) < WGM ? (nM - fm) : WGM;
        u.pm = fm + ((wgid % nig) % gsz); u.pn = (wgid % nig) / gsz; return true;
    }
    __device__ __forceinline__ void a_ready(const Unit&) const {}
    __device__ __forceinline__ void done(const Unit&) const {}
};

template <class Epi, class Sched, bool ALIGN_EPI = false, bool SP2 = false>
__device__ __forceinline__ void gemm_phase(PG8_LAS unsigned char* lds, const Gemm g, const Sched& S, const Epi& E, const int tid) {
    const int wid = __builtin_amdgcn_readfirstlane(tid >> 6), lane = tid & 63, wr = wid >> 2, wc = wid & 3, fr = lane & 15, fq = lane >> 4;
    const int K = g.K, nt = K / BK;
    unsigned voffA[2], voffB[2];
#pragma unroll
    for (int i = 0; i < 2; ++i) { int R, C; stage_rc(tid * 16 + i * 8192, R, C); const int Rb = Epi::PERM ? ((R & ~31) + perm32(R & 31)) : R;
        voffA[i] = (unsigned)(R * K + C) * 2u; voffB[i] = (unsigned)(Rb * K + C) * 2u; }
    const size_t kstep = (size_t)(BK * 2);
    const size_t hstep = (size_t)HALF * K * 2;
    const size_t tstep = 2 * hstep;
    const unsigned ldsw = (unsigned)wid * 1024u;
    const int aoff = lds_byte(wr * 64 + fr, fq * 8), boff = lds_byte(wc * 32 + fr, fq * 8);
#define PG8_SA(b, h) (((b) * 2 + (h)) * HTB)
#define PG8_SB(b, h) ((4 + (b) * 2 + (h)) * HTB)
#define PG8_STAGE(bufoff, gbase, voff) do { _Pragma("unroll") for (int _i = 0; _i < 2; ++_i) \
        __builtin_amdgcn_global_load_lds((const unsigned*)((const char*)(gbase) + (voff)[_i]), (PG8_LAS unsigned*)(lds + (bufoff) + ldsw + _i * 8192), 16, 0, 0); } while (0)
#define PG8_LDA(dst, b, h) do { _Pragma("unroll") for (int m = 0; m < 4; ++m) _Pragma("unroll") for (int k = 0; k < 2; ++k) dst[m][k] = *(const PG8_LAS bf16x8*)(lds + PG8_SA(b, h) + aoff + m * 2048 + k * 1024); } while (0)
#define PG8_LDB(dst, b, h) do { _Pragma("unroll") for (int n = 0; n < 2; ++n) _Pragma("unroll") for (int k = 0; k < 2; ++k) dst[n][k] = *(const PG8_LAS bf16x8*)(lds + PG8_SB(b, h) + boff + n * 2048 + k * 1024); } while (0)
#define PG8_MMA(ai, bj, At, Bt) do { __builtin_amdgcn_s_setprio(1); _Pragma("unroll") for (int m = 0; m < 4; ++m) _Pragma("unroll") for (int n = 0; n < 2; ++n) _Pragma("unroll") for (int k = 0; k < 2; ++k) \
        acc[ai][bj][m][n] = __builtin_amdgcn_mfma_f32_16x16x32_bf16(Bt[n][k], At[m][k], acc[ai][bj][m][n], 0, 0, 0); __builtin_amdgcn_s_setprio(0); } while (0)
#define PG8_WAIT_V(n) asm volatile("s_waitcnt vmcnt(" #n ")" ::: "memory")
#define PG8_WAIT_L(n) asm volatile("s_waitcnt lgkmcnt(" #n ")" ::: "memory")
#define PG8_BAR __builtin_amdgcn_s_barrier()
#define PG8_SCHED __builtin_amdgcn_sched_barrier(0)
    Unit cur, nxt; int ui = 0;
    if (!S.next(0, cur)) return;
    f32x4 acc[2][2][4][2];
#pragma unroll
    for (int a = 0; a < 2; ++a)
#pragma unroll
        for (int b = 0; b < 2; ++b)
#pragma unroll
            for (int m = 0; m < 4; ++m)
#pragma unroll
                for (int n = 0; n < 2; ++n) acc[a][b][m][n] = (f32x4){0.f, 0.f, 0.f, 0.f};
    bf16x8 At[4][2], B0[2][2], B1[2][2];
    const char* cA = (const char*)g.A + (size_t)cur.pm * tstep; const char* cB = (const char*)g.Bt + (size_t)cur.pn * tstep;
    S.a_ready(cur);
    if constexpr (SP2) {
        PG8_STAGE(PG8_SB(0, 0), cB, voffB); PG8_STAGE(PG8_SB(0, 1), cB + hstep, voffB); PG8_STAGE(PG8_SA(0, 0), cA, voffA); PG8_STAGE(PG8_SA(0, 1), cA + hstep, voffA);
        if (wr == 1) PG8_BAR;
        PG8_WAIT_V(2); PG8_BAR;
        PG8_STAGE(PG8_SB(1, 0), cB + kstep, voffB); PG8_STAGE(PG8_SA(1, 0), cA + kstep, voffA); PG8_STAGE(PG8_SB(1, 1), cB + hstep + kstep, voffB);
        PG8_WAIT_V(6); PG8_BAR;
    } else {
        PG8_STAGE(PG8_SB(0, 0), cB, voffB); PG8_STAGE(PG8_SA(0, 0), cA, voffA); PG8_STAGE(PG8_SB(0, 1), cB + hstep, voffB); PG8_STAGE(PG8_SA(0, 1), cA + hstep, voffA);
        if (wr == 1) PG8_BAR;
        PG8_WAIT_V(4); PG8_BAR;
        PG8_STAGE(PG8_SB(1, 0), cB + kstep, voffB); PG8_STAGE(PG8_SA(1, 0), cA + kstep, voffA); PG8_STAGE(PG8_SB(1, 1), cB + hstep + kstep, voffB);
        PG8_WAIT_V(6); PG8_BAR;
    }
    for (;;) {
        const bool has_next = S.next(ui + 1, nxt);
        const char* nA = has_next ? (const char*)g.A + (size_t)nxt.pm * tstep : cA; const char* nB = has_next ? (const char*)g.Bt + (size_t)nxt.pn * tstep : cB;
        for (int t = 0; t < nt; t += 2) {
            const bool last = (t == nt - 2);
            const char* a1 = cA + (size_t)(t + 1) * kstep;
            const char* a2 = last ? nA : cA + (size_t)(t + 2) * kstep; const char* b2 = last ? nB : cB + (size_t)(t + 2) * kstep;
            const char* a3 = a2 + kstep; const char* b3 = b2 + kstep;
            if (last && has_next) S.a_ready(nxt);
            if constexpr (SP2) {
            PG8_LDB(B0, 0, 0); PG8_LDB(B1, 0, 1); PG8_SCHED; PG8_LDA(At, 0, 0); PG8_STAGE(PG8_SA(1, 1), a1 + hstep, voffA);
            PG8_WAIT_V(8); PG8_WAIT_L(0); PG8_BAR; PG8_MMA(0, 0, At, B0); PG8_MMA(0, 1, At, B1); PG8_BAR; PG8_SCHED;
            PG8_LDA(At, 0, 1); PG8_STAGE(PG8_SB(0, 0), b2, voffB); PG8_STAGE(PG8_SB(0, 1), b2 + hstep, voffB); PG8_STAGE(PG8_SA(0, 0), a2, voffA);
            PG8_WAIT_V(8); PG8_WAIT_L(0); PG8_BAR; PG8_MMA(1, 0, At, B0); PG8_MMA(1, 1, At, B1); PG8_BAR; PG8_SCHED;
            PG8_LDB(B0, 1, 0); PG8_LDB(B1, 1, 1); PG8_SCHED; PG8_LDA(At, 1, 0); PG8_STAGE(PG8_SA(0, 1), a2 + hstep, voffA);
            PG8_WAIT_V(8); PG8_WAIT_L(0); PG8_BAR; PG8_MMA(0, 0, At, B0); PG8_MMA(0, 1, At, B1); PG8_BAR; PG8_SCHED;
            PG8_LDA(At, 1, 1); PG8_STAGE(PG8_SB(1, 0), b3, voffB); PG8_STAGE(PG8_SB(1, 1), b3 + hstep, voffB); PG8_STAGE(PG8_SA(1, 0), a3, voffA);
            PG8_WAIT_V(8); PG8_WAIT_L(0); PG8_BAR; PG8_MMA(1, 0, At, B0); PG8_MMA(1, 1, At, B1); PG8_BAR; PG8_SCHED;
            } else {
            PG8_LDB(B0, 0, 0); PG8_SCHED; PG8_LDA(At, 0, 0); PG8_STAGE(PG8_SA(1, 1), a1 + hstep, voffA);
            PG8_WAIT_L(8); PG8_BAR; PG8_WAIT_L(0); PG8_MMA(0, 0, At, B0); PG8_BAR; PG8_SCHED;
            PG8_LDB(B1, 0, 1); PG8_STAGE(PG8_SB(0, 0), b2, voffB);
            PG8_BAR; PG8_WAIT_L(0); PG8_MMA(0, 1, At, B1); PG8_BAR;
            PG8_LDA(At, 0, 1); PG8_STAGE(PG8_SA(0, 0), a2, voffA);
            PG8_BAR; PG8_WAIT_L(0); PG8_MMA(1, 0, At, B0); PG8_BAR; PG8_SCHED;
            PG8_STAGE(PG8_SB(0, 1), b2 + hstep, voffB);
            PG8_WAIT_V(6); PG8_BAR; PG8_MMA(1, 1, At, B1); PG8_BAR;
            PG8_LDB(B0, 1, 0); PG8_SCHED; PG8_LDA(At, 1, 0); PG8_STAGE(PG8_SA(0, 1), a2 + hstep, voffA);
            PG8_WAIT_L(8); PG8_BAR; PG8_WAIT_L(0); PG8_MMA(0, 0, At, B0); PG8_BAR; PG8_SCHED;
            PG8_LDB(B1, 1, 1); PG8_STAGE(PG8_SB(1, 0), b3, voffB);
            PG8_BAR; PG8_WAIT_L(0); PG8_MMA(0, 1, At, B1); PG8_BAR;
            PG8_LDA(At, 1, 1); PG8_STAGE(PG8_SA(1, 0), a3, voffA);
            PG8_BAR; PG8_WAIT_L(0); PG8_MMA(1, 0, At, B0); PG8_BAR; PG8_SCHED;
            PG8_STAGE(PG8_SB(1, 1), b3 + hstep, voffB);
            PG8_WAIT_V(6); PG8_BAR; PG8_MMA(1, 1, At, B1); PG8_BAR;
            }
        }
        if constexpr (ALIGN_EPI) { if (wr == 0) PG8_BAR; }
        if constexpr (!Epi::AFTER_DRAIN) { E(acc, cur, wr, wc, fr, fq); S.done(cur); }
        if (!has_next) break;
#pragma unroll
        for (int a = 0; a < 2; ++a)
#pragma unroll
            for (int b = 0; b < 2; ++b)
#pragma unroll
                for (int m = 0; m < 4; ++m)
#pragma unroll
                    for (int n = 0; n < 2; ++n) acc[a][b][m][n] = (f32x4){0.f, 0.f, 0.f, 0.f};
        cur = nxt; cA = nA; cB = nB; ++ui;
        if constexpr (ALIGN_EPI) { if (wr == 1) PG8_BAR; }
    }
    PG8_WAIT_V(0);
    if constexpr (!ALIGN_EPI) { if (wr == 0) PG8_BAR; }
    PG8_BAR;
    if constexpr (Epi::AFTER_DRAIN) { E.fused(acc, cur, wr, wc, fr, fq, lds, wid, lane); S.done(cur); }
#undef PG8_SA
#undef PG8_SB
#undef PG8_STAGE
#undef PG8_LDA
#undef PG8_LDB
#undef PG8_MMA
#undef PG8_WAIT_V
#undef PG8_WAIT_L
#undef PG8_BAR
#undef PG8_SCHED
}
}

namespace pg8 {
template <int ACT> struct EpiBf16 {
    static constexpr bool PERM = true, AFTER_DRAIN = false;
    bf16_t* O; int ldc;
    __device__ __forceinline__ void operator()(const f32x4 (&acc)[2][2][4][2], const Unit& u, int wr, int wc, int fr, int fq) const {
        const int row0 = u.pm * BM + wr * 64 + fr; const int col0 = u.pn * BM + wc * 32 + 8 * fq;
#pragma unroll
        for (int ai = 0; ai < 2; ++ai)
#pragma unroll
            for (int m = 0; m < 4; ++m) { bf16_t* rowp = O + (size_t)(row0 + ai * HALF + m * 16) * ldc + col0;
#pragma unroll
                for (int bj = 0; bj < 2; ++bj) { f32x4 v0 = acc[ai][bj][m][0], v1 = acc[ai][bj][m][1];
                    if (ACT == 2) {
#pragma unroll
                        for (int e = 0; e < 4; ++e) { float a = fmaxf(v0[e], 0.f), b = fmaxf(v1[e], 0.f); v0[e] = a * a; v1[e] = b * b; } }
                    u32x4 w; w.x = ::pk2(v0[0], v0[1]); w.y = ::pk2(v0[2], v0[3]); w.z = ::pk2(v1[0], v1[1]); w.w = ::pk2(v1[2], v1[3]);
                    *(u32x4*)(rowp + bj * HALF) = w; } }
    }
};
struct EpiRes {
    static constexpr bool PERM = false, AFTER_DRAIN = false;
    const float* base_lat; const float* base_ctx; float* out_lat; float* out_ctx; const float* gate  ;
    __device__ __forceinline__ void operator()(const f32x4 (&acc)[2][2][4][2], const Unit& u, int wr, int wc, int fr, int fq) const {
        const bool lat = u.pm < (ML / BM); const int mi = lat ? (u.pm >> 5) : 4;
        const float* gv = gate + (size_t)mi * 6144;
        const size_t tile_off = lat ? (size_t)u.pm * BM * DM : (size_t)(u.pm - ML / BM) * BM * DM;
        const float* bp = (lat ? base_lat : base_ctx) + tile_off; float* op = (lat ? out_lat : out_ctx) + tile_off;
        const int col0 = u.pn * BM + wc * 32 + 4 * fq;
        f32x4 g4[2][2];
#pragma unroll
        for (int bj = 0; bj < 2; ++bj)
#pragma unroll
            for (int n = 0; n < 2; ++n) g4[bj][n] = *(const f32x4*)(gv + col0 + bj * HALF + n * 16);
#pragma unroll
        for (int ai = 0; ai < 2; ++ai)
#pragma unroll
            for (int m = 0; m < 4; ++m) { const size_t off = (size_t)(ai * HALF + wr * 64 + m * 16 + fr) * DM + col0;
#pragma unroll
                for (int bj = 0; bj < 2; ++bj)
#pragma unroll
                    for (int n = 0; n < 2; ++n) { const f32x4 bs = *(const f32x4*)(bp + off + bj * HALF + n * 16);
                        *(f32x4*)(op + off + bj * HALF + n * 16) = bs + g4[bj][n] * acc[ai][bj][m][n]; } }
    }
};
}

struct Args { const float* in[29]; float* out; unsigned char* ws; int ph_lo, ph_hi; };
enum { I_X = 0, I_C, I_CTX, I_CCTX, I_FNG, I_MODW, I_MODB, I_N1G, I_N2G, I_WIN, I_WOUT, I_W1, I_W2, I_GGW2, I_GGB, I_GNG, I_RMU, I_RW0, I_RW2, I_RA0, I_RA2, I_RG2,
       I_RKK, I_RKA, I_RRK, I_RLNG, I_RLNB, I_RETLR, I_RETNG };

typedef const __attribute__((address_space(4))) Args* CArgs;
struct Frame {
    LAS unsigned char* lds;
    int tid, lane, wave, bid, G;
    CArgs ap; float* out; unsigned char* ws;
    float* mod; bf16_t *Win_t, *Wout_t, *W1_t, *W2_t; float* xc; bf16_t *A, *Z, *PREP, *H;
};

__device__ __forceinline__ int mod_index(int m) { return m < ML ? (m >> 13) : 4; }
__device__ __forceinline__ int seq_row(int b, int dir, int s) {
    if (s < CTXL) { const int tc = dir ? (CTXL - 1 - s) : s; return ML + b * CTXL + tc; }
    const int tl = s - CTXL; const int t = dir ? (SEQ - 1 - tl) : tl; return b * SEQ + t;
}
__device__ __forceinline__ float zshift(const bf16_t* Z, int m, int col, float mu) {
    const bf16_t* p = Z + (size_t)m * ZP + col;
    const float z0 = bf2f(*p); float nb;
    if (m < ML) { const int t = m & (SEQ - 1), gr = t >> 6, gc = t & 63; float s = 0.f;
        if (gr > 0) s += bf2f(*(p - (ptrdiff_t)64 * ZP)); if (gr < 127) s += bf2f(*(p + (ptrdiff_t)64 * ZP));
        if (gc > 0) s += bf2f(*(p - (ptrdiff_t)ZP)); if (gc < 63) s += bf2f(*(p + (ptrdiff_t)ZP));
        nb = 0.25f * s;
    } else { const int t = (m - ML) & (CTXL - 1); float s = 0.f;
        if (t > 0) s += bf2f(*(p - (ptrdiff_t)ZP)); if (t < CTXL - 1) s += bf2f(*(p + (ptrdiff_t)ZP));
        nb = 0.5f * s; }
    return z0 + mu * (nb - z0);
}


struct ZNb { ptrdiff_t o[4]; float w[4]; };
__device__ __forceinline__ ZNb znb(int m) { ZNb n;
    if (m < ML) { const int t = m & (SEQ - 1), gr = t >> 6, gc = t & 63;
        n.o[0] = gr > 0 ? -(ptrdiff_t)64 * ZP : 0; n.o[1] = gr < 127 ? (ptrdiff_t)64 * ZP : 0; n.o[2] = gc > 0 ? -(ptrdiff_t)ZP : 0; n.o[3] = gc < 63 ? (ptrdiff_t)ZP : 0;
        n.w[0] = gr > 0 ? 0.25f : 0.f; n.w[1] = gr < 127 ? 0.25f : 0.f; n.w[2] = gc > 0 ? 0.25f : 0.f; n.w[3] = gc < 63 ? 0.25f : 0.f;
    } else { const int t = (m - ML) & (CTXL - 1);
        n.o[0] = 0; n.o[1] = 0; n.o[2] = t > 0 ? -(ptrdiff_t)ZP : 0; n.o[3] = t < CTXL - 1 ? (ptrdiff_t)ZP : 0;
        n.w[0] = 0.f; n.w[1] = 0.f; n.w[2] = t > 0 ? 0.5f : 0.f; n.w[3] = t < CTXL - 1 ? 0.5f : 0.f; }
    return n; }
struct ZRaw { bf16_t c, n0, n1, n2, n3; };
__device__ __forceinline__ ZRaw zload(const bf16_t* p, const ZNb& n) { ZRaw r; r.c = *p; r.n0 = *(p + n.o[0]); r.n1 = *(p + n.o[1]); r.n2 = *(p + n.o[2]); r.n3 = *(p + n.o[3]); return r; }
__device__ __forceinline__ float zmix(const ZRaw& r, const ZNb& n, float mu) { const float z0 = bf2f(r.c);
    const float nb = (bf2f(r.n0) * n.w[0] + bf2f(r.n1) * n.w[1]) + (bf2f(r.n2) * n.w[2] + bf2f(r.n3) * n.w[3]); return z0 + mu * (nb - z0); }
__device__ __forceinline__ float fast_tanh(float x) { const float e = __expf(2.0f * x); return 1.0f - 2.0f / (e + 1.0f); }

__device__ __forceinline__ void phase_mod(Frame& F) {
    LAS float* sc = (LAS float*)F.lds;
    LAS float* red = sc + 5 * 1024;
    for (int i = F.tid; i < 5 * 1024; i += NTHR) { const int j = i >> 10, k = i & 1023; const float v = j < 4 ? F.ap->in[I_C][j * 1024 + k] : F.ap->in[I_CCTX][k]; sc[i] = siluf_(v); }
    __syncthreads();
    const int kg = F.tid >> 6, c = F.tid & 63;
    for (int it = F.bid; it < DEPTH * 96; it += F.G) {
        const int l = it / 96, cgp = it % 96, col = cgp * 64 + c;
        const float* W = F.ap->in[I_MODW] + (size_t)l * DM * 6144 + col;
        float a0 = 0.f, a1 = 0.f, a2 = 0.f, a3 = 0.f, a4 = 0.f;
#pragma unroll 4
        for (int k = kg * 128; k < kg * 128 + 128; ++k) { const float w = W[(size_t)k * 6144];
            a0 += sc[k] * w; a1 += sc[1024 + k] * w; a2 += sc[2048 + k] * w; a3 += sc[3072 + k] * w; a4 += sc[4096 + k] * w; }
        red[(kg * 5 + 0) * 64 + c] = a0; red[(kg * 5 + 1) * 64 + c] = a1; red[(kg * 5 + 2) * 64 + c] = a2; red[(kg * 5 + 3) * 64 + c] = a3; red[(kg * 5 + 4) * 64 + c] = a4;
        __syncthreads();
        if (F.tid < 320) { const int j = F.tid >> 6; float s = 0.f;
#pragma unroll
            for (int g = 0; g < 8; ++g) s += red[(g * 5 + j) * 64 + c];
            F.mod[((size_t)l * 5 + j) * 6144 + col] = s + F.ap->in[I_MODB][l * 6144 + col]; }
        __syncthreads();
    }
}

__device__ __forceinline__ void transpose_item(const float* W, int K, int N, bf16_t* WT, LAS float* scr, int item, int lane) {
    const int nblk = N / 32, kb = item / nblk, nb = item % nblk, k0 = 64 * kb, n0 = 32 * nb;
#pragma unroll 8
    for (int i = 0; i < 32; ++i) { const int kk = 2 * i + (lane >> 5); scr[kk * 33 + (lane & 31)] = W[(size_t)(k0 + kk) * N + n0 + (lane & 31)]; }
    LDS_WAIT(); asm volatile("" ::: "memory");
    const int c = lane & 7;
#pragma unroll
    for (int j = 0; j < 4; ++j) { const int n = (lane >> 3) + 8 * j; const LAS float* s = scr + (8 * c) * 33 + n;
        u32x4 o; o.x = pk2(s[0 * 33], s[1 * 33]); o.y = pk2(s[2 * 33], s[3 * 33]); o.z = pk2(s[4 * 33], s[5 * 33]); o.w = pk2(s[6 * 33], s[7 * 33]);
        *(u32x4*)(WT + (size_t)(n0 + n) * K + k0 + 8 * c) = o; }
    LDS_WAIT(); asm volatile("" ::: "memory");
}
__device__ __forceinline__ void phase_wconv(Frame& F, int l) {
    LAS float* scr = (LAS float*)(F.lds + F.wave * 16384);
    const int gw = F.bid * NWAVES + F.wave, NGW = F.G * NWAVES;
    constexpr int I_IN = (DM / 64) * (INC / 32), I_O = (DM / 64) * (DM / 32), I_1 = (DM / 64) * (DFF / 32), I_2 = (DFF / 64) * (DM / 32);
    const float* Win = F.ap->in[I_WIN] + (size_t)l * DM * INC; const float* Wout = F.ap->in[I_WOUT] + (size_t)l * DM * DM;
    const float* W1 = F.ap->in[I_W1] + (size_t)l * DM * DFF; const float* W2 = F.ap->in[I_W2] + (size_t)l * DFF * DM;
    for (int it = gw; it < I_IN + I_O + I_1 + I_2; it += NGW) {
        int r = it;
        if (r < I_IN) { transpose_item(Win, DM, INC, F.Win_t, scr, r, F.lane); continue; } r -= I_IN;
        if (r < I_O) { transpose_item(Wout, DM, DM, F.Wout_t, scr, r, F.lane); continue; } r -= I_O;
        if (r < I_1) { transpose_item(W1, DM, DFF, F.W1_t, scr, r, F.lane); continue; } r -= I_1;
        transpose_item(W2, DFF, DM, F.W2_t, scr, r, F.lane);
    }
    { u32x4* zp = (u32x4*)(F.Win_t + (size_t)INC * DM); const int n16 = (ZP - INC) * DM * 2 / 16;
      for (int i = F.bid * NTHR + F.tid; i < n16; i += F.G * NTHR) zp[i] = (u32x4){0u, 0u, 0u, 0u}; }
}

__device__ __forceinline__ void phase_norm(Frame& F, const float* src_lat, const float* src_ctx, const float* g, const float* modl, int shift_idx, int scale_idx, int Mrows) {
    const int gw = F.bid * NWAVES + F.wave, NGW = F.G * NWAVES;
    for (int m = gw; m < Mrows; m += NGW) {
        const float* xrow = m < ML ? src_lat + (size_t)m * DM : src_ctx + (size_t)(m - ML) * DM;
        const float* mv = modl + (size_t)mod_index(m) * 6144;
        const f32x4* xr = (const f32x4*)xrow + F.lane;
        f32x4 v[4]; float ss = 0.f;
#pragma unroll
        for (int j = 0; j < 4; ++j) { v[j] = xr[64 * j]; ss += (v[j].x * v[j].x + v[j].y * v[j].y) + (v[j].z * v[j].z + v[j].w * v[j].w); }
        const float r = rsqrtf(wave_sum(ss) * (1.f / DM) + 1e-6f);
        u32x2* o8 = (u32x2*)(F.A + (size_t)m * DM) + F.lane;
#pragma unroll
        for (int j = 0; j < 4; ++j) { const int col = 4 * F.lane + 256 * j;
            const f32x4 gg = *(const f32x4*)(g + col), sh = *(const f32x4*)(mv + shift_idx * 1024 + col), sc = *(const f32x4*)(mv + scale_idx * 1024 + col);
            const f32x4 y = v[j] * r * gg * (sc + 1.0f) + sh;
            u32x2 w; w.x = pk2(y.x, y.y); w.y = pk2(y.z, y.w); o8[64 * j] = w; }
    }
}
__device__ __forceinline__ void phase_final(Frame& F) {
    const int gw = F.bid * NWAVES + F.wave, NGW = F.G * NWAVES; const float* g = F.ap->in[I_FNG];
    for (int m = gw; m < ML; m += NGW) {
        f32x4* xr = (f32x4*)(F.out + (size_t)m * DM) + F.lane;
        f32x4 v[4]; float ss = 0.f;
#pragma unroll
        for (int j = 0; j < 4; ++j) { v[j] = xr[64 * j]; ss += (v[j].x * v[j].x + v[j].y * v[j].y) + (v[j].z * v[j].z + v[j].w * v[j].w); }
        const float r = rsqrtf(wave_sum(ss) * (1.f / DM) + 1e-6f);
#pragma unroll
        for (int j = 0; j < 4; ++j) { const f32x4 gg = *(const f32x4*)(g + 4 * F.lane + 256 * j); xr[64 * j] = v[j] * r * gg; }
    }
}

#ifndef SCAN_GLA_V0
#define SCAN_GLA_V0 0
#endif
__device__ __forceinline__ void gla_scan_block(Frame& F, int l, int chain) {
    constexpr int TS = 64;
    const int dir = chain & 1, h = (chain >> 1) & 3, b = chain >> 3;
    LAS float* q = (LAS float*)F.lds;
    LAS float* k = q + TS * 48; LAS float* g = k + TS * 48;
    LAS float* v = g + TS * 48;
    LAS float* y = v + TS * 96;
    const float* W2 = F.ap->in[I_GGW2] + (size_t)(l * 2 + dir) * 16 * 192 + h * 48; const float* Bg = F.ap->in[I_GGB] + (l * 2 + dir) * 192 + h * 48;
    const float qs = 0.14433756729740643f;
    float S[48];
#pragma unroll
    for (int j = 0; j < 48; ++j) S[j] = 0.f;
    for (int tile = 0; tile < SEQT / TS; ++tile) {
        const int sbase = tile * TS;
        for (int i = F.tid; i < TS * 48; i += NTHR) { const int st = i / 48, j = i % 48; const int m = seq_row(b, dir, sbase + st); const bf16_t* zr = F.Z + (size_t)m * ZP;
            q[i] = bf2f(zr[GLA_OFF + h * 48 + j]) * qs; k[i] = bf2f(zr[GLA_OFF + 192 + h * 48 + j]);
            float x = Bg[j];
#pragma unroll
            for (int r = 0; r < 16; ++r) x += bf2f(zr[GLA_OFF + 1152 + dir * 16 + r]) * W2[r * 192 + j];
            const float ls = fminf(x, 0.f) - log1pf(__expf(-fabsf(x)));
            g[i] = __expf(ls * (1.0f / 16.0f)); }
        for (int i = F.tid; i < TS * 96; i += NTHR) { const int st = i / 96, n = i % 96; const int m = seq_row(b, dir, sbase + st); v[i] = bf2f(F.Z[(size_t)m * ZP + GLA_OFF + 384 + h * 96 + n]); }
        __syncthreads();
        if (F.tid < 96) {
            for (int st = 0; st < TS; ++st) { const float vn = v[st * 96 + F.tid]; float o = 0.f;
#pragma unroll
                for (int j = 0; j < 48; ++j) { S[j] = S[j] * g[st * 48 + j] + k[st * 48 + j] * vn; o += q[st * 48 + j] * S[j]; }
                y[st * 96 + F.tid] = o; }
        }
        __syncthreads();
        for (int i = F.tid; i < TS * 96; i += NTHR) { const int st = i / 96, n = i % 96; const int m = seq_row(b, dir, sbase + st); const bf16_t o = f2bf(y[i]);
            if (dir == 0) F.A[(size_t)m * DM + h * 96 + n] = o; else F.Z[(size_t)m * ZP + YB_OFF + h * 96 + n] = o; }
        __syncthreads();
    }
}
typedef short bf16x8 __attribute__((ext_vector_type(8)));
__device__ __forceinline__ void rwkv_stage(const bf16_t* PREP, LAS float* vecb, LAS float* vvb, int b, int dir, int h, int quarter, int wsel, int sbase, int lt) {
    constexpr int TS = 32;
    const int st = lt >> 3, part = lt & 7; const int m = seq_row(b, dir, sbase + st);
    const bf16_t* src = PREP + (size_t)m * 384 + h * 64 + part * 8;
    u32x4 raw[5];
    raw[0] = *(const u32x4*)(src + (size_t)PR_KK * PREP_STRIDE); raw[1] = *(const u32x4*)(src + (size_t)wsel * PREP_STRIDE); raw[2] = *(const u32x4*)(src + (size_t)PR_B * PREP_STRIDE);
    raw[3] = *(const u32x4*)(src + (size_t)PR_K * PREP_STRIDE); raw[4] = *(const u32x4*)(src + (size_t)PR_R * PREP_STRIDE);
    bf16_t vraw[2];
#pragma unroll
    for (int q = 0; q < 2; ++q) { const int idx = lt + 256 * q, s2 = idx >> 4, rr = idx & 15; const int m2 = seq_row(b, dir, sbase + s2);
        vraw[q] = PREP[(size_t)PR_V * PREP_STRIDE + (size_t)m2 * 384 + h * 64 + quarter * 16 + rr]; }
#pragma unroll
    for (int vi = 0; vi < 5; ++vi) { const u32x4 r = raw[vi]; f32x4 lo, hi;
        lo.x = __uint_as_float(r.x << 16); lo.y = __uint_as_float(r.x & 0xffff0000u); lo.z = __uint_as_float(r.y << 16); lo.w = __uint_as_float(r.y & 0xffff0000u);
        hi.x = __uint_as_float(r.z << 16); hi.y = __uint_as_float(r.z & 0xffff0000u); hi.z = __uint_as_float(r.w << 16); hi.w = __uint_as_float(r.w & 0xffff0000u);
        if (vi == 1) { lo = 1.0f - lo; hi = 1.0f - hi; }
        LAS float* dst = vecb + (vi * TS + st) * 64 + part * 8; *(LAS f32x4*)dst = lo; *(LAS f32x4*)(dst + 4) = hi; }
#pragma unroll
    for (int q = 0; q < 2; ++q) { const int idx = lt + 256 * q; vvb[idx] = bf2f(vraw[q]); }
}
__device__ __forceinline__ void rwkv_flush(bf16_t* A, bf16_t* Z, const LAS float* ybb, int b, int dir, int h, int quarter, int sbase, int lt) {
#pragma unroll
    for (int q = 0; q < 2; ++q) { const int idx = lt + 256 * q, st = idx >> 4, rr = idx & 15; const int m = seq_row(b, dir, sbase + st);
        const bf16_t o = f2bf(ybb[idx]);
        if (dir == 0) A[(size_t)m * DM + 384 + h * 64 + quarter * 16 + rr] = o; else Z[(size_t)m * ZP + YB_OFF + 384 + h * 64 + quarter * 16 + rr] = o; }
}
__device__ __forceinline__ void rwkv_scan_block(Frame& F, int chain, int quarter) {
    constexpr int TS = 32, NT = SEQT / TS;
    const int dir = chain & 1, h = (chain >> 1) % 6, b = (chain >> 1) / 6;
    LAS float* vec = (LAS float*)F.lds;
    LAS float* vv = vec + 2 * 5 * TS * 64;
    LAS float* yb = vv + 2 * TS * 16;
    const bool comp = F.wave < 4;
    const int rg = F.lane >> 4, lrow = (F.wave & 3) * 4 + rg, lt = F.tid - 256; int cgp = F.lane & 15;
    const int wsel = dir ? PR_WB : PR_WF;
    f32x2 sA = {0.f, 0.f}, sB = {0.f, 0.f};
    if (!comp) rwkv_stage(F.PREP, vec, vv, b, dir, h, quarter, wsel, 0, lt);
    __syncthreads();
    for (int tile = 0; tile < NT; ++tile) {
        const int cur = tile & 1;
        if (comp) {
            asm volatile("" : "+v"(cgp));
            const LAS float* vb = vec + cur * 5 * TS * 64 + cgp * 4; const LAS float* vvb = vv + cur * TS * 16 + lrow; LAS float* ybb = yb + cur * TS * 16;
            f32x4 kk_1 = *(const LAS f32x4*)(vb + (0 * TS) * 64), w_1 = *(const LAS f32x4*)(vb + (1 * TS) * 64), b_1 = *(const LAS f32x4*)(vb + (2 * TS) * 64);
            f32x4 k_1 = *(const LAS f32x4*)(vb + (3 * TS) * 64), r_1 = *(const LAS f32x4*)(vb + (4 * TS) * 64); float v_1 = vvb[0];
            f32x4 kk_2 = *(const LAS f32x4*)(vb + (0 * TS + 1) * 64), w_2 = *(const LAS f32x4*)(vb + (1 * TS + 1) * 64), b_2 = *(const LAS f32x4*)(vb + (2 * TS + 1) * 64);
            f32x4 k_2 = *(const LAS f32x4*)(vb + (3 * TS + 1) * 64), r_2 = *(const LAS f32x4*)(vb + (4 * TS + 1) * 64); float v_2 = vvb[16];
            float ypart = 0.f, yacc = 0.f;
#pragma unroll
            for (int st = 0; st < TS; ++st) {
                const f32x4 kk4 = kk_1, w4 = w_1, b4 = b_1, k4 = k_1, r4 = r_1; const float vr = v_1;
                kk_1 = kk_2; w_1 = w_2; b_1 = b_2; k_1 = k_2; r_1 = r_2; v_1 = v_2;
                if (st + 2 < TS) { kk_2 = *(const LAS f32x4*)(vb + (0 * TS + st + 2) * 64); w_2 = *(const LAS f32x4*)(vb + (1 * TS + st + 2) * 64); b_2 = *(const LAS f32x4*)(vb + (2 * TS + st + 2) * 64);
                    k_2 = *(const LAS f32x4*)(vb + (3 * TS + st + 2) * 64); r_2 = *(const LAS f32x4*)(vb + (4 * TS + st + 2) * 64); v_2 = vvb[(st + 2) * 16]; }
                const f32x2 p2 = sA * kk4.xy + sB * kk4.zw; float p = p2.x + p2.y;
                sA = sA * w4.xy + k4.xy * vr; sB = sB * w4.zw + k4.zw * vr;
                float yq = ypart;
                p += dpp_mov<0xB1>(p); yq += dpp_mov<0xB1>(yq);
                p += dpp_mov<0x4E>(p); yq += dpp_mov<0x4E>(yq);
                p += dpp_mov<0x141>(p); yq += dpp_mov<0x141>(yq);
                p += dpp_mov<0x140>(p); yq += dpp_mov<0x140>(yq);
                if (st > 0) { if (((st - 1) & 15) == 0) yacc = 0.f; yacc = (cgp == ((st - 1) & 15)) ? yq : yacc; if (((st - 1) & 15) == 15) ybb[((st - 1) & ~15) * 16 + cgp * 16 + lrow] = yacc; }
                sA = sA - b4.xy * p; sB = sB - b4.zw * p;
                const f32x2 y2 = sA * r4.xy + sB * r4.zw; ypart = y2.x + y2.y;
            }
            { float yq = reduce16(ypart); yacc = (cgp == 15) ? yq : yacc; ybb[16 * 16 + cgp * 16 + lrow] = yacc; }
        } else {
            if (tile + 1 < NT) rwkv_stage(F.PREP, vec + (cur ^ 1) * 5 * TS * 64, vv + (cur ^ 1) * TS * 16, b, dir, h, quarter, wsel, (tile + 1) * TS, lt);
            if (tile > 0) rwkv_flush(F.A, F.Z, yb + (cur ^ 1) * TS * 16, b, dir, h, quarter, (tile - 1) * TS, lt);
        }
        __syncthreads();
    }
    if (!comp) rwkv_flush(F.A, F.Z, yb + ((NT - 1) & 1) * TS * 16, b, dir, h, quarter, (NT - 1) * TS, lt);
}

namespace ce {
constexpr int PITCH = 72, IMG = 64 * PITCH * 2;
constexpr int VTB = 96 * PITCH * 2;
constexpr int O_QG = 0, O_KG = 2 * IMG, O_KET = 4 * IMG, O_VT = 6 * IMG, O_PB = O_VT + 2 * VTB, O_ST = O_PB + IMG, O_DEC = O_ST + 2 * VTB, O_WSUM = O_DEC + 512, O_END = O_WSUM + 8 * 48 * 4, O_W2 = O_END, O_END2 = O_W2 + 17 * 48 * 4;
static_assert(O_END2 <= 131072, "chunk engine LDS");
__device__ __forceinline__ bf16x8 frag(const LAS unsigned char* img, int row, int col) { return *(const LAS bf16x8*)(img + (row * PITCH + col) * 2); }
__device__ __forceinline__ void st4(LAS unsigned char* img, int row, int col, f32x4 v) { u32x2 w; w.x = pk2(v.x, v.y); w.y = pk2(v.z, v.w); *(LAS u32x2*)(img + (row * PITCH + col) * 2) = w; }
__device__ __forceinline__ f32x2 up2(unsigned u) { f32x2 r; r.x = __uint_as_float(u << 16); r.y = __uint_as_float(u & 0xffff0000u); return r; }

template <int DV> __device__ __forceinline__ void chunk_mma(Frame& F, LAS unsigned char* L, int cb, int sb, f32x4 (&acc_s)[DV / 32], int b, int dir, int cs, int ycol0) {
    constexpr int NQ = DV / 32;
    const int lane = F.lane, w = F.wave, lr = lane & 15, lq = lane >> 4;
    LAS unsigned char* Qg = L + O_QG + cb * IMG; LAS unsigned char* Kg = L + O_KG + cb * IMG; LAS unsigned char* KeT = L + O_KET + cb * IMG;
    LAS unsigned char* Vt = L + O_VT + cb * VTB; LAS unsigned char* Pb = L + O_PB; LAS unsigned char* St = L + O_ST + sb * VTB; LAS unsigned char* Sn = L + O_ST + (sb ^ 1) * VTB;
    const LAS float* dec = (const LAS float*)(L + O_DEC + cb * 256);
#pragma unroll
    for (int q = 0; q < 2; ++q) { const int idx = w + 8 * q; if (idx < 10) {
            const int jt = idx < 4 ? 0 : idx < 7 ? 1 : idx < 9 ? 2 : 3; const int it = idx < 4 ? idx : idx < 7 ? idx - 3 : idx < 9 ? idx - 5 : 3;
            f32x4 acc = {0.f, 0.f, 0.f, 0.f};
#pragma unroll
            for (int ks = 0; ks < 2; ++ks) acc = __builtin_amdgcn_mfma_f32_16x16x32_bf16(frag(Kg, jt * 16 + lr, 32 * ks + 8 * lq), frag(Qg, it * 16 + lr, 32 * ks + 8 * lq), acc, 0, 0, 0);
            if (jt == it) {
#pragma unroll
                for (int r = 0; r < 4; ++r) if (4 * lq + r > lr) acc[r] = 0.f; }
            st4(Pb, it * 16 + lr, jt * 16 + 4 * lq, acc); } }
    __syncthreads();
#pragma unroll
    for (int q = 0; q < NQ; ++q) { const int id = w + 8 * q, nt = id >> 2, it = id & 3;
        f32x4 acc = {0.f, 0.f, 0.f, 0.f};
#pragma unroll
        for (int ks = 0; ks < 2; ++ks) acc = __builtin_amdgcn_mfma_f32_16x16x32_bf16(frag(St, nt * 16 + lr, 32 * ks + 8 * lq), frag(Qg, it * 16 + lr, 32 * ks + 8 * lq), acc, 0, 0, 0);
#pragma unroll
        for (int ks = 0; ks < 2; ++ks) acc = __builtin_amdgcn_mfma_f32_16x16x32_bf16(frag(Vt, nt * 16 + lr, 32 * ks + 8 * lq), frag(Pb, it * 16 + lr, 32 * ks + 8 * lq), acc, 0, 0, 0);
        const int m = seq_row(b, dir, cs * 64 + it * 16 + lr); const int col = ycol0 + nt * 16 + 4 * lq;
        u32x2 o; o.x = pk2(acc.x, acc.y); o.y = pk2(acc.z, acc.w);
        if (dir == 0) *(u32x2*)(F.A + (size_t)m * DM + col) = o; else *(u32x2*)(F.Z + (size_t)m * ZP + YB_OFF + col) = o; }
#pragma unroll
    for (int q = 0; q < NQ; ++q) { const int id = w + 8 * q, kt = id & 3, nt = id >> 2;
        const f32x4 d4 = *(const LAS f32x4*)(dec + kt * 16 + 4 * lq);
        f32x4 acc = acc_s[q] * d4;
#pragma unroll
        for (int ks = 0; ks < 2; ++ks) acc = __builtin_amdgcn_mfma_f32_16x16x32_bf16(frag(KeT, kt * 16 + lr, 32 * ks + 8 * lq), frag(Vt, nt * 16 + lr, 32 * ks + 8 * lq), acc, 0, 0, 0);
        acc_s[q] = acc;
        st4(Sn, nt * 16 + lr, kt * 16 + 4 * lq, acc); }
}

__device__ __forceinline__ void ret_chain(Frame& F, int l, int chain) {
    constexpr int DV = 64, NCH = SEQT / 64;
    const int dir = chain & 1, h = (chain >> 1) & 3, b = chain >> 3;
    LAS unsigned char* L = F.lds;
    const int tp = F.tid >> 4, jj = F.tid & 15, t0 = 2 * tp, t1 = t0 + 1;
    const float lgam = -__expf(F.ap->in[I_RETLR][(l * 2 + dir) * 4 + h]);
    float eq[2], ek[2], ee[2];
#pragma unroll
    for (int e = 0; e < 2; ++e) { const float G = (float)(t0 + e + 1) * lgam; eq[e] = __expf(G); ek[e] = 0.125f * __expf(-G); ee[e] = 0.125f * __expf(64.0f * lgam - G); }
    const int d0 = 2 * jj;
    const bool rowb = d0 < 16; float inv[2];
#pragma unroll
    for (int e = 0; e < 2; ++e) inv[e] = powf(10000.0f, -(float)((d0 + e) & 15) * (1.0f / 16.0f));
    float ccs[2][2], csn[2][2];
#pragma unroll
    for (int tk = 0; tk < 2; ++tk)
#pragma unroll
        for (int e = 0; e < 2; ++e) { const float pos = (float)(dir ? 63 - (t0 + tk) : (t0 + tk)); sincosf(pos * inv[e], &csn[tk][e], &ccs[tk][e]); }
    for (int i = F.tid; i < IMG / 4; i += NTHR) ((LAS unsigned*)(L + O_PB))[i] = 0u;
    for (int i = F.tid; i < VTB / 4; i += NTHR) ((LAS unsigned*)(L + O_ST))[i] = 0u;
    if (F.tid < 128) ((LAS float*)(L + O_DEC))[F.tid] = __expf(64.0f * lgam);
    f32x4 acc_s[DV / 32];
#pragma unroll
    for (int q = 0; q < DV / 32; ++q) acc_s[q] = (f32x4){0.f, 0.f, 0.f, 0.f};
    unsigned rq[2][2], rk[2][2], rv[2][2];
    const bf16_t* Zc = F.Z + RET_OFF + h * 64 + d0;
#define RET_LOAD(cs_) do { _Pragma("unroll") for (int tk = 0; tk < 2; ++tk) { const int m = seq_row(b, dir, (cs_) * 64 + t0 + tk); const bf16_t* zr = Zc + (size_t)m * ZP; \
        rq[tk][0] = *(const unsigned*)(zr); rq[tk][1] = *(const unsigned*)(zr + 32); rk[tk][0] = *(const unsigned*)(zr + 256); rk[tk][1] = *(const unsigned*)(zr + 288); \
        rv[tk][0] = *(const unsigned*)(zr + 512); rv[tk][1] = *(const unsigned*)(zr + 544); } } while (0)
#define RET_STAGE(cs_, cb_) do { \
        LAS unsigned char* Qg = L + O_QG + (cb_) * IMG; LAS unsigned char* Kg = L + O_KG + (cb_) * IMG; LAS unsigned char* KeT = L + O_KET + (cb_) * IMG; LAS unsigned char* Vt = L + O_VT + (cb_) * VTB; \
        const bool lat = (cs_) >= 4; float rc[2] = {1.f, 1.f}, rs[2] = {0.f, 0.f}; \
        if (lat && rowb) { const float row = (float)(dir ? 127 - ((cs_) - 4) : (cs_) - 4); _Pragma("unroll") for (int e = 0; e < 2; ++e) { rs[e] = __sinf(row * inv[e]); rc[e] = __cosf(row * inv[e]); } } \
        f32x2 ke_lo[2], ke_hi[2], v_lo[2], v_hi[2]; \
        _Pragma("unroll") for (int tk = 0; tk < 2; ++tk) { \
            f32x2 q1 = up2(rq[tk][0]), q2 = up2(rq[tk][1]), k1 = up2(rk[tk][0]), k2 = up2(rk[tk][1]); \
            f32x2 c, s; if (rowb) { c.x = rc[0]; c.y = rc[1]; s.x = rs[0]; s.y = rs[1]; } else { c.x = lat ? ccs[tk][0] : 1.f; c.y = lat ? ccs[tk][1] : 1.f; s.x = lat ? csn[tk][0] : 0.f; s.y = lat ? csn[tk][1] : 0.f; } \
            const f32x2 qa = q1 * c - q2 * s, qb = q1 * s + q2 * c, ka = k1 * c - k2 * s, kb = k1 * s + k2 * c; \
            const int t = t0 + tk; \
            *(LAS unsigned*)(Qg + (t * PITCH + d0) * 2) = pk2(qa.x * eq[tk], qa.y * eq[tk]); *(LAS unsigned*)(Qg + (t * PITCH + d0 + 32) * 2) = pk2(qb.x * eq[tk], qb.y * eq[tk]); \
            *(LAS unsigned*)(Kg + (t * PITCH + d0) * 2) = pk2(ka.x * ek[tk], ka.y * ek[tk]); *(LAS unsigned*)(Kg + (t * PITCH + d0 + 32) * 2) = pk2(kb.x * ek[tk], kb.y * ek[tk]); \
            ke_lo[tk] = ka * ee[tk]; ke_hi[tk] = kb * ee[tk]; v_lo[tk] = up2(rv[tk][0]); v_hi[tk] = up2(rv[tk][1]); } \
        *(LAS unsigned*)(KeT + ((d0) * PITCH + t0) * 2) = pk2(ke_lo[0].x, ke_lo[1].x); *(LAS unsigned*)(KeT + ((d0 + 1) * PITCH + t0) * 2) = pk2(ke_lo[0].y, ke_lo[1].y); \
        *(LAS unsigned*)(KeT + ((d0 + 32) * PITCH + t0) * 2) = pk2(ke_hi[0].x, ke_hi[1].x); *(LAS unsigned*)(KeT + ((d0 + 33) * PITCH + t0) * 2) = pk2(ke_hi[0].y, ke_hi[1].y); \
        *(LAS unsigned*)(Vt + ((d0) * PITCH + t0) * 2) = pk2(v_lo[0].x, v_lo[1].x); *(LAS unsigned*)(Vt + ((d0 + 1) * PITCH + t0) * 2) = pk2(v_lo[0].y, v_lo[1].y); \
        *(LAS unsigned*)(Vt + ((d0 + 32) * PITCH + t0) * 2) = pk2(v_hi[0].x, v_hi[1].x); *(LAS unsigned*)(Vt + ((d0 + 33) * PITCH + t0) * 2) = pk2(v_hi[0].y, v_hi[1].y); \
    } while (0)
    RET_LOAD(0); RET_STAGE(0, 0);
    __syncthreads();
    for (int cs = 0; cs < NCH; ++cs) { const int cb = cs & 1;
        if (cs + 1 < NCH) RET_LOAD(cs + 1);
        chunk_mma<DV>(F, L, cb, cb, acc_s, b, dir, cs, 768 + h * 64);
        if (cs + 1 < NCH) RET_STAGE(cs + 1, cb ^ 1);
        __syncthreads();
    }
#undef RET_LOAD
#undef RET_STAGE
}

__device__ __forceinline__ void gla_chain(Frame& F, int l, int chain) {
    constexpr int DV = 96, NCH = SEQT / 64;
    const int dir = chain & 1, h = (chain >> 1) & 3, b = chain >> 3;
    LAS unsigned char* L = F.lds;
    const int t = F.tid >> 3, j8 = F.tid & 7, d0 = 2 * j8;
    const float qs = 0.14433756729740643f;
    for (int i = F.tid; i < O_END / 4; i += NTHR) ((LAS unsigned*)L)[i] = 0u;
    f32x4 acc_s[DV / 32];
#pragma unroll
    for (int q = 0; q < DV / 32; ++q) acc_s[q] = (f32x4){0.f, 0.f, 0.f, 0.f};
    unsigned rq[3], rk[3], rv[6]; f32x2 rg[3], rge[3];
    const bf16_t* Zc = F.Z + GLA_OFF + h * 48 + d0;
#define GLA_GP(m_) ((dir == 0 ? (const float*)(F.A + (size_t)(m_) * DM) : (const float*)(F.Z + (size_t)(m_) * ZP + YB_OFF)) + h * 48 + d0)
#define GLA_LOAD(cs_) do { const int m = seq_row(b, dir, (cs_) * 64 + t); const bf16_t* zr = Zc + (size_t)m * ZP; const bf16_t* zv = F.Z + (size_t)m * ZP + GLA_OFF + 384 + h * 96 + d0; \
        _Pragma("unroll") for (int q = 0; q < 3; ++q) { rq[q] = *(const unsigned*)(zr + 16 * q); rk[q] = *(const unsigned*)(zr + 192 + 16 * q); } \
        _Pragma("unroll") for (int q = 0; q < 6; ++q) rv[q] = *(const unsigned*)(zv + 16 * q); \
        const float* gp = GLA_GP(m); const float* ge = GLA_GP(seq_row(b, dir, (cs_) * 64 + 63)); \
        _Pragma("unroll") for (int q = 0; q < 3; ++q) { rg[q] = *(const f32x2*)(gp + 16 * q); rge[q] = *(const f32x2*)(ge + 16 * q); } } while (0)
#define GLA_STAGE(cs_, cb_) do { \
        LAS unsigned char* Qg = L + O_QG + (cb_) * IMG; LAS unsigned char* Kg = L + O_KG + (cb_) * IMG; LAS unsigned char* KeT = L + O_KET + (cb_) * IMG; LAS unsigned char* Vt = L + O_VT + (cb_) * VTB; \
        if (t == 0) { _Pragma("unroll") for (int q = 0; q < 3; ++q) *(LAS f32x2*)((LAS float*)(L + O_DEC + (cb_) * 256) + d0 + 16 * q) = (f32x2){__expf(rge[q].x), __expf(rge[q].y)}; } \
        _Pragma("unroll") for (int q = 0; q < 3; ++q) { const f32x2 qv = up2(rq[q]), kv = up2(rk[q]); const int d = d0 + 16 * q; const float g0 = rg[q].x, g1 = rg[q].y; \
            const float eq0 = __expf(g0) * qs, eq1 = __expf(g1) * qs, ek0 = __expf(-g0), ek1 = __expf(-g1), ee0 = __expf(rge[q].x - g0), ee1 = __expf(rge[q].y - g1); \
            *(LAS unsigned*)(Qg + (t * PITCH + d) * 2) = pk2(qv.x * eq0, qv.y * eq1); *(LAS unsigned*)(Kg + (t * PITCH + d) * 2) = pk2(kv.x * ek0, kv.y * ek1); \
            *(LAS bf16_t*)(KeT + (d * PITCH + t) * 2) = f2bf(kv.x * ee0); *(LAS bf16_t*)(KeT + ((d + 1) * PITCH + t) * 2) = f2bf(kv.y * ee1); } \
        _Pragma("unroll") for (int q = 0; q < 6; ++q) { const int d = d0 + 16 * q; *(LAS bf16_t*)(Vt + (d * PITCH + t) * 2) = (bf16_t)(rv[q] & 0xffffu); *(LAS bf16_t*)(Vt + ((d + 1) * PITCH + t) * 2) = (bf16_t)(rv[q] >> 16); } \
    } while (0)
    __syncthreads();
    GLA_LOAD(0); GLA_STAGE(0, 0);
    __syncthreads();
    for (int cs = 0; cs < NCH; ++cs) { const int cb = cs & 1;
        if (cs + 1 < NCH) GLA_LOAD(cs + 1);
        chunk_mma<DV>(F, L, cb, cb, acc_s, b, dir, cs, h * 96);
        if (cs + 1 < NCH) GLA_STAGE(cs + 1, cb ^ 1);
        __syncthreads();
    }
#undef GLA_LOAD
#undef GLA_STAGE
#undef GLA_GP
}
}

#ifndef PROBE_DUP
#define PROBE_DUP 0
#endif
__device__ __forceinline__ void phase_scan(Frame& F, int l) {
    for (int task = F.bid; task < 256; task += F.G) {
        if ((PROBE_DUP & 32) && task < 192) { rwkv_scan_block(F, task >> 2, task & 3); __syncthreads(); }
        if ((PROBE_DUP & 64) && task >= 192 && task < 224) { ce::gla_chain(F, l, task - 192); __syncthreads(); }
        if ((PROBE_DUP & 128) && task >= 224) { ce::ret_chain(F, l, task - 224); __syncthreads(); }
        if (task < 192) rwkv_scan_block(F, task >> 2, task & 3);
        else if (task < 224) {
#if SCAN_GLA_V0
            gla_scan_block(F, l, task - 192);
#else
            ce::gla_chain(F, l, task - 192);
#endif
        } else ce::ret_chain(F, l, task - 224);
        __syncthreads();
    }
}
namespace pp {
constexpr int OSP = 392;
__device__ __forceinline__ bf16x8 pack8(const float (&w)[8]) { u32x4 u; u.x = pk2(w[0], w[1]); u.y = pk2(w[2], w[3]); u.z = pk2(w[4], w[5]); u.w = pk2(w[6], w[7]); return __builtin_bit_cast(bf16x8, u); }
__device__ __forceinline__ void unpack8(u32x4 r, float (&o)[8]) {
    o[0] = __uint_as_float(r.x << 16); o[1] = __uint_as_float(r.x & 0xffff0000u); o[2] = __uint_as_float(r.y << 16); o[3] = __uint_as_float(r.y & 0xffff0000u);
    o[4] = __uint_as_float(r.z << 16); o[5] = __uint_as_float(r.z & 0xffff0000u); o[6] = __uint_as_float(r.w << 16); o[7] = __uint_as_float(r.w & 0xffff0000u); }
__device__ __forceinline__ u32x4 pack8u(const float (&w)[8]) { u32x4 u; u.x = pk2(w[0], w[1]); u.y = pk2(w[2], w[3]); u.z = pk2(w[4], w[5]); u.w = pk2(w[6], w[7]); return u; }
__device__ __forceinline__ void shift8(const bf16_t* p, const ZNb& n, const float* mu8  , float (&o)[8]) {
    const u32x4 c = *(const u32x4*)p, n0 = *(const u32x4*)(p + n.o[0]), n1 = *(const u32x4*)(p + n.o[1]), n2 = *(const u32x4*)(p + n.o[2]), n3 = *(const u32x4*)(p + n.o[3]);
    float zc[8], a0[8], a1[8], a2[8], a3[8]; unpack8(c, zc); unpack8(n0, a0); unpack8(n1, a1); unpack8(n2, a2); unpack8(n3, a3);
#pragma unroll
    for (int e = 0; e < 8; ++e) { const float nb = (a0[e] * n.w[0] + a1[e] * n.w[1]) + (a2[e] * n.w[2] + a3[e] * n.w[3]); o[e] = zc[e] + mu8[e] * (nb - zc[e]); }
}

__device__ __forceinline__ void phase_prep(Frame& F, int l) {
    constexpr int ZSP = 488;
    LAS unsigned char* L = F.lds;
    LAS bf16_t* zs = (LAS bf16_t*)L;
    LAS bf16_t* os = (LAS bf16_t*)(L + 16 * ZSP * 2);
    LAS float* mus = (LAS float*)(L + 16 * ZSP * 2 + 5 * 16 * OSP * 2);
    const float* mu = F.ap->in[I_RMU] + l * 1312;
    for (int i = F.tid; i < 1248; i += NTHR) mus[i] = mu[i];
    const int lr = F.lane & 15, lq = F.lane >> 4, h = F.wave;
    bf16x8 Bf[4], Bb[4], Ba[4]; float w0f[4], w0b[4], a0[4], kk_[4], ka_[4];
    if (h < 6) {
#pragma unroll
        for (int nt = 0; nt < 4; ++nt) { const int col = h * 64 + 16 * nt + lr; float t0[8], t1[8], t2[8];
#pragma unroll
            for (int j = 0; j < 8; ++j) { const int k = 8 * lq + j; t0[j] = F.ap->in[I_RW2][((size_t)(l * 2 + 0) * 32 + k) * 384 + col]; t1[j] = F.ap->in[I_RW2][((size_t)(l * 2 + 1) * 32 + k) * 384 + col]; t2[j] = F.ap->in[I_RA2][((size_t)l * 32 + k) * 384 + col]; }
            Bf[nt] = pack8(t0); Bb[nt] = pack8(t1); Ba[nt] = pack8(t2);
            w0f[nt] = F.ap->in[I_RW0][(l * 2 + 0) * 384 + col]; w0b[nt] = F.ap->in[I_RW0][(l * 2 + 1) * 384 + col]; a0[nt] = F.ap->in[I_RA0][l * 384 + col];
            kk_[nt] = F.ap->in[I_RKK][l * 384 + col]; ka_[nt] = F.ap->in[I_RKA][l * 384 + col]; }
    }
    __syncthreads();
    for (int it = F.bid; it < MT / 16; it += F.G) {
        const int m0 = it * 16;
        for (int p = F.tid; p < 16 * 156; p += NTHR) { const int tok = p / 156, gi = p - tok * 156, col0 = gi * 8, m = m0 + tok;
            const ZNb nbv = znb(m); float o[8]; float mu8[8];
#pragma unroll
            for (int e = 0; e < 8; ++e) mu8[e] = mus[col0 + e];
            shift8(F.Z + (size_t)m * ZP + RW_OFF + col0, nbv, mu8, o);
            if (col0 < 384) *(u32x4*)(F.PREP + PR_R * PREP_STRIDE + (size_t)m * 384 + col0) = pack8u(o);
            else if (col0 < 768) *(LAS u32x4*)(zs + tok * ZSP + (col0 - 384)) = pack8u(o);
            else if (col0 < 1152) *(u32x4*)(F.PREP + PR_V * PREP_STRIDE + (size_t)m * 384 + (col0 - 768)) = pack8u(o);
            else { if (col0 < 1216) {
#pragma unroll
                    for (int e = 0; e < 8; ++e) o[e] = fast_tanh(o[e]); }
                *(LAS u32x4*)(zs + tok * ZSP + 384 + (col0 - 1152)) = pack8u(o); }
        }
        __syncthreads();
        if (h < 6) {
            const bf16x8 af = *(const LAS bf16x8*)(zs + lr * ZSP + 384 + 8 * lq), ab = *(const LAS bf16x8*)(zs + lr * ZSP + 416 + 8 * lq), aa = *(const LAS bf16x8*)(zs + lr * ZSP + 448 + 8 * lq);
            float kv[4][4], kkv[4][4], av[4][4]; float ss[4] = {0.f, 0.f, 0.f, 0.f};
#pragma unroll
            for (int nt = 0; nt < 4; ++nt) { const f32x4 z4 = {0.f, 0.f, 0.f, 0.f};
                const f32x4 xf = __builtin_amdgcn_mfma_f32_16x16x32_bf16(af, Bf[nt], z4, 0, 0, 0), xb = __builtin_amdgcn_mfma_f32_16x16x32_bf16(ab, Bb[nt], z4, 0, 0, 0), xa = __builtin_amdgcn_mfma_f32_16x16x32_bf16(aa, Ba[nt], z4, 0, 0, 0);
                const int cl = h * 64 + 16 * nt + lr;
#pragma unroll
                for (int r = 0; r < 4; ++r) { const int tok = 4 * lq + r;
                    const float k = bf2f(zs[tok * ZSP + cl]);
                    const float ef = sigmoidf_(xf[r] + w0f[nt]) * 0.6065306597f, eb = sigmoidf_(xb[r] + w0b[nt]) * 0.6065306597f;
                    os[(0 * 16 + tok) * OSP + cl] = f2bf(1.0f - __expf(-ef)); os[(1 * 16 + tok) * OSP + cl] = f2bf(1.0f - __expf(-eb));
                    const float a = sigmoidf_(xa[r] + a0[nt]); const float kx = k * kk_[nt];
                    kv[nt][r] = k; kkv[nt][r] = kx; av[nt][r] = a; ss[r] += kx * kx; } }
#pragma unroll
            for (int r = 0; r < 4; ++r) ss[r] = rsqrtf(reduce16(ss[r]) + 1e-12f);
#pragma unroll
            for (int nt = 0; nt < 4; ++nt) { const int cl = h * 64 + 16 * nt + lr;
#pragma unroll
                for (int r = 0; r < 4; ++r) { const int tok = 4 * lq + r; const float kk = kkv[nt][r] * ss[r], a = av[nt][r];
                    os[(2 * 16 + tok) * OSP + cl] = f2bf(kv[nt][r] * (1.f + (a - 1.f) * ka_[nt])); os[(3 * 16 + tok) * OSP + cl] = f2bf(kk); os[(4 * 16 + tok) * OSP + cl] = f2bf(kk * a); } }
        }
        __syncthreads();
        for (int p = F.tid; p < 5 * 16 * 48; p += NTHR) { const int t = p / 768, rem = p - t * 768, tok = rem / 48, pc = rem - tok * 48;
            const int ts = t == 0 ? PR_WF : t == 1 ? PR_WB : t == 2 ? PR_K : t == 3 ? PR_KK : PR_B;
            *(u32x4*)(F.PREP + (size_t)ts * PREP_STRIDE + (size_t)(m0 + tok) * 384 + pc * 8) = *(const LAS u32x4*)(os + (t * 16 + tok) * OSP + pc * 8); }
    }
}

__device__ __forceinline__ void gla_gate_units(Frame& F, int l) {
    LAS float* lrs = (LAS float*)F.lds;
    LAS float* qsum = lrs + 64 * 16;
    const int dp = F.tid % 96, tq = F.tid / 96;
    for (int it = F.bid; it < NB * 2 * (SEQT / 64); it += F.G) {
        const int b = it / (2 * (SEQT / 64)), rem = it - b * (2 * (SEQT / 64)), dir = rem / (SEQT / 64), cs = rem - dir * (SEQT / 64);
#pragma unroll
        for (int q = 0; q < 2; ++q) { const int idx = F.tid + NTHR * q, tok = idx >> 4, r = idx & 15; const int m = seq_row(b, dir, cs * 64 + tok);
            lrs[idx] = bf2f(F.Z[(size_t)m * ZP + GLA_OFF + 1152 + dir * 16 + r]); }
        f32x2 w[16], bias = {0.f, 0.f};
        if (tq < 4) { const float* W2 = F.ap->in[I_GGW2] + (size_t)(l * 2 + dir) * 16 * 192 + 2 * dp;
#pragma unroll
            for (int r = 0; r < 16; ++r) w[r] = *(const f32x2*)(W2 + r * 192);
            bias = *(const f32x2*)(F.ap->in[I_GGB] + (l * 2 + dir) * 192 + 2 * dp); }
        __syncthreads();
        f32x2 Gv[16]; f32x2 run = {0.f, 0.f};
        if (tq < 4) {
#pragma unroll
            for (int i = 0; i < 16; ++i) { const LAS float* lp = lrs + (tq * 16 + i) * 16; f32x2 x = bias;
#pragma unroll
                for (int r = 0; r < 16; ++r) x += w[r] * lp[r];
                f32x2 ls; ls.x = (fminf(x.x, 0.f) - __logf(1.0f + __expf(-fabsf(x.x)))) * (1.0f / 16.0f); ls.y = (fminf(x.y, 0.f) - __logf(1.0f + __expf(-fabsf(x.y)))) * (1.0f / 16.0f);
                run += ls; Gv[i] = run; }
            *(LAS f32x2*)(qsum + tq * 192 + 2 * dp) = run;
        }
        __syncthreads();
        if (tq < 4) { f32x2 off = {0.f, 0.f};
#pragma unroll
            for (int q = 0; q < 3; ++q) if (q < tq) off += *(const LAS f32x2*)(qsum + q * 192 + 2 * dp);
#pragma unroll
            for (int i = 0; i < 16; ++i) { const int m = seq_row(b, dir, cs * 64 + tq * 16 + i);
                float* dst = (dir == 0 ? (float*)(F.A + (size_t)m * DM) : (float*)(F.Z + (size_t)m * ZP + YB_OFF)) + 2 * dp;
                *(f32x2*)dst = Gv[i] + off; }
        }
    }
}

__device__ __forceinline__ void phase_post(Frame& F, int l, int Mrows) {
    constexpr int SGP = 72;
    LAS unsigned char* L = F.lds;
    LAS bf16_t* in5 = (LAS bf16_t*)L;
    LAS bf16_t* sgs = (LAS bf16_t*)(L + 5 * 16 * OSP * 2);
    LAS bf16_t* outs = (LAS bf16_t*)(L + 5 * 16 * OSP * 2 + 16 * SGP * 2);
    const float* mu = F.ap->in[I_RMU] + l * 1312 + 1248;
    const int lr = F.lane & 15, lq = F.lane >> 4, h = F.wave;
    bf16x8 Bg[4][2]; float lng[4], lnb[4], rk[4];
    if (h < 6) {
#pragma unroll
        for (int nt = 0; nt < 4; ++nt) { const int col = h * 64 + 16 * nt + lr;
#pragma unroll
            for (int ks = 0; ks < 2; ++ks) { float t0[8];
#pragma unroll
                for (int j = 0; j < 8; ++j) t0[j] = F.ap->in[I_RG2][((size_t)l * 64 + 32 * ks + 8 * lq + j) * 384 + col];
                Bg[nt][ks] = pack8(t0); }
            lng[nt] = F.ap->in[I_RLNG][l * 384 + col]; lnb[nt] = F.ap->in[I_RLNB][l * 384 + col]; rk[nt] = F.ap->in[I_RRK][l * 384 + col]; }
    }
    for (int it = F.bid; it < Mrows / 16; it += F.G) {
        const int m0 = it * 16;
        for (int p = F.tid; p < 5 * 16 * 48; p += NTHR) { const int t = p / 768, rem = p - t * 768, tok = rem / 48, pc = rem - tok * 48; const int m = m0 + tok;
            const bf16_t* src = t == 0 ? F.A + (size_t)m * DM + 384 + pc * 8 : t == 1 ? F.Z + (size_t)m * ZP + YB_OFF + 384 + pc * 8
                              : F.PREP + (size_t)(t == 2 ? PR_R : t == 3 ? PR_K : PR_V) * PREP_STRIDE + (size_t)m * 384 + pc * 8;
            *(LAS u32x4*)(in5 + (t * 16 + tok) * OSP + pc * 8) = *(const u32x4*)src; }
        if (F.tid < 128) { const int tok = F.tid >> 3, gi = F.tid & 7, m = m0 + tok; const ZNb nbv = znb(m); float o[8], mu8[8];
#pragma unroll
            for (int e = 0; e < 8; ++e) mu8[e] = mu[gi * 8 + e];
            shift8(F.Z + (size_t)m * ZP + RW_OFF + 1248 + gi * 8, nbv, mu8, o);
#pragma unroll
            for (int e = 0; e < 8; ++e) o[e] = sigmoidf_(o[e]);
            *(LAS u32x4*)(sgs + tok * SGP + gi * 8) = pack8u(o); }
        __syncthreads();
        if (h < 6) {
            const bf16x8 a0 = *(const LAS bf16x8*)(sgs + lr * SGP + 8 * lq), a1 = *(const LAS bf16x8*)(sgs + lr * SGP + 32 + 8 * lq);
            float yv[4][4], gt[4][4]; float s1[4] = {0.f, 0.f, 0.f, 0.f}, s2[4] = {0.f, 0.f, 0.f, 0.f}, s3[4] = {0.f, 0.f, 0.f, 0.f};
#pragma unroll
            for (int nt = 0; nt < 4; ++nt) { f32x4 g4 = {0.f, 0.f, 0.f, 0.f};
                g4 = __builtin_amdgcn_mfma_f32_16x16x32_bf16(a0, Bg[nt][0], g4, 0, 0, 0); g4 = __builtin_amdgcn_mfma_f32_16x16x32_bf16(a1, Bg[nt][1], g4, 0, 0, 0);
                const int cl = h * 64 + 16 * nt + lr;
#pragma unroll
                for (int r = 0; r < 4; ++r) { const int tok = 4 * lq + r;
                    const float y = bf2f(in5[(0 * 16 + tok) * OSP + cl]) + bf2f(in5[(1 * 16 + tok) * OSP + cl]);
                    yv[nt][r] = y; gt[nt][r] = g4[r]; s1[r] += y; s2[r] += y * y;
                    s3[r] += bf2f(in5[(2 * 16 + tok) * OSP + cl]) * bf2f(in5[(3 * 16 + tok) * OSP + cl]) * rk[nt]; } }
#pragma unroll
            for (int r = 0; r < 4; ++r) { s1[r] = reduce16(s1[r]) * (1.f / 64.f); s2[r] = reduce16(s2[r]) * (1.f / 64.f); s3[r] = reduce16(s3[r]);
                s2[r] = rsqrtf(fmaxf(s2[r] - s1[r] * s1[r], 0.f) + 64e-5f); }
#pragma unroll
            for (int nt = 0; nt < 4; ++nt) { const int cl = h * 64 + 16 * nt + lr;
#pragma unroll
                for (int r = 0; r < 4; ++r) { const int tok = 4 * lq + r;
                    const float yn = (yv[nt][r] - s1[r]) * s2[r] * lng[nt] + lnb[nt]; const float bon = s3[r] * bf2f(in5[(4 * 16 + tok) * OSP + cl]);
                    outs[tok * OSP + cl] = f2bf((yn + bon) * gt[nt][r]); } }
        } else {
            const int u = F.tid - 384, tok = u >> 3, hu = u & 7, m = m0 + tok; const bool gla = hu < 4;
            const int ycol = gla ? hu * 96 : 768 + (hu - 4) * 64, gcol = gla ? GLA_OFF + 768 + hu * 96 : RET_OFF + 768 + (hu - 4) * 64, npc = gla ? 12 : 8;
            const float* gain = gla ? F.ap->in[I_GNG] + l * 384 + hu * 96 : F.ap->in[I_RETNG] + l * 256 + (hu - 4) * 64;
            bf16_t* ar = F.A + (size_t)m * DM + ycol; const bf16_t* zb = F.Z + (size_t)m * ZP + YB_OFF + ycol; const bf16_t* zg = F.Z + (size_t)m * ZP + gcol;
            u32x4 ypk[12]; float ssq = 0.f;
#pragma unroll
            for (int pc = 0; pc < 12; ++pc) { if (pc < npc) { float a[8], b[8]; unpack8(*(const u32x4*)(ar + pc * 8), a); unpack8(*(const u32x4*)(zb + pc * 8), b);
#pragma unroll
                    for (int e = 0; e < 8; ++e) { a[e] += b[e]; ssq += a[e] * a[e]; }
                    ypk[pc] = pack8u(a); } }
            const float rn = rsqrtf(ssq / (float)(npc * 8) + 1e-6f);
#pragma unroll
            for (int pc = 0; pc < 12; ++pc) { if (pc < npc) { float y[8], g[8]; unpack8(ypk[pc], y); unpack8(*(const u32x4*)(zg + pc * 8), g);
                    const f32x4 g0 = *(const f32x4*)(gain + pc * 8), g1 = *(const f32x4*)(gain + pc * 8 + 4); const float gg[8] = {g0.x, g0.y, g0.z, g0.w, g1.x, g1.y, g1.z, g1.w};
#pragma unroll
                    for (int e = 0; e < 8; ++e) y[e] = siluf_(g[e]) * y[e] * rn * gg[e];
                    *(u32x4*)(ar + pc * 8) = pack8u(y); } }
        }
        __syncthreads();
        for (int p = F.tid; p < 16 * 48; p += NTHR) { const int tok = p / 48, pc = p - tok * 48;
            *(u32x4*)(F.A + (size_t)(m0 + tok) * DM + 384 + pc * 8) = *(const LAS u32x4*)(outs + tok * OSP + pc * 8); }
    }
}
}
using pp::phase_prep;
using pp::phase_post;
constexpr int PH_PER_LAYER = 9, N_PHASES = 1 + DEPTH * PH_PER_LAYER + 1;
#define PHASE_ENTER() \
    CArgs ap = (CArgs)__builtin_amdgcn_kernarg_segment_ptr(); asm volatile("" : "+s"(ap)); \
    int tid = threadIdx.x; asm volatile("" : "+v"(tid)); \
    Frame F; F.lds = lds; F.ap = ap; F.tid = tid; F.lane = tid & 63; F.wave = __builtin_amdgcn_readfirstlane(tid >> 6); F.bid = blockIdx.x; F.G = gridDim.x; \
    unsigned char* ws = ap->ws; F.out = ap->out; F.ws = ws; \
    F.mod = (float*)(ws + WS_MOD); F.Win_t = (bf16_t*)(ws + WS_WIN); F.Wout_t = (bf16_t*)(ws + WS_WOUT); F.W1_t = (bf16_t*)(ws + WS_W1); F.W2_t = (bf16_t*)(ws + WS_W2); \
    F.xc = (float*)(ws + WS_XC); F.A = (bf16_t*)(ws + WS_ABUF); F.Z = (bf16_t*)(ws + WS_Z); F.PREP = (bf16_t*)(ws + WS_PREP); F.H = (bf16_t*)(ws + WS_H); \
    const float* modl = F.mod + (size_t)L * 5 * 6144; (void)modl; \
    const float* xl_in = L == 0 ? F.ap->in[I_X] : F.out; const float* xc_in = L == 0 ? F.ap->in[I_CTX] : F.xc; (void)xl_in; (void)xc_in;

#ifndef PROBE_DUP
#define PROBE_DUP 0
#endif
#define IN(k) (lo <= (k) && (k) < hi)
#define SEAM(k) do { if (IN(k) && IN((k) + 1)) { if ((k) == 0) grid.sync(); else xcd_barrier(bar); if (PROBE_DUP & 16) xcd_barrier(bar); } } while (0)
template <int L> __device__ __forceinline__ void run_layer(int lo, int hi, LAS unsigned char* lds, cg::grid_group& grid, const XcdBarrier& bar) {
    constexpr int p0 = 1 + L * PH_PER_LAYER; constexpr bool last = (L == DEPTH - 1); constexpr int Mo = last ? ML : MT;
    if (IN(p0 + 0)) { PHASE_ENTER(); phase_wconv(F, L); phase_norm(F, xl_in, xc_in, F.ap->in[I_N1G] + L * DM, modl, 0, 1, MT); } SEAM(p0 + 0);
    if (PROBE_DUP & 4) { if (IN(p0 + 0)) { PHASE_ENTER(); phase_wconv(F, L); phase_norm(F, xl_in, xc_in, F.ap->in[I_N1G] + L * DM, modl, 0, 1, MT); } SEAM(p0 + 0); }
    if (IN(p0 + 1)) { PHASE_ENTER(); pg8::Gemm g{F.A, F.Win_t, MT, ZP, DM}; pg8::StaticOrder S; S.init(MT, ZP, F.G, F.bid); pg8::EpiBf16<0> E{F.Z, ZP};
        pg8::gemm_phase<pg8::EpiBf16<0>, pg8::StaticOrder, true, true>(F.lds, g, S, E, tid); if (PROBE_DUP & 8) { grid.sync(); pg8::gemm_phase<pg8::EpiBf16<0>, pg8::StaticOrder, true, true>(F.lds, g, S, E, tid); } } SEAM(p0 + 1);
    if (IN(p0 + 2)) { PHASE_ENTER(); phase_prep(F, L); xcd_barrier(bar);   pp::gla_gate_units(F, L); } SEAM(p0 + 2);
    if (IN(p0 + 3)) { PHASE_ENTER(); phase_scan(F, L); if (PROBE_DUP & 1) { grid.sync(); phase_scan(F, L); } } SEAM(p0 + 3);
    if (IN(p0 + 4)) { PHASE_ENTER(); phase_post(F, L, Mo); } SEAM(p0 + 4);
    if (IN(p0 + 5)) { PHASE_ENTER(); pg8::Gemm g{F.A, F.Wout_t, Mo, DM, DM}; pg8::StaticOrder S; S.init(Mo, DM, F.G, F.bid); pg8::EpiRes E{xl_in, xc_in, F.out, F.xc, modl + 2 * 1024};
        pg8::gemm_phase<pg8::EpiRes, pg8::StaticOrder, true, true>(F.lds, g, S, E, tid); } SEAM(p0 + 5);
    if (IN(p0 + 6)) { PHASE_ENTER(); phase_norm(F, F.out, F.xc, F.ap->in[I_N2G] + L * DM, modl, 3, 4, Mo); if (PROBE_DUP & 4) { grid.sync(); phase_norm(F, F.out, F.xc, F.ap->in[I_N2G] + L * DM, modl, 3, 4, Mo); } } SEAM(p0 + 6);
    if (IN(p0 + 7)) { PHASE_ENTER(); pg8::Gemm g{F.A, F.W1_t, Mo, DFF, DM}; pg8::StaticOrder S; S.init(Mo, DFF, F.G, F.bid); pg8::EpiBf16<2> E{F.H, DFF};
        pg8::gemm_phase<pg8::EpiBf16<2>, pg8::StaticOrder, true, true>(F.lds, g, S, E, tid); if (PROBE_DUP & 8) { grid.sync(); pg8::gemm_phase<pg8::EpiBf16<2>, pg8::StaticOrder, true, true>(F.lds, g, S, E, tid); } } SEAM(p0 + 7);
    if (IN(p0 + 8)) { PHASE_ENTER(); pg8::Gemm g{F.H, F.W2_t, Mo, DM, DFF}; pg8::StaticOrder S; S.init(Mo, DM, F.G, F.bid); pg8::EpiRes E{F.out, F.xc, F.out, F.xc, modl + 5 * 1024};
        pg8::gemm_phase<pg8::EpiRes, pg8::StaticOrder, true, true>(F.lds, g, S, E, tid); } SEAM(p0 + 8);
}
__global__ void __launch_bounds__(NTHR, 2) mega_fwd(Args args) {
    extern __shared__ __attribute__((aligned(16))) unsigned char lds_raw[];
    LAS unsigned char* lds = (LAS unsigned char*)lds_raw;
    const int lo = args.ph_lo, hi = args.ph_hi;
    cg::grid_group grid = cg::this_grid();
    volatile LAS unsigned* misc = (volatile LAS unsigned*)(lds + LDS_BYTES - 256);
    if (threadIdx.x < 4) misc[threadIdx.x] = 0u;
    __syncthreads();
    const XcdBarrier bar = xcd_barrier_post((unsigned*)(args.ws + WS_CTL) + 1024, misc);
    { constexpr int L = 0; if (IN(0)) { PHASE_ENTER(); phase_mod(F); } SEAM(0); }
    run_layer<0>(lo, hi, lds, grid, bar);
    run_layer<1>(lo, hi, lds, grid, bar);
    { constexpr int L = 0; if (IN(N_PHASES - 1)) { PHASE_ENTER(); phase_final(F); } }
}
#undef IN
#undef SEAM

extern "C" void kernel_launch(void* const* d_in, const int* in_sizes, int n_in, void* d_out, int out_size, void* d_ws, size_t ws_size, hipStream_t stream) {
    static int grid = 0;
    if (grid == 0) {
        int dev = 0, cus = 0, per_cu = 0;
        hipGetDevice(&dev); hipDeviceGetAttribute(&cus, hipDeviceAttributeMultiprocessorCount, dev);
        hipFuncSetAttribute((const void*)mega_fwd, hipFuncAttributeMaxDynamicSharedMemorySize, LDS_BYTES);
        hipOccupancyMaxActiveBlocksPerMultiprocessor(&per_cu, (const void*)mega_fwd, NTHR, LDS_BYTES);
        if (per_cu < 1) { fprintf(stderr, "kernel_launch: occupancy query says %d blocks per CU\n", per_cu); per_cu = 1; }
        (void)hipGetLastError();
        grid = cus * per_cu;
        if (n_in != 29 || ws_size < WS_END) fprintf(stderr, "kernel_launch: unexpected n_in %d / ws_size %zu (need %zu)\n", n_in, ws_size, (size_t)WS_END);
    }
    Args a{};
    for (int i = 0; i < 29; ++i) a.in[i] = (const float*)d_in[i];
    a.out = (float*)d_out; a.ws = (unsigned char*)d_ws;
#if MK_ONE_LAUNCH
    (void)hipMemsetAsync((char*)d_ws + WS_CTL, 0, 65536, stream);
    a.ph_lo = 0; a.ph_hi = N_PHASES;
    void* kargs[] = {&a};
    hipError_t e = hipLaunchCooperativeKernel((const void*)mega_fwd, dim3(grid), dim3(NTHR), kargs, LDS_BYTES, stream);
    if (e != hipSuccess) fprintf(stderr, "cooperative launch failed: %s (grid %d)\n", hipGetErrorString(e), grid);
#else
    for (int ph = 0; ph < N_PHASES; ++ph) { a.ph_lo = ph; a.ph_hi = ph + 1;
        hipLaunchKernelGGL(mega_fwd, dim3(grid), dim3(NTHR), LDS_BYTES, stream, a); }
#endif
}
```

```cpp
#include <hip/hip_runtime.h>
#include <hip/hip_cooperative_groups.h>
#include <cstdio>
#include <cstdint>
namespace cg = cooperative_groups;

#ifndef MK_ONE_LAUNCH
#define MK_ONE_LAUNCH 1
#endif

#define LAS __attribute__((address_space(3)))
#define GAS __attribute__((address_space(1)))
typedef unsigned short bf16_t;
typedef float f32x4 __attribute__((ext_vector_type(4)));
typedef float f32x2 __attribute__((ext_vector_type(2)));
typedef unsigned u32x4 __attribute__((ext_vector_type(4)));
typedef unsigned u32x2 __attribute__((ext_vector_type(2)));

constexpr int DM = 1024, NB = 4, SEQ = 8192, CTXL = 256, DEPTH = 2, DFF = 4096;
constexpr int ML = NB * SEQ, MC = NB * CTXL, MT = ML + MC;
constexpr int INC = 3520, ZP = 3584;
constexpr int GLA_OFF = 0, RW_OFF = 1184, RET_OFF = 2496;
constexpr int YB_OFF = RW_OFF;
constexpr int SEQT = CTXL + SEQ;
constexpr int NTHR = 512, NWAVES = 8;

constexpr size_t MiB = 1u << 20;
constexpr size_t WS_CTL = 0, CTL_BYTES = 1 * MiB;
constexpr size_t WS_MOD = 1 * MiB;
constexpr size_t WS_WIN = 2 * MiB, WS_WOUT = 9 * MiB, WS_W1 = 11 * MiB, WS_W2 = 19 * MiB;
constexpr size_t WS_XC = 27 * MiB;
constexpr size_t WS_ABUF = 32 * MiB;
constexpr size_t WS_Z = 98 * MiB;
constexpr size_t WS_PREP = 329 * MiB;
constexpr size_t PREP_STRIDE = (size_t)MT * 384;
constexpr size_t WS_H = 98 * MiB;
constexpr size_t WS_END = WS_PREP + 7 * PREP_STRIDE * 2;
static_assert(WS_ABUF + (size_t)MT * DM * 2 <= WS_Z, "ws map");
static_assert(WS_Z + (size_t)MT * ZP * 2 <= WS_PREP, "ws map");
static_assert(WS_H + (size_t)MT * DFF * 2 <= WS_END, "ws map");
static_assert(WS_END <= 512 * MiB, "ws map");
enum { PR_R = 0, PR_WF = 1, PR_WB = 2, PR_K = 3, PR_V = 4, PR_KK = 5, PR_B = 6 };

constexpr int LDS_BYTES = 147456;

__device__ __forceinline__ float bf2f(bf16_t v) { return __uint_as_float(((unsigned)v) << 16); }
__device__ __forceinline__ unsigned f2bf_u(float f) { unsigned u = __float_as_uint(f); return (u + 0x7fffu + ((u >> 16) & 1u)) >> 16; }
typedef float f32x2_cv __attribute__((ext_vector_type(2))); typedef __bf16 bf16x2_cv __attribute__((ext_vector_type(2)));
__device__ __forceinline__ unsigned pk2(float lo, float hi) { f32x2_cv v = {lo, hi}; bf16x2_cv b = __builtin_convertvector(v, bf16x2_cv); return __builtin_bit_cast(unsigned, b); }
__device__ __forceinline__ bf16_t f2bf(float f) { return (bf16_t)(pk2(f, 0.f) & 0xffffu); }
typedef _Float16 h2_cv __attribute__((ext_vector_type(2)));
__device__ __forceinline__ unsigned pkh2(float lo, float hi) { const h2_cv v = {(_Float16)lo, (_Float16)hi}; return __builtin_bit_cast(unsigned, v); }
__device__ __forceinline__ f32x2 uph2(unsigned u) { const h2_cv v = __builtin_bit_cast(h2_cv, u); return (f32x2){(float)v.x, (float)v.y}; }
__device__ __forceinline__ f32x2 bfx2(unsigned u) { f32x2 r; r.x = __uint_as_float(u << 16); r.y = __uint_as_float(u & 0xffff0000u); return r; }
__device__ __forceinline__ float sigmoidf_(float x) { return __builtin_amdgcn_rcpf(1.0f + __expf(-x)); }
__device__ __forceinline__ float siluf_(float x) { return x * __builtin_amdgcn_rcpf(1.0f + __expf(-x)); }
__device__ __forceinline__ float softplusf_(float x) { return fmaxf(x, 0.f) + log1pf(__expf(-fabsf(x))); }
__device__ __forceinline__ float wave_sum(float v) {
#pragma unroll
    for (int o = 1; o < 64; o <<= 1) v += __shfl_xor(v, o);
    return v;
}
template <int CTRL> __device__ __forceinline__ float dpp_mov(float x) { return __int_as_float(__builtin_amdgcn_update_dpp(0, __float_as_int(x), CTRL, 0xF, 0xF, true)); }
__device__ __forceinline__ float reduce16(float x) {
    x += dpp_mov<0xB1>(x);
    x += dpp_mov<0x4E>(x);
    x += dpp_mov<0x141>(x);
    x += dpp_mov<0x140>(x);
    return x;
}
#define LDS_WAIT() asm volatile("s_waitcnt lgkmcnt(0)" ::: "memory")


#define XB_TMO      128
#define XB_XCNT(j)  (256  + 64 * (j))
#define XB_XSUB(j)  (1280 + 64 * (j))
#define XB_XGEN(j)  (2304 + 64 * (j))
#define XB_TOP      3328
#define XB_TOPGEN   3392
#define XCD_BAR_WORDS 3456
#define XB_SPIN_CAP (1u << 18)

__device__ __forceinline__ unsigned xb_ld(unsigned* p)              { return __hip_atomic_load(p, __ATOMIC_RELAXED, __HIP_MEMORY_SCOPE_AGENT); }
__device__ __forceinline__ unsigned xb_add(unsigned* p, unsigned v) { return __hip_atomic_fetch_add(p, v, __ATOMIC_RELAXED, __HIP_MEMORY_SCOPE_AGENT); }
__device__ __forceinline__ unsigned xb_xcc_id() { return (unsigned)__builtin_amdgcn_s_getreg((3 << 11) | 20) & 0xFu; }
#define XB_SPIN(cond, bar) do { unsigned _sp = 0; while (cond) { __builtin_amdgcn_s_sleep(1); \
    if ((++_sp & 255u) == 0u) { if (xb_ld(&(bar)[XB_TMO])) break; if (_sp > XB_SPIN_CAP) { atomicAdd(&(bar)[XB_TMO], 1u); break; } } } } while (0)

struct XcdBarrier {
    unsigned* bar; unsigned x;
    volatile LAS unsigned* st;
};

__device__ __forceinline__ XcdBarrier xcd_barrier_post(unsigned* bar, volatile LAS unsigned* st) {
    XcdBarrier b; b.bar = bar; b.x = xb_xcc_id(); b.st = st;
    if (threadIdx.x == 0) (void)xb_add(&bar[XB_XCNT(b.x)], 1u);
    return b;
}
__device__ __forceinline__ void xcd_barrier_complete(unsigned* bar, unsigned x, unsigned& nloc, unsigned& nx) {
    const unsigned G = gridDim.x * gridDim.y * gridDim.z;
    unsigned sum, cnt, mine, sp = 0u;
    for (;;) {
        sum = 0u; cnt = 0u; mine = 0u;
#pragma unroll
        for (unsigned j = 0; j < 16; ++j) { const unsigned c = xb_ld(&bar[XB_XCNT(j)]); sum += c; cnt += (c > 0u) ? 1u : 0u; mine = (j == x) ? c : mine; }
        if (sum == G) break;
        __builtin_amdgcn_s_sleep(1);
        if ((++sp & 255u) == 0u) { if (xb_ld(&bar[XB_TMO])) break; if (sp > XB_SPIN_CAP) { atomicAdd(&bar[XB_TMO], 1u); break; } }
    }
    nloc = mine > 0u ? mine : 1u; nx = cnt > 0u ? cnt : 1u;
}

__device__ __forceinline__ void xcd_barrier(const XcdBarrier& b) {
    asm volatile("s_waitcnt vmcnt(0)" ::: "memory");
    __syncthreads();
    if (threadIdx.x == 0) {
        unsigned* bar = b.bar;
        __builtin_amdgcn_s_waitcnt(0);
        unsigned nloc = b.st[0], nx = b.st[1];
        if (nloc == 0u) { xcd_barrier_complete(bar, b.x, nloc, nx); b.st[0] = nloc; b.st[1] = nx; }
        const unsigned old = xb_add(&bar[XB_XSUB(b.x)], 1u);
        const unsigned gen = old / nloc;
        if (old + 1u == (gen + 1u) * nloc) {
            __builtin_amdgcn_fence(__ATOMIC_RELEASE, "agent");
            asm volatile("s_waitcnt vmcnt(0)" ::: "memory");
            const unsigned og = xb_add(&bar[XB_TOP], 1u);
            const unsigned tg = og / nx;
            if (og + 1u == (tg + 1u) * nx) xb_add(&bar[XB_TOPGEN], 1u);
            else XB_SPIN(xb_ld(&bar[XB_TOPGEN]) == tg, bar);
            __builtin_amdgcn_fence(__ATOMIC_ACQUIRE, "agent");
            xb_add(&bar[XB_XGEN(b.x)], 1u);
            asm volatile("s_waitcnt vmcnt(0)" ::: "memory");
        } else {
            XB_SPIN(xb_ld(&bar[XB_XGEN(b.x)]) == gen, bar);
            __builtin_amdgcn_fence(__ATOMIC_ACQUIRE, "agent");
            asm volatile("s_waitcnt vmcnt(0)" ::: "memory");
        }
    }
    __syncthreads();
}


namespace pg8 {
#define PG8_LAS __attribute__((address_space(3)))
typedef unsigned short bf16_t;
typedef short bf16x8 __attribute__((ext_vector_type(8)));
typedef float f32x4 __attribute__((ext_vector_type(4)));
typedef unsigned u32x4 __attribute__((ext_vector_type(4)));
constexpr int BM = 256, BK = 64, HALF = 128, HTB = HALF * BK * 2  , STAGE_BYTES = 8 * HTB, NXCD = 8, WGM = 8;

__host__ __device__ __forceinline__ int lds_byte(int r, int c) { const int st = (r >> 4) * 2 + (c >> 5), rr = r & 15, cc = c & 31, ob = rr * 64 + cc * 2; return st * 1024 + (ob ^ (((ob >> 9) & 1) << 5)); }
__host__ __device__ __forceinline__ void stage_rc(int b, int& R, int& C) { const int st = b / 1024, sb = b % 1024, swz = sb ^ (((sb >> 9) & 1) << 5); R = (st >> 1) * 16 + swz / 64; C = (st & 1) * 32 + (swz % 64) / 2; }
__host__ __device__ __forceinline__ int perm32(int rho) { const int n = rho >> 4, i = rho & 15; return 8 * (i >> 2) + 4 * n + (i & 3); }

struct Unit { int pm, pn; };
struct Gemm { const bf16_t* A; const bf16_t* Bt; int M, N, K; };

struct StaticOrder {
    int nM, nN, nwg, G, c;
    __host__ __device__ void init(int M, int N, int G_, int c_) { nM = M / BM; nN = N / BM; nwg = nM * nN; G = G_; c = c_; }
    __host__ __device__ bool next(int i, Unit& u) const {
        const long L = (long)i * G + c; if (L >= nwg) return false;
        int wgid = (int)L; { const int q = nwg / NXCD, r = nwg % NXCD, xcd = wgid % NXCD, off = wgid / NXCD; wgid = (xcd < r ? xcd * (q + 1) : r * (q + 1) + (xcd - r) * q) + off; }
        const int nig = WGM * nN, gid = wgid / nig, fm = gid * WGM, gsz = (nM - fm) < WGM ? (nM - fm) : WGM;
        u.pm = fm + ((wgid % nig) % gsz); u.pn = (wgid % nig) / gsz; return true;
    }
    __device__ __forceinline__ void a_ready(const Unit&) const {}
    __device__ __forceinline__ void done(const Unit&) const {}
};

template <class Epi, class Sched, bool ALIGN_EPI = false, bool SP2 = false>
__device__ __forceinline__ void gemm_phase(PG8_LAS unsigned char* lds, const Gemm g, const Sched& S, const Epi& E, const int tid) {
    const int wid = __builtin_amdgcn_readfirstlane(tid >> 6), lane = tid & 63, wr = wid >> 2, wc = wid & 3, fr = lane & 15, fq = lane >> 4;
    const int K = g.K, nt = K / BK;
    unsigned voffA[2], voffB[2];
#pragma unroll
    for (int i = 0; i < 2; ++i) { int R, C; stage_rc(tid * 16 + i * 8192, R, C); const int Rb = Epi::PERM ? ((R & ~31) + perm32(R & 31)) : R;
        voffA[i] = (unsigned)(R * K + C) * 2u; voffB[i] = (unsigned)(Rb * K + C) * 2u; }
    const size_t kstep = (size_t)(BK * 2);
    const size_t hstep = (size_t)HALF * K * 2;
    const size_t tstep = 2 * hstep;
    const unsigned ldsw = (unsigned)wid * 1024u;
    const int aoff = lds_byte(wr * 64 + fr, fq * 8), boff = lds_byte(wc * 32 + fr, fq * 8);
#define PG8_SA(b, h) (((b) * 2 + (h)) * HTB)
#define PG8_SB(b, h) ((4 + (b) * 2 + (h)) * HTB)
#define PG8_STAGE(bufoff, gbase, voff) do { _Pragma("unroll") for (int _i = 0; _i < 2; ++_i) \
        __builtin_amdgcn_global_load_lds((const unsigned*)((const char*)(gbase) + (voff)[_i]), (PG8_LAS unsigned*)(lds + (bufoff) + ldsw + _i * 8192), 16, 0, 0); } while (0)
#define PG8_LDA(dst, b, h) do { _Pragma("unroll") for (int m = 0; m < 4; ++m) _Pragma("unroll") for (int k = 0; k < 2; ++k) dst[m][k] = *(const PG8_LAS bf16x8*)(lds + PG8_SA(b, h) + aoff + m * 2048 + k * 1024); } while (0)
#define PG8_LDB(dst, b, h) do { _Pragma("unroll") for (int n = 0; n < 2; ++n) _Pragma("unroll") for (int k = 0; k < 2; ++k) dst[n][k] = *(const PG8_LAS bf16x8*)(lds + PG8_SB(b, h) + boff + n * 2048 + k * 1024); } while (0)
#define PG8_MMA(ai, bj, At, Bt) do { __builtin_amdgcn_s_setprio(1); _Pragma("unroll") for (int m = 0; m < 4; ++m) _Pragma("unroll") for (int n = 0; n < 2; ++n) _Pragma("unroll") for (int k = 0; k < 2; ++k) \
        acc[ai][bj][m][n] = __builtin_amdgcn_mfma_f32_16x16x32_bf16(Bt[n][k], At[m][k], acc[ai][bj][m][n], 0, 0, 0); __builtin_amdgcn_s_setprio(0); } while (0)
#define PG8_WAIT_V(n) asm volatile("s_waitcnt vmcnt(" #n ")" ::: "memory")
#define PG8_WAIT_L(n) asm volatile("s_waitcnt lgkmcnt(" #n ")" ::: "memory")
#define PG8_BAR __builtin_amdgcn_s_barrier()
#define PG8_SCHED __builtin_amdgcn_sched_barrier(0)
    Unit cur, nxt; int ui = 0;
    if (!S.next(0, cur)) return;
    f32x4 acc[2][2][4][2];
#pragma unroll
    for (int a = 0; a < 2; ++a)
#pragma unroll
        for (int b = 0; b < 2; ++b)
#pragma unroll
            for (int m = 0; m < 4; ++m)
#pragma unroll
                for (int n = 0; n < 2; ++n) acc[a][b][m][n] = (f32x4){0.f, 0.f, 0.f, 0.f};
    bf16x8 At[4][2], B0[2][2], B1[2][2];
    const char* cA = (const char*)g.A + (size_t)cur.pm * tstep; const char* cB = (const char*)g.Bt + (size_t)cur.pn * tstep;
    S.a_ready(cur);
    if constexpr (SP2) {
        PG8_STAGE(PG8_SB(0, 0), cB, voffB); PG8_STAGE(PG8_SB(0, 1), cB + hstep, voffB); PG8_STAGE(PG8_SA(0, 0), cA, voffA); PG8_STAGE(PG8_SA(0, 1), cA + hstep, voffA);
        if (wr == 1) PG8_BAR;
        PG8_WAIT_V(2); PG8_BAR;
        PG8_STAGE(PG8_SB(1, 0), cB + kstep, voffB); PG8_STAGE(PG8_SA(1, 0), cA + kstep, voffA); PG8_STAGE(PG8_SB(1, 1), cB + hstep + kstep, voffB);
        PG8_WAIT_V(6); PG8_BAR;
    } else {
        PG8_STAGE(PG8_SB(0, 0), cB, voffB); PG8_STAGE(PG8_SA(0, 0), cA, voffA); PG8_STAGE(PG8_SB(0, 1), cB + hstep, voffB); PG8_STAGE(PG8_SA(0, 1), cA + hstep, voffA);
        if (wr == 1) PG8_BAR;
        PG8_WAIT_V(4); PG8_BAR;
        PG8_STAGE(PG8_SB(1, 0), cB + kstep, voffB); PG8_STAGE(PG8_SA(1, 0), cA + kstep, voffA); PG8_STAGE(PG8_SB(1, 1), cB + hstep + kstep, voffB);
        PG8_WAIT_V(6); PG8_BAR;
    }
    for (;;) {
        const bool has_next = S.next(ui + 1, nxt);
        const char* nA = has_next ? (const char*)g.A + (size_t)nxt.pm * tstep : cA; const char* nB = has_next ? (const char*)g.Bt + (size_t)nxt.pn * tstep : cB;
        for (int t = 0; t < nt; t += 2) {
            const bool last = (t == nt - 2);
            const char* a1 = cA + (size_t)(t + 1) * kstep;
            const char* a2 = last ? nA : cA + (size_t)(t + 2) * kstep; const char* b2 = last ? nB : cB + (size_t)(t + 2) * kstep;
            const char* a3 = a2 + kstep; const char* b3 = b2 + kstep;
            if (last && has_next) S.a_ready(nxt);
            if constexpr (SP2) {
            PG8_LDB(B0, 0, 0); PG8_LDB(B1, 0, 1); PG8_SCHED; PG8_LDA(At, 0, 0); PG8_STAGE(PG8_SA(1, 1), a1 + hstep, voffA);
            PG8_WAIT_V(8); PG8_WAIT_L(0); PG8_BAR; PG8_MMA(0, 0, At, B0); PG8_MMA(0, 1, At, B1); PG8_BAR; PG8_SCHED;
            PG8_LDA(At, 0, 1); PG8_STAGE(PG8_SB(0, 0), b2, voffB); PG8_STAGE(PG8_SB(0, 1), b2 + hstep, voffB); PG8_STAGE(PG8_SA(0, 0), a2, voffA);
            PG8_WAIT_V(8); PG8_WAIT_L(0); PG8_BAR; PG8_MMA(1, 0, At, B0); PG8_MMA(1, 1, At, B1); PG8_BAR; PG8_SCHED;
            PG8_LDB(B0, 1, 0); PG8_LDB(B1, 1, 1); PG8_SCHED; PG8_LDA(At, 1, 0); PG8_STAGE(PG8_SA(0, 1), a2 + hstep, voffA);
            PG8_WAIT_V(8); PG8_WAIT_L(0); PG8_BAR; PG8_MMA(0, 0, At, B0); PG8_MMA(0, 1, At, B1); PG8_BAR; PG8_SCHED;
            PG8_LDA(At, 1, 1); PG8_STAGE(PG8_SB(1, 0), b3, voffB); PG8_STAGE(PG8_SB(1, 1), b3 + hstep, voffB); PG8_STAGE(PG8_SA(1, 0), a3, voffA);
            PG8_WAIT_V(8); PG8_WAIT_L(0); PG8_BAR; PG8_MMA(1, 0, At, B0); PG8_MMA(1, 1, At, B1); PG8_BAR; PG8_SCHED;
            } else {
            PG8_LDB(B0, 0, 0); PG8_SCHED; PG8_LDA(At, 0, 0); PG8_STAGE(PG8_SA(1, 1), a1 + hstep, voffA);
            PG8_WAIT_L(8); PG8_BAR; PG8_WAIT_L(0); PG8_MMA(0, 0, At, B0); PG8_BAR; PG8_SCHED;
            PG8_LDB(B1, 0, 1); PG8_STAGE(PG8_SB(0, 0), b2, voffB);
            PG8_BAR; PG8_WAIT_L(0); PG8_MMA(0, 1, At, B1); PG8_BAR;
            PG8_LDA(At, 0, 1); PG8_STAGE(PG8_SA(0, 0), a2, voffA);
            PG8_BAR; PG8_WAIT_L(0); PG8_MMA(1, 0, At, B0); PG8_BAR; PG8_SCHED;
            PG8_STAGE(PG8_SB(0, 1), b2 + hstep, voffB);
            PG8_WAIT_V(6); PG8_BAR; PG8_MMA(1, 1, At, B1); PG8_BAR;
            PG8_LDB(B0, 1, 0); PG8_SCHED; PG8_LDA(At, 1, 0); PG8_STAGE(PG8_SA(0, 1), a2 + hstep, voffA);
            PG8_WAIT_L(8); PG8_BAR; PG8_WAIT_L(0); PG8_MMA(0, 0, At, B0); PG8_BAR; PG8_SCHED;
            PG8_LDB(B1, 1, 1); PG8_STAGE(PG8_SB(1, 0), b3, voffB);
            PG8_BAR; PG8_WAIT_L(0); PG8_MMA(0, 1, At, B1); PG8_BAR;
            PG8_LDA(At, 1, 1); PG8_STAGE(PG8_SA(1, 0), a3, voffA);
            PG8_BAR; PG8_WAIT_L(0); PG8_MMA(1, 0, At, B0); PG8_BAR; PG8_SCHED;
            PG8_STAGE(PG8_SB(1, 1), b3 + hstep, voffB);
            PG8_WAIT_V(6); PG8_BAR; PG8_MMA(1, 1, At, B1); PG8_BAR;
            }
        }
        if constexpr (ALIGN_EPI) { if (wr == 0) PG8_BAR; }
        if constexpr (!Epi::AFTER_DRAIN) { E(acc, cur, wr, wc, fr, fq); S.done(cur); }
        if (!has_next) break;
#pragma unroll
        for (int a = 0; a < 2; ++a)
#pragma unroll
            for (int b = 0; b < 2; ++b)
#pragma unroll
                for (int m = 0; m < 4; ++m)
#pragma unroll
                    for (int n = 0; n < 2; ++n) acc[a][b][m][n] = (f32x4){0.f, 0.f, 0.f, 0.f};
        cur = nxt; cA = nA; cB = nB; ++ui;
        if constexpr (ALIGN_EPI) { if (wr == 1) PG8_BAR; }
    }
    PG8_WAIT_V(0);
    if constexpr (!ALIGN_EPI) { if (wr == 0) PG8_BAR; }
    PG8_BAR;
    if constexpr (Epi::AFTER_DRAIN) { E.fused(acc, cur, wr, wc, fr, fq, lds, wid, lane); S.done(cur); }
#undef PG8_SA
#undef PG8_SB
#undef PG8_STAGE
#undef PG8_LDA
#undef PG8_LDB
#undef PG8_MMA
#undef PG8_WAIT_V
#undef PG8_WAIT_L
#undef PG8_BAR
#undef PG8_SCHED
}
}

namespace pg8 {
template <int ACT> struct EpiBf16 {
    static constexpr bool PERM = true, AFTER_DRAIN = false;
    bf16_t* O; int ldc;
    __device__ __forceinline__ void operator()(const f32x4 (&acc)[2][2][4][2], const Unit& u, int wr, int wc, int fr, int fq) const {
        const int row0 = u.pm * BM + wr * 64 + fr; const int col0 = u.pn * BM + wc * 32 + 8 * fq;
#pragma unroll
        for (int ai = 0; ai < 2; ++ai)
#pragma unroll
            for (int m = 0; m < 4; ++m) { bf16_t* rowp = O + (size_t)(row0 + ai * HALF + m * 16) * ldc + col0;
#pragma unroll
                for (int bj = 0; bj < 2; ++bj) { f32x4 v0 = acc[ai][bj][m][0], v1 = acc[ai][bj][m][1];
                    if (ACT == 2) {
#pragma unroll
                        for (int e = 0; e < 4; ++e) { float a = fmaxf(v0[e], 0.f), b = fmaxf(v1[e], 0.f); v0[e] = a * a; v1[e] = b * b; } }
                    u32x4 w; w.x = ::pk2(v0[0], v0[1]); w.y = ::pk2(v0[2], v0[3]); w.z = ::pk2(v1[0], v1[1]); w.w = ::pk2(v1[2], v1[3]);
                    *(u32x4*)(rowp + bj * HALF) = w; } }
    }
};
template <bool BASE_BF> struct EpiRes {
    static constexpr bool PERM = false, AFTER_DRAIN = false;
    const void* base_lat; const void* base_ctx; bf16_t* out_lat; bf16_t* out_ctx; const float* gate  ; int pm_off  ;
    __device__ __forceinline__ void operator()(const f32x4 (&acc)[2][2][4][2], const Unit& u0, int wr, int wc, int fr, int fq) const {
        Unit u = u0; u.pm += pm_off;
        const bool lat = u.pm < (ML / BM); const int mi = lat ? (u.pm >> 5) : 4;
        const float* gv = gate + (size_t)mi * 6144;
        const size_t tile_off = lat ? (size_t)u.pm * BM * DM : (size_t)(u.pm - ML / BM) * BM * DM;
        const void* bpv = lat ? base_lat : base_ctx; bf16_t* op = (lat ? out_lat : out_ctx) + tile_off;
        const int col0 = u.pn * BM + wc * 32 + 4 * fq;
        f32x4 g4[2][2];
#pragma unroll
        for (int bj = 0; bj < 2; ++bj)
#pragma unroll
            for (int n = 0; n < 2; ++n) g4[bj][n] = *(const f32x4*)(gv + col0 + bj * HALF + n * 16);
#pragma unroll
        for (int ai = 0; ai < 2; ++ai) {
            f32x4 bs[4][2][2];
#pragma unroll
            for (int m = 0; m < 4; ++m) { const size_t off = tile_off + (size_t)(ai * HALF + wr * 64 + m * 16 + fr) * DM + col0;
#pragma unroll
                for (int bj = 0; bj < 2; ++bj)
#pragma unroll
                    for (int n = 0; n < 2; ++n) {
                        if (BASE_BF) { const u32x2 b2 = *(const u32x2*)((const bf16_t*)bpv + off + bj * HALF + n * 16); bs[m][bj][n] = (f32x4){__uint_as_float(b2.x), __uint_as_float(b2.y), 0.f, 0.f}; }
                        else bs[m][bj][n] = *(const f32x4*)((const float*)bpv + off + bj * HALF + n * 16); } }
#pragma unroll
            for (int m = 0; m < 4; ++m) { const size_t off = (size_t)(ai * HALF + wr * 64 + m * 16 + fr) * DM + col0;
#pragma unroll
                for (int bj = 0; bj < 2; ++bj)
#pragma unroll
                    for (int n = 0; n < 2; ++n) { f32x4 b4 = bs[m][bj][n];
                        if (BASE_BF) { const f32x2 lo = bfx2(__float_as_uint(b4.x)), hi = bfx2(__float_as_uint(b4.y)); b4 = (f32x4){lo.x, lo.y, hi.x, hi.y}; }
                        const f32x4 o = b4 + g4[bj][n] * acc[ai][bj][m][n];
                        *(u32x2*)(op + off + bj * HALF + n * 16) = (u32x2){pk2(o.x, o.y), pk2(o.z, o.w)}; } }
        }
    }
};
}

struct Args { const float* in[29]; float* out; unsigned char* ws; int ph_lo, ph_hi; };
enum { I_X = 0, I_C, I_CTX, I_CCTX, I_FNG, I_MODW, I_MODB, I_N1G, I_N2G, I_WIN, I_WOUT, I_W1, I_W2, I_GGW2, I_GGB, I_GNG, I_RMU, I_RW0, I_RW2, I_RA0, I_RA2, I_RG2,
       I_RKK, I_RKA, I_RRK, I_RLNG, I_RLNB, I_RETLR, I_RETNG };

typedef const __attribute__((address_space(4))) Args* CArgs;
struct Frame {
    LAS unsigned char* lds;
    int tid, lane, wave, bid, G;
    CArgs ap; float* out; unsigned char* ws;
    float* mod; bf16_t *Win_t, *Wout_t, *W1_t, *W2_t; float* xc; bf16_t *A, *Z, *PREP, *H;
};

__device__ __forceinline__ int mod_index(int m) { return m < ML ? (m >> 13) : 4; }
__device__ __forceinline__ int seq_row(int b, int dir, int s) {
    if (s < CTXL) { const int tc = dir ? (CTXL - 1 - s) : s; return ML + b * CTXL + tc; }
    const int tl = s - CTXL; const int t = dir ? (SEQ - 1 - tl) : tl; return b * SEQ + t;
}
__device__ __forceinline__ float zshift(const bf16_t* Z, int m, int col, float mu) {
    const bf16_t* p = Z + (size_t)m * ZP + col;
    const float z0 = bf2f(*p); float nb;
    if (m < ML) { const int t = m & (SEQ - 1), gr = t >> 6, gc = t & 63; float s = 0.f;
        if (gr > 0) s += bf2f(*(p - (ptrdiff_t)64 * ZP)); if (gr < 127) s += bf2f(*(p + (ptrdiff_t)64 * ZP));
        if (gc > 0) s += bf2f(*(p - (ptrdiff_t)ZP)); if (gc < 63) s += bf2f(*(p + (ptrdiff_t)ZP));
        nb = 0.25f * s;
    } else { const int t = (m - ML) & (CTXL - 1); float s = 0.f;
        if (t > 0) s += bf2f(*(p - (ptrdiff_t)ZP)); if (t < CTXL - 1) s += bf2f(*(p + (ptrdiff_t)ZP));
        nb = 0.5f * s; }
    return z0 + mu * (nb - z0);
}


struct ZNb { ptrdiff_t o[4]; float w[4]; };
__device__ __forceinline__ ZNb znb(int m) { ZNb n;
    if (m < ML) { const int t = m & (SEQ - 1), gr = t >> 6, gc = t & 63;
        n.o[0] = gr > 0 ? -(ptrdiff_t)64 * ZP : 0; n.o[1] = gr < 127 ? (ptrdiff_t)64 * ZP : 0; n.o[2] = gc > 0 ? -(ptrdiff_t)ZP : 0; n.o[3] = gc < 63 ? (ptrdiff_t)ZP : 0;
        n.w[0] = gr > 0 ? 0.25f : 0.f; n.w[1] = gr < 127 ? 0.25f : 0.f; n.w[2] = gc > 0 ? 0.25f : 0.f; n.w[3] = gc < 63 ? 0.25f : 0.f;
    } else { const int t = (m - ML) & (CTXL - 1);
        n.o[0] = 0; n.o[1] = 0; n.o[2] = t > 0 ? -(ptrdiff_t)ZP : 0; n.o[3] = t < CTXL - 1 ? (ptrdiff_t)ZP : 0;
        n.w[0] = 0.f; n.w[1] = 0.f; n.w[2] = t > 0 ? 0.5f : 0.f; n.w[3] = t < CTXL - 1 ? 0.5f : 0.f; }
    return n; }
struct ZRaw { bf16_t c, n0, n1, n2, n3; };
__device__ __forceinline__ ZRaw zload(const bf16_t* p, const ZNb& n) { ZRaw r; r.c = *p; r.n0 = *(p + n.o[0]); r.n1 = *(p + n.o[1]); r.n2 = *(p + n.o[2]); r.n3 = *(p + n.o[3]); return r; }
__device__ __forceinline__ float zmix(const ZRaw& r, const ZNb& n, float mu) { const float z0 = bf2f(r.c);
    const float nb = (bf2f(r.n0) * n.w[0] + bf2f(r.n1) * n.w[1]) + (bf2f(r.n2) * n.w[2] + bf2f(r.n3) * n.w[3]); return z0 + mu * (nb - z0); }
__device__ __forceinline__ float fast_tanh(float x) { const float e = __expf(2.0f * x); return 1.0f - 2.0f * __builtin_amdgcn_rcpf(e + 1.0f); }

__device__ __forceinline__ void phase_mod(Frame& F) {
    LAS float* sc = (LAS float*)F.lds;
    LAS float* red = sc + 5 * 1024;
    for (int i = F.tid; i < 5 * 1024; i += NTHR) { const int j = i >> 10, k = i & 1023; const float v = j < 4 ? F.ap->in[I_C][j * 1024 + k] : F.ap->in[I_CCTX][k]; sc[i] = siluf_(v); }
    __syncthreads();
    const int kg = F.tid >> 5, c = F.tid & 31;
    for (int it = F.bid; it < DEPTH * 192; it += F.G) {
        const int l = it / 192, cgp = it % 192, col = cgp * 32 + c;
        const float* W = F.ap->in[I_MODW] + (size_t)l * DM * 6144 + col;
        float a0 = 0.f, a1 = 0.f, a2 = 0.f, a3 = 0.f, a4 = 0.f;
#pragma unroll 1
        for (int k0 = kg * 64; k0 < kg * 64 + 64; k0 += 16) { float w[16];
#pragma unroll
            for (int u = 0; u < 16; ++u) w[u] = W[(size_t)(k0 + u) * 6144];
#pragma unroll
            for (int u = 0; u < 16; ++u) { const int k = k0 + u; a0 += sc[k] * w[u]; a1 += sc[1024 + k] * w[u]; a2 += sc[2048 + k] * w[u]; a3 += sc[3072 + k] * w[u]; a4 += sc[4096 + k] * w[u]; } }
        red[(kg * 5 + 0) * 32 + c] = a0; red[(kg * 5 + 1) * 32 + c] = a1; red[(kg * 5 + 2) * 32 + c] = a2; red[(kg * 5 + 3) * 32 + c] = a3; red[(kg * 5 + 4) * 32 + c] = a4;
        __syncthreads();
        if (F.tid < 160) { const int j = F.tid >> 5; float s = 0.f;
#pragma unroll
            for (int g = 0; g < 16; ++g) s += red[(g * 5 + j) * 32 + c];
            F.mod[((size_t)l * 5 + j) * 6144 + col] = s + F.ap->in[I_MODB][l * 6144 + col]; }
        __syncthreads();
    }
}

__device__ __forceinline__ void transpose_item(const float* W, int K, int N, bf16_t* WT, LAS float* scr, int item, int lane) {
    const int nblk = N / 32, kb = item / nblk, nb = item % nblk, k0 = 64 * kb, n0 = 32 * nb;
#pragma unroll 8
    for (int i = 0; i < 32; ++i) { const int kk = 2 * i + (lane >> 5); scr[kk * 33 + (lane & 31)] = W[(size_t)(k0 + kk) * N + n0 + (lane & 31)]; }
    LDS_WAIT(); asm volatile("" ::: "memory");
    const int c = lane & 7;
#pragma unroll
    for (int j = 0; j < 4; ++j) { const int n = (lane >> 3) + 8 * j; const LAS float* s = scr + (8 * c) * 33 + n;
        u32x4 o; o.x = pk2(s[0 * 33], s[1 * 33]); o.y = pk2(s[2 * 33], s[3 * 33]); o.z = pk2(s[4 * 33], s[5 * 33]); o.w = pk2(s[6 * 33], s[7 * 33]);
        *(u32x4*)(WT + (size_t)(n0 + n) * K + k0 + 8 * c) = o; }
    LDS_WAIT(); asm volatile("" ::: "memory");
}
__device__ __forceinline__ void phase_wconv(Frame& F, int l, int which = 3, int blk_lo = 0, int nblk = 0) {
    if (nblk == 0) nblk = F.G;
    if (F.bid < blk_lo) return;
    LAS float* scr = (LAS float*)(F.lds + F.wave * 16384);
    const int gw = (F.bid - blk_lo) * NWAVES + F.wave, NGW = nblk * NWAVES;
    constexpr int I_IN = (DM / 64) * (INC / 32), I_O = (DM / 64) * (DM / 32), I_1 = (DM / 64) * (DFF / 32), I_2 = (DFF / 64) * (DM / 32);
    const float* Win = F.ap->in[I_WIN] + (size_t)l * DM * INC; const float* Wout = F.ap->in[I_WOUT] + (size_t)l * DM * DM;
    const float* W1 = F.ap->in[I_W1] + (size_t)l * DM * DFF; const float* W2 = F.ap->in[I_W2] + (size_t)l * DFF * DM;
    const int it_lo = (which & 1) ? 0 : I_IN + I_O + I_1, it_hi = (which & 2) ? I_IN + I_O + I_1 + I_2 : I_IN + I_O + I_1;
    for (int it = it_lo + gw; it < it_hi; it += NGW) {
        int r = it;
        if (r < I_IN) { transpose_item(Win, DM, INC, F.Win_t, scr, r, F.lane); continue; } r -= I_IN;
        if (r < I_O) { transpose_item(Wout, DM, DM, F.Wout_t, scr, r, F.lane); continue; } r -= I_O;
        if (r < I_1) { transpose_item(W1, DM, DFF, F.W1_t, scr, r, F.lane); continue; } r -= I_1;
        transpose_item(W2, DFF, DM, F.W2_t, scr, r, F.lane);
    }
    if (which & 1) { u32x4* zp = (u32x4*)(F.Win_t + (size_t)INC * DM); const int n16 = (ZP - INC) * DM * 2 / 16;
      for (int i = (F.bid - blk_lo) * NTHR + F.tid; i < n16; i += nblk * NTHR) zp[i] = (u32x4){0u, 0u, 0u, 0u}; }
}

template <bool SRC_BF> __device__ __forceinline__ void phase_norm(Frame& F, const void* src_lat, const void* src_ctx, const float* g, const float* modl, int shift_idx, int scale_idx, int Mrows, int row_lo = 0, int blk_lo = 0, int nblk = 0) {
    if (nblk == 0) nblk = F.G;
    if (F.bid < blk_lo) return;
    const int gw = (F.bid - blk_lo) * NWAVES + F.wave, NGW = nblk * NWAVES;
    for (int m = row_lo + gw; m < Mrows; m += NGW) {
        const size_t roff = m < ML ? (size_t)m * DM : (size_t)(m - ML) * DM; const void* xbase = m < ML ? src_lat : src_ctx;
        const float* mv = modl + (size_t)mod_index(m) * 6144;
        f32x4 v[4]; float ss = 0.f;
        if (SRC_BF) { const u32x2* xr = (const u32x2*)((const bf16_t*)xbase + roff) + F.lane; u32x2 q[4];
#pragma unroll
            for (int j = 0; j < 4; ++j) q[j] = xr[64 * j];
#pragma unroll
            for (int j = 0; j < 4; ++j) { const f32x2 lo = bfx2(q[j].x), hi = bfx2(q[j].y); v[j] = (f32x4){lo.x, lo.y, hi.x, hi.y}; }
        } else { const f32x4* xr = (const f32x4*)((const float*)xbase + roff) + F.lane;
#pragma unroll
            for (int j = 0; j < 4; ++j) v[j] = xr[64 * j]; }
#pragma unroll
        for (int j = 0; j < 4; ++j) ss += (v[j].x * v[j].x + v[j].y * v[j].y) + (v[j].z * v[j].z + v[j].w * v[j].w);
        const float r = rsqrtf(wave_sum(ss) * (1.f / DM) + 1e-6f);
        u32x2* o8 = (u32x2*)(F.A + (size_t)m * DM) + F.lane;
#pragma unroll
        for (int j = 0; j < 4; ++j) { const int col = 4 * F.lane + 256 * j;
            const f32x4 gg = *(const f32x4*)(g + col), sh = *(const f32x4*)(mv + shift_idx * 1024 + col), sc = *(const f32x4*)(mv + scale_idx * 1024 + col);
            const f32x4 y = v[j] * r * gg * (sc + 1.0f) + sh;
            u32x2 w; w.x = pk2(y.x, y.y); w.y = pk2(y.z, y.w); o8[64 * j] = w; }
    }
}
__device__ __forceinline__ void phase_final(Frame& F) {
    const int gw = F.bid * NWAVES + F.wave, NGW = F.G * NWAVES; const float* g = F.ap->in[I_FNG];
    for (int m = gw; m < ML; m += NGW) {
        const u32x2* xr = (const u32x2*)(F.A + (size_t)m * DM) + F.lane; f32x4* orow = (f32x4*)(F.out + (size_t)m * DM) + F.lane;
        u32x2 q[4]; f32x4 v[4]; float ss = 0.f;
#pragma unroll
        for (int j = 0; j < 4; ++j) q[j] = xr[64 * j];
#pragma unroll
        for (int j = 0; j < 4; ++j) { const f32x2 lo = bfx2(q[j].x), hi = bfx2(q[j].y); v[j] = (f32x4){lo.x, lo.y, hi.x, hi.y}; ss += (v[j].x * v[j].x + v[j].y * v[j].y) + (v[j].z * v[j].z + v[j].w * v[j].w); }
        const float r = rsqrtf(wave_sum(ss) * (1.f / DM) + 1e-6f);
#pragma unroll
        for (int j = 0; j < 4; ++j) { const f32x4 gg = *(const f32x4*)(g + 4 * F.lane + 256 * j); orow[64 * j] = v[j] * r * gg; }
    }
}

#ifndef SCAN_GLA_V0
#define SCAN_GLA_V0 0
#endif
__device__ __forceinline__ void gla_scan_block(Frame& F, int l, int chain) {
    constexpr int TS = 64;
    const int dir = chain & 1, h = (chain >> 1) & 3, b = chain >> 3;
    LAS float* q = (LAS float*)F.lds;
    LAS float* k = q + TS * 48; LAS float* g = k + TS * 48;
    LAS float* v = g + TS * 48;
    LAS float* y = v + TS * 96;
    const float* W2 = F.ap->in[I_GGW2] + (size_t)(l * 2 + dir) * 16 * 192 + h * 48; const float* Bg = F.ap->in[I_GGB] + (l * 2 + dir) * 192 + h * 48;
    const float qs = 0.14433756729740643f;
    float S[48];
#pragma unroll
    for (int j = 0; j < 48; ++j) S[j] = 0.f;
    for (int tile = 0; tile < SEQT / TS; ++tile) {
        const int sbase = tile * TS;
        for (int i = F.tid; i < TS * 48; i += NTHR) { const int st = i / 48, j = i % 48; const int m = seq_row(b, dir, sbase + st); const bf16_t* zr = F.Z + (size_t)m * ZP;
            q[i] = bf2f(zr[GLA_OFF + h * 48 + j]) * qs; k[i] = bf2f(zr[GLA_OFF + 192 + h * 48 + j]);
            float x = Bg[j];
#pragma unroll
            for (int r = 0; r < 16; ++r) x += bf2f(zr[GLA_OFF + 1152 + dir * 16 + r]) * W2[r * 192 + j];
            const float ls = fminf(x, 0.f) - log1pf(__expf(-fabsf(x)));
            g[i] = __expf(ls * (1.0f / 16.0f)); }
        for (int i = F.tid; i < TS * 96; i += NTHR) { const int st = i / 96, n = i % 96; const int m = seq_row(b, dir, sbase + st); v[i] = bf2f(F.Z[(size_t)m * ZP + GLA_OFF + 384 + h * 96 + n]); }
        __syncthreads();
        if (F.tid < 96) {
            for (int st = 0; st < TS; ++st) { const float vn = v[st * 96 + F.tid]; float o = 0.f;
#pragma unroll
                for (int j = 0; j < 48; ++j) { S[j] = S[j] * g[st * 48 + j] + k[st * 48 + j] * vn; o += q[st * 48 + j] * S[j]; }
                y[st * 96 + F.tid] = o; }
        }
        __syncthreads();
        for (int i = F.tid; i < TS * 96; i += NTHR) { const int st = i / 96, n = i % 96; const int m = seq_row(b, dir, sbase + st); const bf16_t o = f2bf(y[i]);
            if (dir == 0) F.A[(size_t)m * DM + h * 96 + n] = o; else F.Z[(size_t)m * ZP + YB_OFF + h * 96 + n] = o; }
        __syncthreads();
    }
}
__device__ __forceinline__ void gla_gate_units(Frame& F, int l, int first, int nblk) {
    LAS float* lrs = (LAS float*)F.lds;
    LAS float* qsum = lrs + 64 * 16;
    const int dp = F.tid % 96, tq = F.tid / 96;
    for (int it = first; it < NB * 2 * (SEQT / 64); it += nblk) {
        const int b = it / (2 * (SEQT / 64)), rem = it - b * (2 * (SEQT / 64)), dir = rem / (SEQT / 64), cs = rem - dir * (SEQT / 64);
#pragma unroll
        for (int q = 0; q < 2; ++q) { const int idx = F.tid + NTHR * q, tok = idx >> 4, r = idx & 15; const int m = seq_row(b, dir, cs * 64 + tok);
            lrs[idx] = bf2f(F.Z[(size_t)m * ZP + GLA_OFF + 1152 + dir * 16 + r]); }
        f32x2 w[16], bias = {0.f, 0.f};
        if (tq < 4) { const float* W2 = F.ap->in[I_GGW2] + (size_t)(l * 2 + dir) * 16 * 192 + 2 * dp;
#pragma unroll
            for (int r = 0; r < 16; ++r) w[r] = *(const f32x2*)(W2 + r * 192);
            bias = *(const f32x2*)(F.ap->in[I_GGB] + (l * 2 + dir) * 192 + 2 * dp); }
        __syncthreads();
        f32x2 Gv[16]; f32x2 run = {0.f, 0.f};
        if (tq < 4) {
#pragma unroll
            for (int i = 0; i < 16; ++i) { const LAS float* lp = lrs + (tq * 16 + i) * 16; f32x2 x = bias;
#pragma unroll
                for (int r = 0; r < 16; ++r) x += w[r] * lp[r];
                f32x2 ls; ls.x = (fminf(x.x, 0.f) - __logf(1.0f + __expf(-fabsf(x.x)))) * (1.0f / 16.0f); ls.y = (fminf(x.y, 0.f) - __logf(1.0f + __expf(-fabsf(x.y)))) * (1.0f / 16.0f);
                run += ls; Gv[i] = run; }
            *(LAS f32x2*)(qsum + tq * 192 + 2 * dp) = run;
        }
        __syncthreads();
        if (tq < 4) { f32x2 off = {0.f, 0.f};
#pragma unroll
            for (int q = 0; q < 3; ++q) if (q < tq) off += *(const LAS f32x2*)(qsum + q * 192 + 2 * dp);
#pragma unroll
            for (int i = 0; i < 16; ++i) { const int m = seq_row(b, dir, cs * 64 + tq * 16 + i);
                float* dst = (dir == 0 ? (float*)(F.A + (size_t)m * DM) : (float*)(F.Z + (size_t)m * ZP + YB_OFF)) + 2 * dp;
                const f32x2 gv = Gv[i] + off;
                __hip_atomic_store((unsigned long long*)dst, ((unsigned long long)__float_as_uint(gv.y) << 32) | __float_as_uint(gv.x), __ATOMIC_RELAXED, __HIP_MEMORY_SCOPE_AGENT); }
        }
    }
}


__device__ __forceinline__ void group_arrive(unsigned* cnt, unsigned target, bool wait) {
    asm volatile("s_waitcnt vmcnt(0)" ::: "memory");
    __syncthreads();
    if (threadIdx.x == 0) {
        __hip_atomic_fetch_add(cnt, 1u, __ATOMIC_RELAXED, __HIP_MEMORY_SCOPE_AGENT);
        if (wait) { unsigned sp = 0; while (__hip_atomic_load(cnt, __ATOMIC_RELAXED, __HIP_MEMORY_SCOPE_AGENT) < target) { __builtin_amdgcn_s_sleep(4); if (++sp > (1u << 22)) break; }
            __builtin_amdgcn_fence(__ATOMIC_ACQUIRE, "agent"); asm volatile("s_waitcnt vmcnt(0)" ::: "memory"); }
    }
    __syncthreads();
}
typedef short bf16x8 __attribute__((ext_vector_type(8)));
#define LDS_BARRIER() do { asm volatile("s_waitcnt lgkmcnt(0)" ::: "memory"); __builtin_amdgcn_s_barrier(); asm volatile("" ::: "memory"); } while (0)
typedef _Float16 h2 __attribute__((ext_vector_type(2)));
typedef _Float16 h4 __attribute__((ext_vector_type(4)));
typedef _Float16 h8 __attribute__((ext_vector_type(8)));
constexpr int RW_PF = 6;
constexpr int YPE = 20, YPS = 16 * YPE;
struct RwRaw { u32x4 raw[5]; bf16_t vraw[2]; unsigned pf; };
struct RwCtx { const unsigned char* pv[5]; const unsigned char* ppf; unsigned cpf; int spf; const unsigned char* pvv; unsigned char* py; unsigned cvec, cv0, cv1, cy0, cy1, yrow; int st, s20, s21, sg; };
__device__ __forceinline__ RwCtx rwkv_ctx(const Frame& F, int dir, int h, int quarter, int lt) {
    RwCtx C; const unsigned char* P = (const unsigned char*)F.PREP; const int wsel = dir ? PR_WB : PR_WF;
    C.pv[0] = P + (size_t)PR_KK * PREP_STRIDE * 2; C.pv[1] = P + (size_t)wsel * PREP_STRIDE * 2; C.pv[2] = P + (size_t)PR_B * PREP_STRIDE * 2; C.pv[3] = P + (size_t)PR_K * PREP_STRIDE * 2; C.pv[4] = P + (size_t)PR_R * PREP_STRIDE * 2;
    C.pvv = P + (size_t)PR_V * PREP_STRIDE * 2 + (h * 64 + quarter * 16) * 2;
    C.py = dir == 0 ? (unsigned char*)F.A + (384 + h * 64 + quarter * 16) * 2 : (unsigned char*)F.Z + (YB_OFF + 384 + h * 64 + quarter * 16) * 2;
    C.yrow = dir == 0 ? DM * 2 : ZP * 2; C.sg = dir ? -1 : 1;
    { const int ti = min(lt >> 5, 5); const int tsel = ti == 0 ? PR_KK : ti == 1 ? wsel : ti == 2 ? PR_B : ti == 3 ? PR_K : ti == 4 ? PR_R : PR_V; C.ppf = P; C.cpf = (unsigned)tsel * (unsigned)(PREP_STRIDE * 2) + h * 128; C.spf = lt & 31; }
    C.st = (lt >> 4) * 2; C.cvec = (h * 64 + (lt & 15) * 4) * 2; C.s20 = lt >> 4; C.s21 = (lt + 256) >> 4; C.cv0 = (lt & 15) * 2; C.cv1 = C.cv0; C.cy0 = C.cv0; C.cy1 = C.cv0;
    return C;
}
__device__ __forceinline__ void rwkv_load(RwRaw& R, const RwCtx& C, int b, int dir, int sbase) {
    const int m0 = __builtin_amdgcn_readfirstlane(seq_row(b, dir, sbase));
    const unsigned voa = (unsigned)(m0 + C.sg * C.st) * 768u + C.cvec, vob = voa + (unsigned)(C.sg * 768);
#pragma unroll
    for (int vi = 0; vi < 5; ++vi) { const u32x2 a = *(const u32x2*)(C.pv[vi] + voa), bb = *(const u32x2*)(C.pv[vi] + vob); R.raw[vi] = (u32x4){a.x, a.y, bb.x, bb.y}; }
    { const int mp = __builtin_amdgcn_readfirstlane(seq_row(b, dir, min(sbase + RW_PF * 32, SEQT - 32)));
      R.pf = *(const unsigned*)(C.ppf + (size_t)((unsigned)(mp + C.sg * C.spf) * 768u) + C.cpf); }
    R.vraw[0] = *(const bf16_t*)(C.pvv + ((unsigned)(m0 + C.sg * C.s20) * 768u + C.cv0));
    R.vraw[1] = *(const bf16_t*)(C.pvv + ((unsigned)(m0 + C.sg * C.s21) * 768u + C.cv1));
}
__device__ __forceinline__ void rwkv_store(const RwRaw& R, LAS _Float16* vecb, LAS unsigned* vvb, int lt) {
    constexpr int TS = 32;
    asm volatile("" :: "v"(R.pf));
    LAS unsigned char* dst0 = (LAS unsigned char*)vecb + lt * 16;
#pragma unroll
    for (int vi = 0; vi < 5; ++vi) *(LAS u32x4*)(dst0 + vi * (TS / 2) * 16 * 8 * 2) = R.raw[vi];
#pragma unroll
    for (int q = 0; q < 2; ++q) { const int idx = lt + 256 * q, s2 = idx >> 4, rr = idx & 15; const unsigned v = R.vraw[q]; vvb[((s2 >> 1) * 16 + rr) * 2 + (s2 & 1)] = v | (v << 16); }
}
template <bool STORE = true> __device__ __forceinline__ void rwkv_flush(const RwCtx& C, const LAS float* ypb, int b, int dir, int sbase, int lt) {
    const int m0 = __builtin_amdgcn_readfirstlane(seq_row(b, dir, sbase));
#pragma unroll
    for (int q = 0; q < 2; ++q) { const int idx = lt + 256 * q;
        const LAS f32x4* pp = (const LAS f32x4*)(ypb + idx * YPE); const f32x4 a0 = pp[0], a1 = pp[1], a2 = pp[2], a3 = pp[3];
        const f32x4 t = (a0 + a1) + (a2 + a3); const bf16_t o = f2bf((t.x + t.y) + (t.z + t.w));
        if (STORE) *(bf16_t*)(C.py + ((unsigned)(m0 + C.sg * (q ? C.s21 : C.s20)) * C.yrow + C.cy0)) = o; else asm volatile("" :: "v"((unsigned)o), "v"(m0)); }
}
__device__ __forceinline__ float dot2_f16_z(h2 a, h2 b) { float d; asm("v_dot2_f32_f16 %0, %1, %2, 0" : "=v"(d) : "v"(a), "v"(b)); return d; }
template <int VAR> __device__ __forceinline__ void rwkv_compute_tile(const LAS _Float16* vb, const LAS u32x2* vvb, LAS float* ypp, h2& sA, h2& sB) {
    constexpr int TS = 32;
#define RW_FETCH(P, j_) do { if (VAR == 3) { P##kk.lo = *(const LAS h4*)(vb + (0 * (TS / 2) + (j_)) * 128); P##w.lo = *(const LAS h4*)(vb + (1 * (TS / 2) + (j_)) * 128); P##b.lo = *(const LAS h4*)(vb + (2 * (TS / 2) + (j_)) * 128); \
                P##k.lo = *(const LAS h4*)(vb + (3 * (TS / 2) + (j_)) * 128); P##r.lo = *(const LAS h4*)(vb + (4 * (TS / 2) + (j_)) * 128); P##kk.hi = P##kk.lo; P##w.hi = P##w.lo; P##b.hi = P##b.lo; P##k.hi = P##k.lo; P##r.hi = P##r.lo; P##v = vvb[(j_) * 16]; break; } \
                P##kk = *(const LAS h8*)(vb + (0 * (TS / 2) + (j_)) * 128); P##w = *(const LAS h8*)(vb + (1 * (TS / 2) + (j_)) * 128); P##b = *(const LAS h8*)(vb + (2 * (TS / 2) + (j_)) * 128); \
                P##k = *(const LAS h8*)(vb + (3 * (TS / 2) + (j_)) * 128); P##r = *(const LAS h8*)(vb + (4 * (TS / 2) + (j_)) * 128); P##v = vvb[(j_) * 16]; } while (0)
    h8 n_kk, n_w, n_b, n_k, n_r; u32x2 n_v;
    RW_FETCH(n_, 0);
    h4 r_p = n_r.lo;
#pragma unroll
    for (int j = 0; j < TS / 2; ++j) {
        const h4 kka = n_kk.lo, wa = n_w.lo, ba = n_b.lo, ka = n_k.lo, ra = n_r.lo, kkb = n_kk.hi, wb = n_w.hi, bb = n_b.hi, kb = n_k.hi, rb = n_r.hi;
        const unsigned vxa_ = n_v.x, vxb_ = n_v.y;
        const h2 vha = __builtin_bit_cast(h2, vxa_), vhb = __builtin_bit_cast(h2, vxb_);
        if (j + 1 < TS / 2) RW_FETCH(n_, j + 1);
        __builtin_amdgcn_sched_barrier(0);
        __builtin_amdgcn_s_waitcnt(0xC67F);
        float p = dot2_f16_z(sA, kka.xy); p = __builtin_amdgcn_fdot2(sB, kka.zw, p, false);
        if (j > 0) { float yq = dot2_f16_z(sA, r_p.xy); yq = __builtin_amdgcn_fdot2(sB, r_p.zw, yq, false); ypp[(2 * j - 1) * YPS] = yq; }
        sA = sA * wa.xy + ka.xy * vha; sB = sB * wa.zw + ka.zw * vha;
        if (VAR != 4) p = reduce16(p);
        { const _Float16 ph = (_Float16)p; const h2 p2 = {ph, ph}; sA = sA - ba.xy * p2; sB = sB - ba.zw * p2; }
        float pb = dot2_f16_z(sA, kkb.xy); pb = __builtin_amdgcn_fdot2(sB, kkb.zw, pb, false);
        { float yq = dot2_f16_z(sA, ra.xy); yq = __builtin_amdgcn_fdot2(sB, ra.zw, yq, false); ypp[(2 * j) * YPS] = yq; }
        sA = sA * wb.xy + kb.xy * vhb; sB = sB * wb.zw + kb.zw * vhb;
        if (VAR != 4) pb = reduce16(pb);
        { const _Float16 ph = (_Float16)pb; const h2 p2 = {ph, ph}; sA = sA - bb.xy * p2; sB = sB - bb.zw * p2; }
        r_p = rb;
    }
    { float yq = dot2_f16_z(sA, r_p.xy); yq = __builtin_amdgcn_fdot2(sB, r_p.zw, yq, false); ypp[(TS - 1) * YPS] = yq; }
#undef RW_FETCH
}
#ifndef PROBE_T
#define PROBE_T 0
#endif
__device__ unsigned long long g_probe_acc;
#ifndef RW_VAR
#define RW_VAR 0
#endif
template <int VAR = 0> __device__ __forceinline__ void rwkv_scan_block(Frame& F, int chain, int quarter) {
    constexpr int TS = 32, NT = SEQT / TS;
    const int dir = chain & 1, h = (chain >> 1) % 6, b = (chain >> 1) / 6;
    LAS _Float16* vec = (LAS _Float16*)F.lds;
    LAS unsigned* vv = (LAS unsigned*)(vec + 2 * 5 * TS * 64);
    LAS float* yp = (LAS float*)(vv + 2 * TS * 16);
#ifndef RW_ROLE
#define RW_ROLE 0
#endif
    const bool comp = RW_ROLE ? (F.wave & 1) == 0 : F.wave < 4; const int rw = RW_ROLE ? F.wave >> 1 : F.wave & 3;
    const int rg = F.lane >> 4, lrow = rw * 4 + rg, lt = rw * 64 + F.lane; const int cgp = F.lane & 15;
    h2 sA = {(_Float16)0.f, (_Float16)0.f}, sB = sA;
    RwRaw RE, RO;
    const RwCtx C = rwkv_ctx(F, dir, h, quarter, lt);
    if (!comp && VAR != 1 && VAR != 6 && VAR != 11 && VAR != 16) { rwkv_load(RE, C, b, dir, 0); rwkv_store(RE, vec, vv, lt); rwkv_load(RO, C, b, dir, TS); rwkv_load(RE, C, b, dir, 2 * TS); }
    __syncthreads();
#define RW_TILE(tile, cur, RS) do { \
        if (comp) { if (VAR != 2) rwkv_compute_tile<VAR>(vec + (cur) * 5 * TS * 64 + cgp * 8, (const LAS u32x2*)(vv + (cur) * TS * 16) + lrow, yp + (cur) * TS * YPS + lrow * YPE + cgp, sA, sB); } \
        else if (VAR != 1 && VAR != 11) { \
            if (VAR != 6 && VAR != 16) { rwkv_store(RS, vec + ((cur) ^ 1) * 5 * TS * 64, vv + ((cur) ^ 1) * TS * 16, lt);     \
                rwkv_load(RS, C, b, dir, min((tile) + 3, NT - 1) * TS); } \
            if ((tile) > 0 && VAR != 5 && VAR != 15) rwkv_flush<(VAR < 10)>(C, yp + ((cur) ^ 1) * TS * YPS, b, dir, ((tile) - 1) * TS, lt); } \
        LDS_BARRIER(); } while (0)
    for (int tile = 0; tile < NT; tile += 2) { RW_TILE(tile, 0, RO); RW_TILE(tile + 1, 1, RE); }
#undef RW_TILE
    if (!comp && VAR != 1 && VAR != 11) rwkv_flush<(VAR < 10)>(C, yp + ((NT - 1) & 1) * TS * YPS, b, dir, (NT - 1) * TS, lt);
}

namespace ce {
constexpr int PITCH = 72, IMG = 64 * PITCH * 2;
constexpr int VTB = 96 * PITCH * 2;
constexpr int O_QG = 0, O_KG = 2 * IMG, O_KET = 4 * IMG, O_VT = 6 * IMG, O_PB = O_VT + 2 * VTB, O_ST = O_PB + IMG, O_DEC = O_ST + 2 * VTB, O_WSUM = O_DEC + 512, O_END = O_WSUM + 8 * 48 * 4, O_W2 = O_END, O_END2 = O_W2 + 17 * 48 * 4;
static_assert(O_END2 <= 131072, "chunk engine LDS");
__device__ __forceinline__ bf16x8 frag(const LAS unsigned char* img, int row, int col) { return *(const LAS bf16x8*)(img + (row * PITCH + col) * 2); }
__device__ __forceinline__ void st4(LAS unsigned char* img, int row, int col, f32x4 v) { u32x2 w; w.x = pk2(v.x, v.y); w.y = pk2(v.z, v.w); *(LAS u32x2*)(img + (row * PITCH + col) * 2) = w; }
__device__ __forceinline__ f32x2 up2(unsigned u) { f32x2 r; r.x = __uint_as_float(u << 16); r.y = __uint_as_float(u & 0xffff0000u); return r; }

template <int DV> __device__ __forceinline__ void chunk_mma(Frame& F, LAS unsigned char* L, int cb, int sb, f32x4 (&acc_s)[DV / 32], int b, int dir, int cs, int ycol0) {
    constexpr int NQ = DV / 32;
    const int lane = F.lane, w = F.wave, lr = lane & 15, lq = lane >> 4;
    LAS unsigned char* Qg = L + O_QG + cb * IMG; LAS unsigned char* Kg = L + O_KG + cb * IMG; LAS unsigned char* KeT = L + O_KET + cb * IMG;
    LAS unsigned char* Vt = L + O_VT + cb * VTB; LAS unsigned char* Pb = L + O_PB; LAS unsigned char* St = L + O_ST + sb * VTB; LAS unsigned char* Sn = L + O_ST + (sb ^ 1) * VTB;
    const LAS float* dec = (const LAS float*)(L + O_DEC + cb * 256);
#pragma unroll
    for (int q = 0; q < 2; ++q) { const int idx = w + 8 * q; if (idx < 10) {
            const int jt = idx < 4 ? 0 : idx < 7 ? 1 : idx < 9 ? 2 : 3; const int it = idx < 4 ? idx : idx < 7 ? idx - 3 : idx < 9 ? idx - 5 : 3;
            f32x4 acc = {0.f, 0.f, 0.f, 0.f};
#pragma unroll
            for (int ks = 0; ks < 2; ++ks) acc = __builtin_amdgcn_mfma_f32_16x16x32_bf16(frag(Kg, jt * 16 + lr, 32 * ks + 8 * lq), frag(Qg, it * 16 + lr, 32 * ks + 8 * lq), acc, 0, 0, 0);
            if (jt == it) {
#pragma unroll
                for (int r = 0; r < 4; ++r) if (4 * lq + r > lr) acc[r] = 0.f; }
            st4(Pb, it * 16 + lr, jt * 16 + 4 * lq, acc); } }
    LDS_BARRIER();
#pragma unroll
    for (int q = 0; q < NQ; ++q) { const int id = w + 8 * q, nt = id >> 2, it = id & 3;
        f32x4 acc = {0.f, 0.f, 0.f, 0.f};
#pragma unroll
        for (int ks = 0; ks < 2; ++ks) acc = __builtin_amdgcn_mfma_f32_16x16x32_bf16(frag(St, nt * 16 + lr, 32 * ks + 8 * lq), frag(Qg, it * 16 + lr, 32 * ks + 8 * lq), acc, 0, 0, 0);
#pragma unroll
        for (int ks = 0; ks < 2; ++ks) acc = __builtin_amdgcn_mfma_f32_16x16x32_bf16(frag(Vt, nt * 16 + lr, 32 * ks + 8 * lq), frag(Pb, it * 16 + lr, 32 * ks + 8 * lq), acc, 0, 0, 0);
        const int m = seq_row(b, dir, cs * 64 + it * 16 + lr); const int col = ycol0 + nt * 16 + 4 * lq;
        u32x2 o; o.x = pk2(acc.x, acc.y); o.y = pk2(acc.z, acc.w);
        if (dir == 0) *(u32x2*)(F.A + (size_t)m * DM + col) = o; else *(u32x2*)(F.Z + (size_t)m * ZP + YB_OFF + col) = o; }
#pragma unroll
    for (int q = 0; q < NQ; ++q) { const int id = w + 8 * q, kt = id & 3, nt = id >> 2;
        const f32x4 d4 = *(const LAS f32x4*)(dec + kt * 16 + 4 * lq);
        f32x4 acc = acc_s[q] * d4;
#pragma unroll
        for (int ks = 0; ks < 2; ++ks) acc = __builtin_amdgcn_mfma_f32_16x16x32_bf16(frag(KeT, kt * 16 + lr, 32 * ks + 8 * lq), frag(Vt, nt * 16 + lr, 32 * ks + 8 * lq), acc, 0, 0, 0);
        acc_s[q] = acc;
        st4(Sn, nt * 16 + lr, kt * 16 + 4 * lq, acc); }
}

__device__ __forceinline__ void ret_chain(Frame& F, int l, int chain) {
    constexpr int DV = 64, NCH = SEQT / 64;
    const int dir = chain & 1, h = (chain >> 1) & 3, b = chain >> 3;
    LAS unsigned char* L = F.lds;
    const int tp = F.tid >> 4, jj = F.tid & 15, t0 = 2 * tp, t1 = t0 + 1;
    const float lgam = -__expf(F.ap->in[I_RETLR][(l * 2 + dir) * 4 + h]);
    float eq[2], ek[2], ee[2];
#pragma unroll
    for (int e = 0; e < 2; ++e) { const float G = (float)(t0 + e + 1) * lgam; eq[e] = __expf(G); ek[e] = 0.125f * __expf(-G); ee[e] = 0.125f * __expf(64.0f * lgam - G); }
    const int d0 = 2 * jj;
    const bool rowb = d0 < 16; float inv[2];
#pragma unroll
    for (int e = 0; e < 2; ++e) inv[e] = powf(10000.0f, -(float)((d0 + e) & 15) * (1.0f / 16.0f));
    float ccs[2][2], csn[2][2];
#pragma unroll
    for (int tk = 0; tk < 2; ++tk)
#pragma unroll
        for (int e = 0; e < 2; ++e) { const float pos = (float)(dir ? 63 - (t0 + tk) : (t0 + tk)); sincosf(pos * inv[e], &csn[tk][e], &ccs[tk][e]); }
    for (int i = F.tid; i < IMG / 4; i += NTHR) ((LAS unsigned*)(L + O_PB))[i] = 0u;
    for (int i = F.tid; i < VTB / 4; i += NTHR) ((LAS unsigned*)(L + O_ST))[i] = 0u;
    if (F.tid < 128) ((LAS float*)(L + O_DEC))[F.tid] = __expf(64.0f * lgam);
    f32x4 acc_s[DV / 32];
#pragma unroll
    for (int q = 0; q < DV / 32; ++q) acc_s[q] = (f32x4){0.f, 0.f, 0.f, 0.f};
    unsigned rq[2][2], rk[2][2], rv[2][2];
    const bf16_t* Zc = F.Z + RET_OFF + h * 64 + d0;
#define RET_LOAD(cs_) do { _Pragma("unroll") for (int tk = 0; tk < 2; ++tk) { const int m = seq_row(b, dir, (cs_) * 64 + t0 + tk); const bf16_t* zr = Zc + (size_t)m * ZP; \
        rq[tk][0] = *(const unsigned*)(zr); rq[tk][1] = *(const unsigned*)(zr + 32); rk[tk][0] = *(const unsigned*)(zr + 256); rk[tk][1] = *(const unsigned*)(zr + 288); \
        rv[tk][0] = *(const unsigned*)(zr + 512); rv[tk][1] = *(const unsigned*)(zr + 544); } } while (0)
#define RET_STAGE(cs_, cb_) do { \
        LAS unsigned char* Qg = L + O_QG + (cb_) * IMG; LAS unsigned char* Kg = L + O_KG + (cb_) * IMG; LAS unsigned char* KeT = L + O_KET + (cb_) * IMG; LAS unsigned char* Vt = L + O_VT + (cb_) * VTB; \
        const bool lat = (cs_) >= 4; float rc[2] = {1.f, 1.f}, rs[2] = {0.f, 0.f}; \
        if (lat && rowb) { const float row = (float)(dir ? 127 - ((cs_) - 4) : (cs_) - 4); _Pragma("unroll") for (int e = 0; e < 2; ++e) { rs[e] = __sinf(row * inv[e]); rc[e] = __cosf(row * inv[e]); } } \
        f32x2 ke_lo[2], ke_hi[2], v_lo[2], v_hi[2]; \
        _Pragma("unroll") for (int tk = 0; tk < 2; ++tk) { \
            f32x2 q1 = up2(rq[tk][0]), q2 = up2(rq[tk][1]), k1 = up2(rk[tk][0]), k2 = up2(rk[tk][1]); \
            f32x2 c, s; if (rowb) { c.x = rc[0]; c.y = rc[1]; s.x = rs[0]; s.y = rs[1]; } else { c.x = lat ? ccs[tk][0] : 1.f; c.y = lat ? ccs[tk][1] : 1.f; s.x = lat ? csn[tk][0] : 0.f; s.y = lat ? csn[tk][1] : 0.f; } \
            const f32x2 qa = q1 * c - q2 * s, qb = q1 * s + q2 * c, ka = k1 * c - k2 * s, kb = k1 * s + k2 * c; \
            const int t = t0 + tk; \
            *(LAS unsigned*)(Qg + (t * PITCH + d0) * 2) = pk2(qa.x * eq[tk], qa.y * eq[tk]); *(LAS unsigned*)(Qg + (t * PITCH + d0 + 32) * 2) = pk2(qb.x * eq[tk], qb.y * eq[tk]); \
            *(LAS unsigned*)(Kg + (t * PITCH + d0) * 2) = pk2(ka.x * ek[tk], ka.y * ek[tk]); *(LAS unsigned*)(Kg + (t * PITCH + d0 + 32) * 2) = pk2(kb.x * ek[tk], kb.y * ek[tk]); \
            ke_lo[tk] = ka * ee[tk]; ke_hi[tk] = kb * ee[tk]; v_lo[tk] = up2(rv[tk][0]); v_hi[tk] = up2(rv[tk][1]); } \
        *(LAS unsigned*)(KeT + ((d0) * PITCH + t0) * 2) = pk2(ke_lo[0].x, ke_lo[1].x); *(LAS unsigned*)(KeT + ((d0 + 1) * PITCH + t0) * 2) = pk2(ke_lo[0].y, ke_lo[1].y); \
        *(LAS unsigned*)(KeT + ((d0 + 32) * PITCH + t0) * 2) = pk2(ke_hi[0].x, ke_hi[1].x); *(LAS unsigned*)(KeT + ((d0 + 33) * PITCH + t0) * 2) = pk2(ke_hi[0].y, ke_hi[1].y); \
        *(LAS unsigned*)(Vt + ((d0) * PITCH + t0) * 2) = pk2(v_lo[0].x, v_lo[1].x); *(LAS unsigned*)(Vt + ((d0 + 1) * PITCH + t0) * 2) = pk2(v_lo[0].y, v_lo[1].y); \
        *(LAS unsigned*)(Vt + ((d0 + 32) * PITCH + t0) * 2) = pk2(v_hi[0].x, v_hi[1].x); *(LAS unsigned*)(Vt + ((d0 + 33) * PITCH + t0) * 2) = pk2(v_hi[0].y, v_hi[1].y); \
    } while (0)
    RET_LOAD(0); RET_STAGE(0, 0);
    __syncthreads();
    for (int cs = 0; cs < NCH; ++cs) { const int cb = cs & 1;
        if (cs + 1 < NCH) RET_LOAD(cs + 1);
        chunk_mma<DV>(F, L, cb, cb, acc_s, b, dir, cs, 768 + h * 64);
        if (cs + 1 < NCH) RET_STAGE(cs + 1, cb ^ 1);
        LDS_BARRIER();
    }
#undef RET_LOAD
#undef RET_STAGE
}

__device__ __forceinline__ void gla_chain(Frame& F, int l, int chain) {
    constexpr int DV = 96, NCH = SEQT / 64;
    const int dir = chain & 1, h = (chain >> 1) & 3, b = chain >> 3;
    LAS unsigned char* L = F.lds;
    const int t = F.tid >> 3, j8 = F.tid & 7, d0 = 2 * j8;
    const float qs = 0.14433756729740643f;
    for (int i = F.tid; i < O_END / 4; i += NTHR) ((LAS unsigned*)L)[i] = 0u;
    f32x4 acc_s[DV / 32];
#pragma unroll
    for (int q = 0; q < DV / 32; ++q) acc_s[q] = (f32x4){0.f, 0.f, 0.f, 0.f};
    unsigned rq[3], rk[3], rv[6]; f32x2 rg[3], rge[3];
    const bf16_t* Zc = F.Z + GLA_OFF + h * 48 + d0;
#define GLA_GP(m_) ((dir == 0 ? (const float*)(F.A + (size_t)(m_) * DM) : (const float*)(F.Z + (size_t)(m_) * ZP + YB_OFF)) + h * 48 + d0)
#define GLA_LOAD(cs_) do { const int m = seq_row(b, dir, (cs_) * 64 + t); const bf16_t* zr = Zc + (size_t)m * ZP; const bf16_t* zv = F.Z + (size_t)m * ZP + GLA_OFF + 384 + h * 96 + d0; \
        _Pragma("unroll") for (int q = 0; q < 3; ++q) { rq[q] = *(const unsigned*)(zr + 16 * q); rk[q] = *(const unsigned*)(zr + 192 + 16 * q); } \
        _Pragma("unroll") for (int q = 0; q < 6; ++q) rv[q] = *(const unsigned*)(zv + 16 * q); \
        const float* gp = GLA_GP(m); const float* ge = GLA_GP(seq_row(b, dir, (cs_) * 64 + 63)); \
        _Pragma("unroll") for (int q = 0; q < 3; ++q) { rg[q] = *(const f32x2*)(gp + 16 * q); rge[q] = *(const f32x2*)(ge + 16 * q); } } while (0)
#define GLA_STAGE(cs_, cb_) do { \
        LAS unsigned char* Qg = L + O_QG + (cb_) * IMG; LAS unsigned char* Kg = L + O_KG + (cb_) * IMG; LAS unsigned char* KeT = L + O_KET + (cb_) * IMG; LAS unsigned char* Vt = L + O_VT + (cb_) * VTB; \
        if (t == 0) { _Pragma("unroll") for (int q = 0; q < 3; ++q) *(LAS f32x2*)((LAS float*)(L + O_DEC + (cb_) * 256) + d0 + 16 * q) = (f32x2){__expf(rge[q].x), __expf(rge[q].y)}; } \
        _Pragma("unroll") for (int q = 0; q < 3; ++q) { const f32x2 qv = up2(rq[q]), kv = up2(rk[q]); const int d = d0 + 16 * q; const float g0 = rg[q].x, g1 = rg[q].y; \
            const float eq0 = __expf(g0) * qs, eq1 = __expf(g1) * qs, ek0 = __expf(-g0), ek1 = __expf(-g1), ee0 = __expf(rge[q].x - g0), ee1 = __expf(rge[q].y - g1); \
            *(LAS unsigned*)(Qg + (t * PITCH + d) * 2) = pk2(qv.x * eq0, qv.y * eq1); *(LAS unsigned*)(Kg + (t * PITCH + d) * 2) = pk2(kv.x * ek0, kv.y * ek1); \
            *(LAS bf16_t*)(KeT + (d * PITCH + t) * 2) = f2bf(kv.x * ee0); *(LAS bf16_t*)(KeT + ((d + 1) * PITCH + t) * 2) = f2bf(kv.y * ee1); } \
        _Pragma("unroll") for (int q = 0; q < 6; ++q) { const int d = d0 + 16 * q; *(LAS bf16_t*)(Vt + (d * PITCH + t) * 2) = (bf16_t)(rv[q] & 0xffffu); *(LAS bf16_t*)(Vt + ((d + 1) * PITCH + t) * 2) = (bf16_t)(rv[q] >> 16); } \
    } while (0)
    __syncthreads();
    GLA_LOAD(0); GLA_STAGE(0, 0);
    __syncthreads();
    for (int cs = 0; cs < NCH; ++cs) { const int cb = cs & 1;
        if (cs + 1 < NCH) GLA_LOAD(cs + 1);
        chunk_mma<DV>(F, L, cb, cb, acc_s, b, dir, cs, h * 96);
        if (cs + 1 < NCH) GLA_STAGE(cs + 1, cb ^ 1);
        LDS_BARRIER();
    }
#undef GLA_LOAD
#undef GLA_STAGE
#undef GLA_GP
}
}

#ifndef PROBE_DUP
#define PROBE_DUP 0
#endif
__device__ __forceinline__ void phase_scan(Frame& F, int l) {
    for (int task = F.bid; task < 256; task += F.G) {
        const int rw_chain = (task & 7) * 6 + (task >> 5), rw_quarter = (task >> 3) & 3;
        if ((PROBE_DUP & 32) && task < 192) { rwkv_scan_block<RW_VAR>(F, rw_chain, rw_quarter); __syncthreads(); }
        if ((PROBE_DUP & 64) && task >= 192 && task < 224) { ce::gla_chain(F, l, task - 192); __syncthreads(); }
        if ((PROBE_DUP & 128) && task >= 224) { ce::ret_chain(F, l, task - 224); __syncthreads(); }
        if (task >= 192 && F.G == 256) {
            gla_gate_units(F, l, task - 192, 64);
            group_arrive((unsigned*)(F.ws + WS_CTL) + 8192 + l * 64, 64u, task < 224);
        }
        if (task < 192) { rwkv_scan_block(F, rw_chain, rw_quarter); if (PROBE_DUP & 256) { __syncthreads(); rwkv_scan_block<RW_VAR>(F, rw_chain, rw_quarter); } }
        else if (task < 224) {
#if SCAN_GLA_V0
            gla_scan_block(F, l, task - 192);
#else
            ce::gla_chain(F, l, task - 192);
#endif
        } else ce::ret_chain(F, l, task - 224);
        __syncthreads();
    }
}
namespace pp {
constexpr int OSP = 392;
__device__ __forceinline__ bf16x8 pack8(const float (&w)[8]) { u32x4 u; u.x = pk2(w[0], w[1]); u.y = pk2(w[2], w[3]); u.z = pk2(w[4], w[5]); u.w = pk2(w[6], w[7]); return __builtin_bit_cast(bf16x8, u); }
__device__ __forceinline__ void unpack8(u32x4 r, float (&o)[8]) {
    o[0] = __uint_as_float(r.x << 16); o[1] = __uint_as_float(r.x & 0xffff0000u); o[2] = __uint_as_float(r.y << 16); o[3] = __uint_as_float(r.y & 0xffff0000u);
    o[4] = __uint_as_float(r.z << 16); o[5] = __uint_as_float(r.z & 0xffff0000u); o[6] = __uint_as_float(r.w << 16); o[7] = __uint_as_float(r.w & 0xffff0000u); }
__device__ __forceinline__ u32x4 pack8h(const float (&w)[8]) { u32x4 u; u.x = pkh2(w[0], w[1]); u.y = pkh2(w[2], w[3]); u.z = pkh2(w[4], w[5]); u.w = pkh2(w[6], w[7]); return u; }
__device__ __forceinline__ u32x4 pack8u(const float (&w)[8]) { u32x4 u; u.x = pk2(w[0], w[1]); u.y = pk2(w[2], w[3]); u.z = pk2(w[4], w[5]); u.w = pk2(w[6], w[7]); return u; }
struct Z5 { u32x4 c, n0, n1, n2, n3; };
__device__ __forceinline__ Z5 load5(const bf16_t* p, const ZNb& n) { Z5 z; z.c = *(const u32x4*)p; z.n0 = *(const u32x4*)(p + n.o[0]); z.n1 = *(const u32x4*)(p + n.o[1]); z.n2 = *(const u32x4*)(p + n.o[2]); z.n3 = *(const u32x4*)(p + n.o[3]); return z; }
__device__ __forceinline__ void mix8(const Z5& z, const ZNb& n, const float* mu8, float (&o)[8]) {
    float zc[8], a0[8], a1[8], a2[8], a3[8]; unpack8(z.c, zc); unpack8(z.n0, a0); unpack8(z.n1, a1); unpack8(z.n2, a2); unpack8(z.n3, a3);
#pragma unroll
    for (int e = 0; e < 8; ++e) { const float nb = (a0[e] * n.w[0] + a1[e] * n.w[1]) + (a2[e] * n.w[2] + a3[e] * n.w[3]); o[e] = zc[e] + mu8[e] * (nb - zc[e]); }
}
__device__ __forceinline__ void shift8(const bf16_t* p, const ZNb& n, const float* mu8, float (&o)[8]) { const Z5 z = load5(p, n); mix8(z, n, mu8, o); }

__device__ __forceinline__ void phase_prep(Frame& F, int l) {
    constexpr int ZSP = 488;
    LAS unsigned char* L = F.lds;
    LAS bf16_t* zs = (LAS bf16_t*)L;
    LAS bf16_t* os = (LAS bf16_t*)(L + 16 * ZSP * 2);
    LAS float* mus = (LAS float*)(L + 16 * ZSP * 2 + 5 * 16 * OSP * 2);
    const float* mu = F.ap->in[I_RMU] + l * 1312;
    for (int i = F.tid; i < 1248; i += NTHR) mus[i] = mu[i];
    const int lr = F.lane & 15, lq = F.lane >> 4, h = F.wave;
    bf16x8 Bf[4], Bb[4], Ba[4]; float w0f[4][4], w0b[4][4], a0[4][4], kk_[4][4], ka_[4][4];
    if (h < 6) {
#pragma unroll
        for (int nt = 0; nt < 4; ++nt) { const int col = h * 64 + 16 * nt + lr; float t0[8], t1[8], t2[8];
#pragma unroll
            for (int j = 0; j < 8; ++j) { const int k = 8 * lq + j; t0[j] = F.ap->in[I_RW2][((size_t)(l * 2 + 0) * 32 + k) * 384 + col]; t1[j] = F.ap->in[I_RW2][((size_t)(l * 2 + 1) * 32 + k) * 384 + col]; t2[j] = F.ap->in[I_RA2][((size_t)l * 32 + k) * 384 + col]; }
            Bf[nt] = pack8(t0); Bb[nt] = pack8(t1); Ba[nt] = pack8(t2);
#pragma unroll
            for (int r = 0; r < 4; ++r) { const int c2 = h * 64 + 16 * nt + 4 * lq + r;
                w0f[nt][r] = F.ap->in[I_RW0][(l * 2 + 0) * 384 + c2]; w0b[nt][r] = F.ap->in[I_RW0][(l * 2 + 1) * 384 + c2]; a0[nt][r] = F.ap->in[I_RA0][l * 384 + c2];
                kk_[nt][r] = F.ap->in[I_RKK][l * 384 + c2]; ka_[nt][r] = F.ap->in[I_RKA][l * 384 + c2]; } }
    }
    __syncthreads();
    const bool strips = (F.G == 256);
    for (int iu = 0; iu < 9; ++iu) {
        int m0;
        if (strips) { if (iu < 8) { const int q = F.bid * 8 + iu, s = q >> 7, r = q & 127; m0 = (s >> 2) * SEQ + r * 64 + (s & 3) * 16; } else { if (F.bid >= MC / 16) break; m0 = ML + F.bid * 16; } }
        else { if (iu > 0) break; m0 = -1; }
      for (int it = strips ? 0 : F.bid; it < (strips ? 1 : MT / 16); it += F.G) {
        if (!strips) m0 = it * 16;
        { constexpr int NP = 16 * 156;
          int pn = F.tid; int tokn = pn / 156, gin = pn - tokn * 156; ZNb nbn = znb(m0 + tokn); Z5 zn = load5(F.Z + (size_t)(m0 + tokn) * ZP + RW_OFF + gin * 8, nbn);
#pragma unroll
          for (int k = 0; k < 5; ++k) { const int p = F.tid + NTHR * k; if (p < NP) {
              const int tok = tokn, col0 = gin * 8, m = m0 + tok; const ZNb nbv = nbn; const Z5 zc = zn;
              if (k < 4) { pn = p + NTHR; if (pn < NP) { tokn = pn / 156; gin = pn - tokn * 156; nbn = znb(m0 + tokn); zn = load5(F.Z + (size_t)(m0 + tokn) * ZP + RW_OFF + gin * 8, nbn); } }
              float o[8]; float mu8[8];
#pragma unroll
              for (int e = 0; e < 8; ++e) mu8[e] = mus[col0 + e];
              mix8(zc, nbv, mu8, o);
              if (col0 < 384) *(u32x4*)(F.PREP + PR_R * PREP_STRIDE + (size_t)m * 384 + col0) = pack8h(o);
              else if (col0 < 768) *(LAS u32x4*)(zs + tok * ZSP + (col0 - 384)) = pack8u(o);
              else if (col0 < 1152) *(u32x4*)(F.PREP + PR_V * PREP_STRIDE + (size_t)m * 384 + (col0 - 768)) = pack8h(o);
              else { if (col0 < 1216) {
#pragma unroll
                      for (int e = 0; e < 8; ++e) o[e] = fast_tanh(o[e]); }
                  *(LAS u32x4*)(zs + tok * ZSP + 384 + (col0 - 1152)) = pack8u(o); } } }
        }
        __syncthreads();
        if (h < 6) {
            const bf16x8 af = *(const LAS bf16x8*)(zs + lr * ZSP + 384 + 8 * lq), ab = *(const LAS bf16x8*)(zs + lr * ZSP + 416 + 8 * lq), aa = *(const LAS bf16x8*)(zs + lr * ZSP + 448 + 8 * lq);
            float kv[4][4], kkv[4][4], av[4][4]; float ss = 0.f; const size_t orow = (size_t)(m0 + lr) * 384;
#pragma unroll
            for (int nt = 0; nt < 4; ++nt) { const f32x4 z4 = {0.f, 0.f, 0.f, 0.f};
                const f32x4 xf = __builtin_amdgcn_mfma_f32_16x16x32_bf16(Bf[nt], af, z4, 0, 0, 0), xb = __builtin_amdgcn_mfma_f32_16x16x32_bf16(Bb[nt], ab, z4, 0, 0, 0), xa = __builtin_amdgcn_mfma_f32_16x16x32_bf16(Ba[nt], aa, z4, 0, 0, 0);
                const int cl = h * 64 + 16 * nt + 4 * lq;
                const u32x2 kraw = *(const LAS u32x2*)(zs + lr * ZSP + cl); const f32x2 k01 = ce::up2(kraw.x), k23 = ce::up2(kraw.y); const float kq[4] = {k01.x, k01.y, k23.x, k23.y};
                float dwf[4], dwb[4];
#pragma unroll
                for (int r = 0; r < 4; ++r) {
                    const float ef = sigmoidf_(xf[r] + w0f[nt][r]) * 0.6065306597f, eb = sigmoidf_(xb[r] + w0b[nt][r]) * 0.6065306597f;
                    dwf[r] = __expf(-ef); dwb[r] = __expf(-eb);
                    const float a = sigmoidf_(xa[r] + a0[nt][r]); const float kx = kq[r] * kk_[nt][r];
                    kv[nt][r] = kq[r]; kkv[nt][r] = kx; av[nt][r] = a; ss += kx * kx; }
                *(u32x2*)(F.PREP + (size_t)PR_WF * PREP_STRIDE + orow + cl) = (u32x2){pkh2(dwf[0], dwf[1]), pkh2(dwf[2], dwf[3])};
                *(u32x2*)(F.PREP + (size_t)PR_WB * PREP_STRIDE + orow + cl) = (u32x2){pkh2(dwb[0], dwb[1]), pkh2(dwb[2], dwb[3])}; }
            { auto r1 = __builtin_amdgcn_permlane16_swap(__float_as_uint(ss), __float_as_uint(ss), false, false); ss = __uint_as_float(r1[0]) + __uint_as_float(r1[1]);
              auto r2 = __builtin_amdgcn_permlane32_swap(__float_as_uint(ss), __float_as_uint(ss), false, false); ss = __uint_as_float(r2[0]) + __uint_as_float(r2[1]); }
            const float rn = rsqrtf(ss + 1e-12f);
#pragma unroll
            for (int nt = 0; nt < 4; ++nt) { const int cl = h * 64 + 16 * nt + 4 * lq; float kp[4], kk[4], bb[4];
#pragma unroll
                for (int r = 0; r < 4; ++r) { kk[r] = kkv[nt][r] * rn; const float a = av[nt][r]; kp[r] = kv[nt][r] * (1.f + (a - 1.f) * ka_[nt][r]); bb[r] = kk[r] * a; }
                *(u32x2*)(F.PREP + (size_t)PR_K * PREP_STRIDE + orow + cl) = (u32x2){pkh2(kp[0], kp[1]), pkh2(kp[2], kp[3])};
                *(u32x2*)(F.PREP + (size_t)PR_KK * PREP_STRIDE + orow + cl) = (u32x2){pkh2(kk[0], kk[1]), pkh2(kk[2], kk[3])};
                *(u32x2*)(F.PREP + (size_t)PR_B * PREP_STRIDE + orow + cl) = (u32x2){pkh2(bb[0], bb[1]), pkh2(bb[2], bb[3])}; }
        }
        __syncthreads();
      }
    }
}

__device__ __forceinline__ void phase_post(Frame& F, int l, int Mrows) {
    constexpr int SGP = 72;
    LAS unsigned char* L = F.lds;
    LAS bf16_t* in5 = (LAS bf16_t*)L;
    LAS bf16_t* sgs = (LAS bf16_t*)(L + 5 * 16 * OSP * 2);
    LAS bf16_t* outs = (LAS bf16_t*)(L + 5 * 16 * OSP * 2 + 16 * SGP * 2);
    const float* mu = F.ap->in[I_RMU] + l * 1312 + 1248;
    const int lr = F.lane & 15, lq = F.lane >> 4, h = F.wave;
    bf16x8 Bg[4][2]; float lng[4][4], lnb[4][4], rk[4][4];
    if (h < 6) {
#pragma unroll
        for (int nt = 0; nt < 4; ++nt) { const int col = h * 64 + 16 * nt + lr;
#pragma unroll
            for (int ks = 0; ks < 2; ++ks) { float t0[8];
#pragma unroll
                for (int j = 0; j < 8; ++j) t0[j] = F.ap->in[I_RG2][((size_t)l * 64 + 32 * ks + 8 * lq + j) * 384 + col];
                Bg[nt][ks] = pack8(t0); }
#pragma unroll
            for (int r = 0; r < 4; ++r) { const int c2 = h * 64 + 16 * nt + 4 * lq + r; lng[nt][r] = F.ap->in[I_RLNG][l * 384 + c2]; lnb[nt][r] = F.ap->in[I_RLNB][l * 384 + c2]; rk[nt][r] = F.ap->in[I_RRK][l * 384 + c2]; } }
    }
    const bool strips = (F.G == 256);
    for (int iu = 0; iu < 9; ++iu) {
        int m0;
        if (strips) { if (iu < 8) { const int q = F.bid * 8 + iu, s = q >> 7, r = q & 127; m0 = (s >> 2) * SEQ + r * 64 + (s & 3) * 16; } else { if (Mrows <= ML || F.bid >= MC / 16) break; m0 = ML + F.bid * 16; } }
        else { if (iu > 0) break; m0 = -1; }
      for (int it = strips ? 0 : F.bid; it < (strips ? 1 : Mrows / 16); it += F.G) {
        if (!strips) m0 = it * 16;
        for (int p = F.tid; p < 5 * 16 * 48; p += NTHR) { const int t = p / 768, rem = p - t * 768, tok = rem / 48, pc = rem - tok * 48; const int m = m0 + tok;
            const bf16_t* src = t == 0 ? F.A + (size_t)m * DM + 384 + pc * 8 : t == 1 ? F.Z + (size_t)m * ZP + YB_OFF + 384 + pc * 8
                              : F.PREP + (size_t)(t == 2 ? PR_R : t == 3 ? PR_K : PR_V) * PREP_STRIDE + (size_t)m * 384 + pc * 8;
            *(LAS u32x4*)(in5 + (t * 16 + tok) * OSP + pc * 8) = *(const u32x4*)src; }
        {
            const int u = F.tid >> 2, sub = F.tid & 3, tok = u >> 3, hu = u & 7, m = m0 + tok; const bool gla = hu < 4;
            const int ycol = gla ? hu * 96 : 768 + (hu - 4) * 64, gcol = gla ? GLA_OFF + 768 + hu * 96 : RET_OFF + 768 + (hu - 4) * 64, npc = gla ? 3 : 2;
            const float* gain = gla ? F.ap->in[I_GNG] + l * 384 + hu * 96 : F.ap->in[I_RETNG] + l * 256 + (hu - 4) * 64;
            bf16_t* ar = F.A + (size_t)m * DM + ycol; const bf16_t* zb = F.Z + (size_t)m * ZP + YB_OFF + ycol; const bf16_t* zg = F.Z + (size_t)m * ZP + gcol;
            u32x4 ya[3], yb2[3], gz[3];
#pragma unroll
            for (int i = 0; i < 3; ++i) if (i < npc) { const int pc = sub + 4 * i; ya[i] = *(const u32x4*)(ar + pc * 8); yb2[i] = *(const u32x4*)(zb + pc * 8); gz[i] = *(const u32x4*)(zg + pc * 8); }
            float yv[3][8]; float ssq = 0.f;
#pragma unroll
            for (int i = 0; i < 3; ++i) if (i < npc) { float b8[8]; unpack8(ya[i], yv[i]); unpack8(yb2[i], b8);
#pragma unroll
                for (int e = 0; e < 8; ++e) { yv[i][e] += b8[e]; ssq += yv[i][e] * yv[i][e]; } }
            ssq += dpp_mov<0xB1>(ssq); ssq += dpp_mov<0x4E>(ssq);
            const float rn = rsqrtf(ssq / (gla ? 96.f : 64.f) + 1e-6f);
#pragma unroll
            for (int i = 0; i < 3; ++i) if (i < npc) { const int pc = sub + 4 * i; float g[8]; unpack8(gz[i], g);
                const f32x4 g0 = *(const f32x4*)(gain + pc * 8), g1 = *(const f32x4*)(gain + pc * 8 + 4); const float gg[8] = {g0.x, g0.y, g0.z, g0.w, g1.x, g1.y, g1.z, g1.w};
#pragma unroll
                for (int e = 0; e < 8; ++e) yv[i][e] = siluf_(g[e]) * yv[i][e] * rn * gg[e];
                *(u32x4*)(ar + pc * 8) = pack8u(yv[i]); }
        }
        if (F.tid < 128) { const int tok = F.tid >> 3, gi = F.tid & 7, m = m0 + tok; const ZNb nbv = znb(m); float o[8], mu8[8];
#pragma unroll
            for (int e = 0; e < 8; ++e) mu8[e] = mu[gi * 8 + e];
            shift8(F.Z + (size_t)m * ZP + RW_OFF + 1248 + gi * 8, nbv, mu8, o);
#pragma unroll
            for (int e = 0; e < 8; ++e) o[e] = sigmoidf_(o[e]);
            *(LAS u32x4*)(sgs + tok * SGP + gi * 8) = pack8u(o); }
        __syncthreads();
        if (h < 6) {
            const bf16x8 a0 = *(const LAS bf16x8*)(sgs + lr * SGP + 8 * lq), a1 = *(const LAS bf16x8*)(sgs + lr * SGP + 32 + 8 * lq);
            float yv[4][4], gt[4][4], vv4[4][4]; float s1 = 0.f, s2 = 0.f, s3 = 0.f;
#pragma unroll
            for (int nt = 0; nt < 4; ++nt) { f32x4 g4 = {0.f, 0.f, 0.f, 0.f};
                g4 = __builtin_amdgcn_mfma_f32_16x16x32_bf16(Bg[nt][0], a0, g4, 0, 0, 0); g4 = __builtin_amdgcn_mfma_f32_16x16x32_bf16(Bg[nt][1], a1, g4, 0, 0, 0);
                const int cl = h * 64 + 16 * nt + 4 * lq;
                const u32x2 q0 = *(const LAS u32x2*)(in5 + (0 * 16 + lr) * OSP + cl), q1 = *(const LAS u32x2*)(in5 + (1 * 16 + lr) * OSP + cl), q2 = *(const LAS u32x2*)(in5 + (2 * 16 + lr) * OSP + cl);
                const u32x2 q3 = *(const LAS u32x2*)(in5 + (3 * 16 + lr) * OSP + cl), q4 = *(const LAS u32x2*)(in5 + (4 * 16 + lr) * OSP + cl);
                const f32x2 f0a = ce::up2(q0.x), f0b = ce::up2(q0.y), f1a = ce::up2(q1.x), f1b = ce::up2(q1.y), f2a = uph2(q2.x), f2b = uph2(q2.y), f3a = uph2(q3.x), f3b = uph2(q3.y), f4a = uph2(q4.x), f4b = uph2(q4.y);
                const float yf[4] = {f0a.x, f0a.y, f0b.x, f0b.y}, yb_[4] = {f1a.x, f1a.y, f1b.x, f1b.y}, rr[4] = {f2a.x, f2a.y, f2b.x, f2b.y}, kp[4] = {f3a.x, f3a.y, f3b.x, f3b.y}, vv[4] = {f4a.x, f4a.y, f4b.x, f4b.y};
#pragma unroll
                for (int r = 0; r < 4; ++r) { const float y = yf[r] + yb_[r]; yv[nt][r] = y; gt[nt][r] = g4[r]; vv4[nt][r] = vv[r]; s1 += y; s2 += y * y; s3 += rr[r] * kp[r] * rk[nt][r]; } }
#define PP_SUM4(x) do { auto r1_ = __builtin_amdgcn_permlane16_swap(__float_as_uint(x), __float_as_uint(x), false, false); x = __uint_as_float(r1_[0]) + __uint_as_float(r1_[1]); \
                        auto r2_ = __builtin_amdgcn_permlane32_swap(__float_as_uint(x), __float_as_uint(x), false, false); x = __uint_as_float(r2_[0]) + __uint_as_float(r2_[1]); } while (0)
            PP_SUM4(s1); PP_SUM4(s2); PP_SUM4(s3);
#undef PP_SUM4
            const float mean = s1 * (1.f / 64.f); const float rstd = rsqrtf(fmaxf(s2 * (1.f / 64.f) - mean * mean, 0.f) + 64e-5f);
            bf16_t* orow = F.A + (size_t)(m0 + lr) * DM + 384;
#pragma unroll
            for (int nt = 0; nt < 4; ++nt) { const int cl = h * 64 + 16 * nt + 4 * lq; float o[4];
#pragma unroll
                for (int r = 0; r < 4; ++r) { const float yn = (yv[nt][r] - mean) * rstd * lng[nt][r] + lnb[nt][r]; o[r] = (yn + s3 * vv4[nt][r]) * gt[nt][r]; }
                *(u32x2*)(orow + cl) = (u32x2){pk2(o[0], o[1]), pk2(o[2], o[3])}; }
        }
        __syncthreads();
      }
    }
}
}
using pp::phase_prep;
using pp::phase_post;
constexpr int PH_PER_LAYER = 9, N_PHASES = 1 + DEPTH * PH_PER_LAYER + 1;
#define PHASE_ENTER() \
    CArgs ap = (CArgs)__builtin_amdgcn_kernarg_segment_ptr(); asm volatile("" : "+s"(ap)); \
    int tid = threadIdx.x; asm volatile("" : "+v"(tid)); \
    Frame F; F.lds = lds; F.ap = ap; F.tid = tid; F.lane = tid & 63; F.wave = __builtin_amdgcn_readfirstlane(tid >> 6); F.bid = blockIdx.x; F.G = gridDim.x; \
    unsigned char* ws = ap->ws; F.out = ap->out; F.ws = ws; \
    F.mod = (float*)(ws + WS_MOD); F.Win_t = (bf16_t*)(ws + WS_WIN); F.Wout_t = (bf16_t*)(ws + WS_WOUT); F.W1_t = (bf16_t*)(ws + WS_W1); F.W2_t = (bf16_t*)(ws + WS_W2); \
    F.xc = (float*)(ws + WS_XC); F.A = (bf16_t*)(ws + WS_ABUF); F.Z = (bf16_t*)(ws + WS_Z); F.PREP = (bf16_t*)(ws + WS_PREP); F.H = (bf16_t*)(ws + WS_H); \
    const float* modl = F.mod + (size_t)L * 5 * 6144; (void)modl; \
    bf16_t* XB = (bf16_t*)F.out; bf16_t* XCB = (bf16_t*)F.xc; (void)XB; (void)XCB;     \
    const void* xl_in = L == 0 ? (const void*)F.ap->in[I_X] : (const void*)XB; const void* xc_in = L == 0 ? (const void*)F.ap->in[I_CTX] : (const void*)XCB; (void)xl_in; (void)xc_in;

#ifndef PROBE_T
#define PROBE_T 0
#endif
#define PB_SCAN (PROBE_T == 13 || PROBE_T == 14 || PROBE_T == 17)
#define PB_BLK (PROBE_T == 13 ? 192 : PROBE_T == 14 ? 224 : 0)
#define IN(k) (lo <= (k) && (k) < hi)
#define SEAM(k) do { if (IN(k) && IN((k) + 1)) { if ((k) == 0 && gridDim.x != 256) grid.sync(); else xcd_barrier(bar); } } while (0)
#define T_PREV (*(volatile LAS unsigned long long*)(lds + LDS_BYTES - 128))
#define T_ACC (*(volatile LAS unsigned long long*)(lds + LDS_BYTES - 120))
#define STAMP(id) do { if (PROBE_T == (id) && blockIdx.x == 0 && threadIdx.x == 0) { const unsigned long long now_ = __builtin_amdgcn_s_memrealtime(); T_ACC = T_ACC + (now_ - T_PREV); } \
                       if (PROBE_T && PROBE_T == (id) + 1 && blockIdx.x == 0 && threadIdx.x == 0) T_PREV = __builtin_amdgcn_s_memrealtime(); } while (0)
template <int L> __device__ __forceinline__ void run_layer(int lo, int hi, LAS unsigned char* lds, cg::grid_group& grid, const XcdBarrier& bar) {
    constexpr int p0 = 1 + L * PH_PER_LAYER; constexpr bool last = (L == DEPTH - 1); constexpr int Mo = last ? ML : MT;
    if (PROBE_T == 2 && blockIdx.x == 0 && threadIdx.x == 0) T_PREV = __builtin_amdgcn_s_memrealtime();
    if (IN(p0 + 0)) { PHASE_ENTER(); phase_wconv(F, L, L == 0 ? 3 : 2); if (L == 0) phase_norm<false>(F, xl_in, xc_in, F.ap->in[I_N1G] + L * DM, modl, 0, 1, MT); else phase_norm<true>(F, xl_in, xc_in, F.ap->in[I_N1G] + L * DM, modl, 0, 1, MT, ML); } SEAM(p0 + 0); STAMP(2);
    if (IN(p0 + 1)) { PHASE_ENTER(); pg8::Gemm g{F.A, F.Win_t, MT, ZP, DM}; pg8::StaticOrder S; S.init(MT, ZP, F.G, F.bid); pg8::EpiBf16<0> E{F.Z, ZP};
        pg8::gemm_phase<pg8::EpiBf16<0>, pg8::StaticOrder, true, true>(F.lds, g, S, E, tid); } SEAM(p0 + 1); STAMP(3);
    if (IN(p0 + 2)) { PHASE_ENTER(); phase_prep(F, L); if (F.G != 256) { xcd_barrier(bar); gla_gate_units(F, L, F.bid, F.G); } } SEAM(p0 + 2); STAMP(4); STAMP(5);
    { if (PB_SCAN && blockIdx.x == PB_BLK && threadIdx.x == 0) T_PREV = __builtin_amdgcn_s_memrealtime();
      if (IN(p0 + 3)) { PHASE_ENTER(); phase_scan(F, L); }
      if (PB_SCAN && blockIdx.x == PB_BLK && threadIdx.x == 0) T_ACC = T_ACC + (__builtin_amdgcn_s_memrealtime() - T_PREV); }
    SEAM(p0 + 3); STAMP(6);
    if (IN(p0 + 4)) { PHASE_ENTER(); phase_post(F, L, Mo); } SEAM(p0 + 4); STAMP(7);
    if (IN(p0 + 5)) { { PHASE_ENTER(); pg8::Gemm g{F.A, F.Wout_t, ML, DM, DM}; pg8::StaticOrder S; S.init(ML, DM, F.G, F.bid); pg8::EpiRes<L != 0> E{xl_in, xc_in, XB, XCB, modl + 2 * 1024, 0};
        pg8::gemm_phase<pg8::EpiRes<L != 0>, pg8::StaticOrder, true, true>(F.lds, g, S, E, tid); }
      if (L == 0) { xcd_barrier(bar);
        { PHASE_ENTER(); if (F.bid < 16) { pg8::Gemm g{F.A + (size_t)ML * DM, F.Wout_t, MC, DM, DM}; pg8::StaticOrder S; S.init(MC, DM, 16, F.bid); pg8::EpiRes<L != 0> E{xl_in, xc_in, XB, XCB, modl + 2 * 1024, ML / 256};
              pg8::gemm_phase<pg8::EpiRes<L != 0>, pg8::StaticOrder, true, true>(F.lds, g, S, E, tid); }
          else phase_norm<true>(F, XB, XCB, F.ap->in[I_N2G] + L * DM, modl, 3, 4, ML, 0, 16, F.G - 16); }
        xcd_barrier(bar);
        { PHASE_ENTER(); phase_norm<true>(F, XB, XCB, F.ap->in[I_N2G] + L * DM, modl, 3, 4, MT, ML); } } } SEAM(p0 + 5); STAMP(8);
    if (IN(p0 + 6)) { if (L != 0) { PHASE_ENTER(); phase_norm<true>(F, XB, XCB, F.ap->in[I_N2G] + L * DM, modl, 3, 4, Mo); } } if (L != 0) SEAM(p0 + 6); STAMP(9);
    if (IN(p0 + 7)) { PHASE_ENTER(); pg8::Gemm g{F.A, F.W1_t, Mo, DFF, DM}; pg8::StaticOrder S; S.init(Mo, DFF, F.G, F.bid); pg8::EpiBf16<2> E{F.H, DFF};
        pg8::gemm_phase<pg8::EpiBf16<2>, pg8::StaticOrder, true, true>(F.lds, g, S, E, tid); } SEAM(p0 + 7); STAMP(10);
    if (IN(p0 + 8)) { { PHASE_ENTER(); pg8::Gemm g{F.H, F.W2_t, ML, DM, DFF}; pg8::StaticOrder S; S.init(ML, DM, F.G, F.bid); pg8::EpiRes<true> E{XB, XCB, last ? F.A : XB, XCB, modl + 5 * 1024, 0};
        pg8::gemm_phase<pg8::EpiRes<true>, pg8::StaticOrder, true, true>(F.lds, g, S, E, tid); }
      if (L == 0) { xcd_barrier(bar);
        { PHASE_ENTER(); if (F.bid < 16) { pg8::Gemm g{F.H + (size_t)ML * DFF, F.W2_t, MC, DM, DFF}; pg8::StaticOrder S; S.init(MC, DM, 16, F.bid); pg8::EpiRes<true> E{XB, XCB, XB, XCB, modl + 5 * 1024, ML / 256};
              pg8::gemm_phase<pg8::EpiRes<true>, pg8::StaticOrder, true, true>(F.lds, g, S, E, tid); }
          else { const float* modn = F.mod + (size_t)(L + 1) * 5 * 6144; phase_norm<true>(F, XB, XCB, F.ap->in[I_N1G] + (L + 1) * DM, modn, 0, 1, ML, 0, 16, F.G - 16);
                 __syncthreads(); phase_wconv(F, L + 1, 1, 16, F.G - 16); } } } } SEAM(p0 + 8); STAMP(11);
}
__global__ void __launch_bounds__(NTHR, 2) mega_fwd(Args args) {
    extern __shared__ __attribute__((aligned(16))) unsigned char lds_raw[];
    LAS unsigned char* lds = (LAS unsigned char*)lds_raw;
    const int lo = args.ph_lo, hi = args.ph_hi;
    cg::grid_group grid = cg::this_grid();
    volatile LAS unsigned* misc = (volatile LAS unsigned*)(lds + LDS_BYTES - 256);
    if (threadIdx.x < 4) misc[threadIdx.x] = 0u;
    __syncthreads();
    const XcdBarrier bar = xcd_barrier_post((unsigned*)(args.ws + WS_CTL) + 1024, misc);
    if (PROBE_T && threadIdx.x == 0) { T_PREV = 0ull; T_ACC = 0ull; }
    if (PROBE_T == 1 && blockIdx.x == 0 && threadIdx.x == 0) T_PREV = __builtin_amdgcn_s_memrealtime();
    { constexpr int L = 0; if (IN(0)) { PHASE_ENTER(); phase_mod(F); } SEAM(0); }
    if (PROBE_T == 1 && blockIdx.x == 0 && threadIdx.x == 0) T_ACC = T_ACC + (__builtin_amdgcn_s_memrealtime() - T_PREV);
    run_layer<0>(lo, hi, lds, grid, bar);
    run_layer<1>(lo, hi, lds, grid, bar);
    if (PROBE_T == 12 && blockIdx.x == 0 && threadIdx.x == 0) T_PREV = __builtin_amdgcn_s_memrealtime();
    { constexpr int L = 0; if (IN(N_PHASES - 1)) { PHASE_ENTER(); phase_final(F); } }
    if (PROBE_T == 12) { xcd_barrier(bar); if (blockIdx.x == 0 && threadIdx.x == 0) T_ACC = T_ACC + (__builtin_amdgcn_s_memrealtime() - T_PREV); }
    if ((PROBE_T == 15 || PROBE_T == 16) && blockIdx.x == 0 && threadIdx.x == (PROBE_T == 15 ? 0 : 256)) { const unsigned long long t_acc = g_probe_acc; g_probe_acc = 0ull; const unsigned long long t0 = __builtin_amdgcn_s_memrealtime(); while (__builtin_amdgcn_s_memrealtime() - t0 < 16ull * t_acc) __builtin_amdgcn_s_sleep(32); }
    else if (PROBE_T && (PROBE_T < 15 || PROBE_T == 17) && blockIdx.x == PB_BLK && threadIdx.x == 0) { const unsigned long long t_acc = T_ACC; const unsigned long long t0 = __builtin_amdgcn_s_memrealtime(); while (__builtin_amdgcn_s_memrealtime() - t0 < 16ull * t_acc) __builtin_amdgcn_s_sleep(32); }
}
#undef IN
#undef SEAM
#undef STAMP

extern "C" void kernel_launch(void* const* d_in, const int* in_sizes, int n_in, void* d_out, int out_size, void* d_ws, size_t ws_size, hipStream_t stream) {
    static int grid = 0;
    if (grid == 0) {
        int dev = 0, cus = 0, per_cu = 0;
        hipGetDevice(&dev); hipDeviceGetAttribute(&cus, hipDeviceAttributeMultiprocessorCount, dev);
        hipFuncSetAttribute((const void*)mega_fwd, hipFuncAttributeMaxDynamicSharedMemorySize, LDS_BYTES);
        hipOccupancyMaxActiveBlocksPerMultiprocessor(&per_cu, (const void*)mega_fwd, NTHR, LDS_BYTES);
        if (per_cu < 1) { fprintf(stderr, "kernel_launch: occupancy query says %d blocks per CU\n", per_cu); per_cu = 1; }
        (void)hipGetLastError();
        grid = cus * per_cu;
        if (n_in != 29 || ws_size < WS_END) fprintf(stderr, "kernel_launch: unexpected n_in %d / ws_size %zu (need %zu)\n", n_in, ws_size, (size_t)WS_END);
    }
    Args a{};
    for (int i = 0; i < 29; ++i) a.in[i] = (const float*)d_in[i];
    a.out = (float*)d_out; a.ws = (unsigned char*)d_ws;
#if MK_ONE_LAUNCH
    (void)hipMemsetAsync((char*)d_ws + WS_CTL, 0, 65536, stream);
    a.ph_lo = 0; a.ph_hi = N_PHASES;
    void* kargs[] = {&a};
    hipError_t e = hipLaunchCooperativeKernel((const void*)mega_fwd, dim3(grid), dim3(NTHR), kargs, LDS_BYTES, stream);
    if (e != hipSuccess) fprintf(stderr, "cooperative launch failed: %s (grid %d)\n", hipGetErrorString(e), grid);
#else
    for (int ph = 0; ph < N_PHASES; ++ph) { a.ph_lo = ph; a.ph_hi = ph + 1;
        hipLaunchKernelGGL(mega_fwd, dim3(grid), dim3(NTHR), LDS_BYTES, stream, a); }
#endif
}
```

```cpp
#include <hip/hip_runtime.h>
#include <hip/hip_cooperative_groups.h>
#include <cstdio>
#include <cstdint>
namespace cg = cooperative_groups;

#ifndef MK_ONE_LAUNCH
#define MK_ONE_LAUNCH 1
#endif

#define LAS __attribute__((address_space(3)))
#define GAS __attribute__((address_space(1)))
typedef unsigned short bf16_t;
typedef float f32x4 __attribute__((ext_vector_type(4)));
typedef float f32x2 __attribute__((ext_vector_type(2)));
typedef unsigned u32x4 __attribute__((ext_vector_type(4)));
typedef unsigned u32x2 __attribute__((ext_vector_type(2)));

constexpr int DM = 1024, NB = 4, SEQ = 8192, CTXL = 256, DEPTH = 2, DFF = 4096;
constexpr int ML = NB * SEQ, MC = NB * CTXL, MT = ML + MC;
constexpr int INC = 3520, ZP = 3584;
constexpr int GLA_OFF = 0, RW_OFF = 1184, RET_OFF = 2496;
constexpr int YB_OFF = RW_OFF;
constexpr int SEQT = CTXL + SEQ;
constexpr int NTHR = 512, NWAVES = 8;

constexpr size_t MiB = 1u << 20;
constexpr size_t WS_CTL = 0, CTL_BYTES = 1 * MiB;
constexpr size_t WS_MOD = 1 * MiB;
constexpr size_t WS_WIN = 2 * MiB, WS_WOUT = 9 * MiB, WS_W1 = 11 * MiB, WS_W2 = 19 * MiB;
constexpr size_t WS_XC = 27 * MiB;
constexpr size_t WS_ABUF = 32 * MiB;
constexpr size_t WS_Z = 98 * MiB;
constexpr size_t WS_PREP = 329 * MiB;
constexpr size_t PREP_STRIDE = (size_t)MT * 384;
constexpr size_t WS_H = 98 * MiB;
constexpr size_t WS_W2B = 503 * MiB;
constexpr size_t WS_END = WS_W2B + 8 * MiB;
static_assert(WS_PREP + 7 * PREP_STRIDE * 2 <= WS_W2B, "ws map");
static_assert(WS_ABUF + (size_t)MT * DM * 2 <= WS_Z, "ws map");
static_assert(WS_Z + (size_t)MT * ZP * 2 <= WS_PREP, "ws map");
static_assert(WS_H + (size_t)MT * DFF * 2 <= WS_END, "ws map");
static_assert(WS_END <= 512 * MiB, "ws map");
enum { PR_R = 0, PR_WF = 1, PR_WB = 2, PR_K = 3, PR_V = 4, PR_KK = 5, PR_B = 6 };

constexpr size_t WS_XB2 = 364 * MiB;
#ifndef PROBE_T
#define PROBE_T 0
#endif
constexpr int LDS_BYTES = 147456;

__device__ __forceinline__ float bf2f(bf16_t v) { return __uint_as_float(((unsigned)v) << 16); }
__device__ __forceinline__ unsigned f2bf_u(float f) { unsigned u = __float_as_uint(f); return (u + 0x7fffu + ((u >> 16) & 1u)) >> 16; }
typedef float f32x2_cv __attribute__((ext_vector_type(2))); typedef __bf16 bf16x2_cv __attribute__((ext_vector_type(2)));
__device__ __forceinline__ unsigned pk2(float lo, float hi) { f32x2_cv v = {lo, hi}; bf16x2_cv b = __builtin_convertvector(v, bf16x2_cv); return __builtin_bit_cast(unsigned, b); }
__device__ __forceinline__ bf16_t f2bf(float f) { return (bf16_t)(pk2(f, 0.f) & 0xffffu); }
typedef _Float16 h2_cv __attribute__((ext_vector_type(2)));
__device__ __forceinline__ unsigned pkh2(float lo, float hi) { const h2_cv v = {(_Float16)lo, (_Float16)hi}; return __builtin_bit_cast(unsigned, v); }
__device__ __forceinline__ f32x2 uph2(unsigned u) { const h2_cv v = __builtin_bit_cast(h2_cv, u); return (f32x2){(float)v.x, (float)v.y}; }
__device__ __forceinline__ f32x2 bfx2(unsigned u) { f32x2 r; r.x = __uint_as_float(u << 16); r.y = __uint_as_float(u & 0xffff0000u); return r; }
__device__ __forceinline__ float sigmoidf_(float x) { return __builtin_amdgcn_rcpf(1.0f + __expf(-x)); }
__device__ __forceinline__ float siluf_(float x) { return x * __builtin_amdgcn_rcpf(1.0f + __expf(-x)); }
__device__ __forceinline__ float softplusf_(float x) { return fmaxf(x, 0.f) + log1pf(__expf(-fabsf(x))); }
__device__ __forceinline__ float wave_sum(float v) {
#pragma unroll
    for (int o = 1; o < 64; o <<= 1) v += __shfl_xor(v, o);
    return v;
}
template <int CTRL> __device__ __forceinline__ float dpp_mov(float x) { return __int_as_float(__builtin_amdgcn_update_dpp(0, __float_as_int(x), CTRL, 0xF, 0xF, true)); }
__device__ __forceinline__ float reduce16(float x) {
    x += dpp_mov<0xB1>(x);
    x += dpp_mov<0x4E>(x);
    x += dpp_mov<0x141>(x);
    x += dpp_mov<0x140>(x);
    return x;
}
#define LDS_WAIT() asm volatile("s_waitcnt lgkmcnt(0)" ::: "memory")


#define XB_TMO      128
#define XB_XCNT(j)  (256  + 64 * (j))
#define XB_XSUB(j)  (1280 + 64 * (j))
#define XB_XGEN(j)  (2304 + 64 * (j))
#define XB_TOP      3328
#define XB_TOPGEN   3392
#define XCD_BAR_WORDS 3456
#define XB_SPIN_CAP (1u << 18)

__device__ __forceinline__ unsigned xb_ld(unsigned* p)              { return __hip_atomic_load(p, __ATOMIC_RELAXED, __HIP_MEMORY_SCOPE_AGENT); }
__device__ __forceinline__ unsigned xb_add(unsigned* p, unsigned v) { return __hip_atomic_fetch_add(p, v, __ATOMIC_RELAXED, __HIP_MEMORY_SCOPE_AGENT); }
__device__ __forceinline__ unsigned xb_xcc_id() { return (unsigned)__builtin_amdgcn_s_getreg((3 << 11) | 20) & 0xFu; }
#define XB_SPIN(cond, bar) do { unsigned _sp = 0; while (cond) { __builtin_amdgcn_s_sleep(1); \
    if ((++_sp & 255u) == 0u) { if (xb_ld(&(bar)[XB_TMO])) break; if (_sp > XB_SPIN_CAP) { atomicAdd(&(bar)[XB_TMO], 1u); break; } } } } while (0)

struct XcdBarrier {
    unsigned* bar; unsigned x;
    volatile LAS unsigned* st;
};

__device__ __forceinline__ XcdBarrier xcd_barrier_post(unsigned* bar, volatile LAS unsigned* st) {
    XcdBarrier b; b.bar = bar; b.x = xb_xcc_id(); b.st = st;
    if (threadIdx.x == 0) (void)xb_add(&bar[XB_XCNT(b.x)], 1u);
    return b;
}
__device__ __forceinline__ void xcd_barrier_complete(unsigned* bar, unsigned x, unsigned& nloc, unsigned& nx) {
    const unsigned G = gridDim.x * gridDim.y * gridDim.z;
    unsigned sum, cnt, mine, sp = 0u;
    for (;;) {
        sum = 0u; cnt = 0u; mine = 0u;
#pragma unroll
        for (unsigned j = 0; j < 16; ++j) { const unsigned c = xb_ld(&bar[XB_XCNT(j)]); sum += c; cnt += (c > 0u) ? 1u : 0u; mine = (j == x) ? c : mine; }
        if (sum == G) break;
        __builtin_amdgcn_s_sleep(1);
        if ((++sp & 255u) == 0u) { if (xb_ld(&bar[XB_TMO])) break; if (sp > XB_SPIN_CAP) { atomicAdd(&bar[XB_TMO], 1u); break; } }
    }
    nloc = mine > 0u ? mine : 1u; nx = cnt > 0u ? cnt : 1u;
}

__device__ __forceinline__ void xcd_barrier(const XcdBarrier& b) {
    asm volatile("s_waitcnt vmcnt(0)" ::: "memory");
    __syncthreads();
    if (threadIdx.x == 0) {
        unsigned* bar = b.bar;
        __builtin_amdgcn_s_waitcnt(0);
        unsigned nloc = b.st[0], nx = b.st[1];
        if (nloc == 0u) { xcd_barrier_complete(bar, b.x, nloc, nx); b.st[0] = nloc; b.st[1] = nx; }
        const unsigned old = xb_add(&bar[XB_XSUB(b.x)], 1u);
        const unsigned gen = old / nloc;
        if (old + 1u == (gen + 1u) * nloc) {
            __builtin_amdgcn_fence(__ATOMIC_RELEASE, "agent");
            asm volatile("s_waitcnt vmcnt(0)" ::: "memory");
            const unsigned og = xb_add(&bar[XB_TOP], 1u);
            const unsigned tg = og / nx;
            if (og + 1u == (tg + 1u) * nx) xb_add(&bar[XB_TOPGEN], 1u);
            else XB_SPIN(xb_ld(&bar[XB_TOPGEN]) == tg, bar);
            __builtin_amdgcn_fence(__ATOMIC_ACQUIRE, "agent");
            xb_add(&bar[XB_XGEN(b.x)], 1u);
            asm volatile("s_waitcnt vmcnt(0)" ::: "memory");
        } else {
            XB_SPIN(xb_ld(&bar[XB_XGEN(b.x)]) == gen, bar);
            __builtin_amdgcn_fence(__ATOMIC_ACQUIRE, "agent");
            asm volatile("s_waitcnt vmcnt(0)" ::: "memory");
        }
    }
    __syncthreads();
}


namespace pg8 {
#define PG8_LAS __attribute__((address_space(3)))
typedef unsigned short bf16_t;
typedef short bf16x8 __attribute__((ext_vector_type(8)));
typedef float f32x4 __attribute__((ext_vector_type(4)));
typedef unsigned u32x4 __attribute__((ext_vector_type(4)));
constexpr int BM = 256, BK = 64, HALF = 128, HTB = HALF * BK * 2  , STAGE_BYTES = 8 * HTB, NXCD = 8, WGM = 8;

__host__ __device__ __forceinline__ int lds_byte(int r, int c) { const int st = (r >> 4) * 2 + (c >> 5), rr = r & 15, cc = c & 31, ob = rr * 64 + cc * 2; return st * 1024 + (ob ^ (((ob >> 9) & 1) << 5)); }
__host__ __device__ __forceinline__ void stage_rc(int b, int& R, int& C) { const int st = b / 1024, sb = b % 1024, swz = sb ^ (((sb >> 9) & 1) << 5); R = (st >> 1) * 16 + swz / 64; C = (st & 1) * 32 + (swz % 64) / 2; }
__host__ __device__ __forceinline__ int perm32(int rho) { const int n = rho >> 4, i = rho & 15; return 8 * (i >> 2) + 4 * n + (i & 3); }

struct Unit { int pm, pn; };
struct Gemm { const bf16_t* A; const bf16_t* Bt; int M, N, K; int ld = 0; };

struct StaticOrder {
    int nM, nN, nwg, G, c;
    __host__ __device__ void init(int M, int N, int G_, int c_) { nM = M / BM; nN = N / BM; nwg = nM * nN; G = G_; c = c_; }
    __host__ __device__ bool next(int i, Unit& u) const {
        const long L = (long)i * G + c; if (L >= nwg) return false;
        int wgid = (int)L; { const int q = nwg / NXCD, r = nwg % NXCD, xcd = wgid % NXCD, off = wgid / NXCD; wgid = (xcd < r ? xcd * (q + 1) : r * (q + 1) + (xcd - r) * q) + off; }
        const int nig = WGM * nN, gid = wgid / nig, fm = gid * WGM, gsz = (nM - fm) < WGM ? (nM - fm) : WGM;
        u.pm = fm + ((wgid % nig) % gsz); u.pn = (wgid % nig) / gsz; return true;
    }
    __device__ __forceinline__ void a_ready(const Unit&) const {}
    __device__ __forceinline__ void done(const Unit&) const {}
};

template <class Epi, class Sched, bool ALIGN_EPI = false, bool SP2 = false>
__device__ __forceinline__ void gemm_phase(PG8_LAS unsigned char* lds, const Gemm g, const Sched& S, const Epi& E, const int tid) {
    const int wid = __builtin_amdgcn_readfirstlane(tid >> 6), lane = tid & 63, wr = wid >> 2, wc = wid & 3, fr = lane & 15, fq = lane >> 4;
    const int K = g.K, nt = K / BK, LD = g.ld ? g.ld : g.K;
    unsigned voffA[2], voffB[2];
#pragma unroll
    for (int i = 0; i < 2; ++i) { int R, C; stage_rc(tid * 16 + i * 8192, R, C); const int Rb = Epi::PERM ? ((R & ~31) + perm32(R & 31)) : R;
        voffA[i] = (unsigned)(R * LD + C) * 2u; voffB[i] = (unsigned)(Rb * LD + C) * 2u; }
    const size_t kstep = (size_t)(BK * 2);
    const size_t hstep = (size_t)HALF * LD * 2;
    const size_t tstep = 2 * hstep;
    const unsigned ldsw = (unsigned)wid * 1024u;
    const int aoff = lds_byte(wr * 64 + fr, fq * 8), boff = lds_byte(wc * 32 + fr, fq * 8);
#define PG8_SA(b, h) (((b) * 2 + (h)) * HTB)
#define PG8_SB(b, h) ((4 + (b) * 2 + (h)) * HTB)
#define PG8_STAGE(bufoff, gbase, voff) do { _Pragma("unroll") for (int _i = 0; _i < 2; ++_i) \
        __builtin_amdgcn_global_load_lds((const unsigned*)((const char*)(gbase) + (voff)[_i]), (PG8_LAS unsigned*)(lds + (bufoff) + ldsw + _i * 8192), 16, 0, 0); } while (0)
#define PG8_LDA(dst, b, h) do { _Pragma("unroll") for (int m = 0; m < 4; ++m) _Pragma("unroll") for (int k = 0; k < 2; ++k) dst[m][k] = *(const PG8_LAS bf16x8*)(lds + PG8_SA(b, h) + aoff + m * 2048 + k * 1024); } while (0)
#define PG8_LDB(dst, b, h) do { _Pragma("unroll") for (int n = 0; n < 2; ++n) _Pragma("unroll") for (int k = 0; k < 2; ++k) dst[n][k] = *(const PG8_LAS bf16x8*)(lds + PG8_SB(b, h) + boff + n * 2048 + k * 1024); } while (0)
#define PG8_MMA(ai, bj, At, Bt) do { __builtin_amdgcn_s_setprio(1); _Pragma("unroll") for (int m = 0; m < 4; ++m) _Pragma("unroll") for (int n = 0; n < 2; ++n) _Pragma("unroll") for (int k = 0; k < 2; ++k) \
        acc[ai][bj][m][n] = __builtin_amdgcn_mfma_f32_16x16x32_bf16(Bt[n][k], At[m][k], acc[ai][bj][m][n], 0, 0, 0); __builtin_amdgcn_s_setprio(0); } while (0)
#define PG8_WAIT_V(n) asm volatile("s_waitcnt vmcnt(" #n ")" ::: "memory")
#define PG8_WAIT_L(n) asm volatile("s_waitcnt lgkmcnt(" #n ")" ::: "memory")
#define PG8_BAR __builtin_amdgcn_s_barrier()
#define PG8_SCHED __builtin_amdgcn_sched_barrier(0)
    Unit cur, nxt; int ui = 0;
    if (!S.next(0, cur)) return;
    f32x4 acc[2][2][4][2];
#pragma unroll
    for (int a = 0; a < 2; ++a)
#pragma unroll
        for (int b = 0; b < 2; ++b)
#pragma unroll
            for (int m = 0; m < 4; ++m)
#pragma unroll
                for (int n = 0; n < 2; ++n) acc[a][b][m][n] = (f32x4){0.f, 0.f, 0.f, 0.f};
    bf16x8 At[4][2], B0[2][2], B1[2][2];
    const char* cA = (const char*)g.A + (size_t)cur.pm * tstep; const char* cB = (const char*)g.Bt + (size_t)cur.pn * tstep;
    S.a_ready(cur);
    if constexpr (SP2) {
        PG8_STAGE(PG8_SB(0, 0), cB, voffB); PG8_STAGE(PG8_SB(0, 1), cB + hstep, voffB); PG8_STAGE(PG8_SA(0, 0), cA, voffA); PG8_STAGE(PG8_SA(0, 1), cA + hstep, voffA);
        if (wr == 1) PG8_BAR;
        PG8_WAIT_V(2); PG8_BAR;
        PG8_STAGE(PG8_SB(1, 0), cB + kstep, voffB); PG8_STAGE(PG8_SA(1, 0), cA + kstep, voffA); PG8_STAGE(PG8_SB(1, 1), cB + hstep + kstep, voffB);
        PG8_WAIT_V(6); PG8_BAR;
    } else {
        PG8_STAGE(PG8_SB(0, 0), cB, voffB); PG8_STAGE(PG8_SA(0, 0), cA, voffA); PG8_STAGE(PG8_SB(0, 1), cB + hstep, voffB); PG8_STAGE(PG8_SA(0, 1), cA + hstep, voffA);
        if (wr == 1) PG8_BAR;
        PG8_WAIT_V(4); PG8_BAR;
        PG8_STAGE(PG8_SB(1, 0), cB + kstep, voffB); PG8_STAGE(PG8_SA(1, 0), cA + kstep, voffA); PG8_STAGE(PG8_SB(1, 1), cB + hstep + kstep, voffB);
        PG8_WAIT_V(6); PG8_BAR;
    }
    for (;;) {
        const bool has_next = S.next(ui + 1, nxt);
        const char* nA = has_next ? (const char*)g.A + (size_t)nxt.pm * tstep : cA; const char* nB = has_next ? (const char*)g.Bt + (size_t)nxt.pn * tstep : cB;
        for (int t = 0; t < nt; t += 2) {
            const bool last = (t == nt - 2);
            const char* a1 = cA + (size_t)(t + 1) * kstep;
            const char* a2 = last ? nA : cA + (size_t)(t + 2) * kstep; const char* b2 = last ? nB : cB + (size_t)(t + 2) * kstep;
            const char* a3 = a2 + kstep; const char* b3 = b2 + kstep;
            if (last && has_next) S.a_ready(nxt);
            if constexpr (SP2) {
            PG8_LDB(B0, 0, 0); PG8_LDB(B1, 0, 1); PG8_SCHED; PG8_LDA(At, 0, 0); PG8_STAGE(PG8_SA(1, 1), a1 + hstep, voffA);
            PG8_WAIT_V(8); PG8_WAIT_L(0); PG8_BAR; PG8_MMA(0, 0, At, B0); PG8_MMA(0, 1, At, B1); PG8_BAR; PG8_SCHED;
            PG8_LDA(At, 0, 1); PG8_STAGE(PG8_SB(0, 0), b2, voffB); PG8_STAGE(PG8_SB(0, 1), b2 + hstep, voffB); PG8_STAGE(PG8_SA(0, 0), a2, voffA);
            PG8_WAIT_V(8); PG8_WAIT_L(0); PG8_BAR; PG8_MMA(1, 0, At, B0); PG8_MMA(1, 1, At, B1); PG8_BAR; PG8_SCHED;
            PG8_LDB(B0, 1, 0); PG8_LDB(B1, 1, 1); PG8_SCHED; PG8_LDA(At, 1, 0); PG8_STAGE(PG8_SA(0, 1), a2 + hstep, voffA);
            PG8_WAIT_V(8); PG8_WAIT_L(0); PG8_BAR; PG8_MMA(0, 0, At, B0); PG8_MMA(0, 1, At, B1); PG8_BAR; PG8_SCHED;
            PG8_LDA(At, 1, 1); PG8_STAGE(PG8_SB(1, 0), b3, voffB); PG8_STAGE(PG8_SB(1, 1), b3 + hstep, voffB); PG8_STAGE(PG8_SA(1, 0), a3, voffA);
            PG8_WAIT_V(8); PG8_WAIT_L(0); PG8_BAR; PG8_MMA(1, 0, At, B0); PG8_MMA(1, 1, At, B1); PG8_BAR; PG8_SCHED;
            } else {
            PG8_LDB(B0, 0, 0); PG8_SCHED; PG8_LDA(At, 0, 0); PG8_STAGE(PG8_SA(1, 1), a1 + hstep, voffA);
            PG8_WAIT_L(8); PG8_BAR; PG8_WAIT_L(0); PG8_MMA(0, 0, At, B0); PG8_BAR; PG8_SCHED;
            PG8_LDB(B1, 0, 1); PG8_STAGE(PG8_SB(0, 0), b2, voffB);
            PG8_BAR; PG8_WAIT_L(0); PG8_MMA(0, 1, At, B1); PG8_BAR;
            PG8_LDA(At, 0, 1); PG8_STAGE(PG8_SA(0, 0), a2, voffA);
            PG8_BAR; PG8_WAIT_L(0); PG8_MMA(1, 0, At, B0); PG8_BAR; PG8_SCHED;
            PG8_STAGE(PG8_SB(0, 1), b2 + hstep, voffB);
            PG8_WAIT_V(6); PG8_BAR; PG8_MMA(1, 1, At, B1); PG8_BAR;
            PG8_LDB(B0, 1, 0); PG8_SCHED; PG8_LDA(At, 1, 0); PG8_STAGE(PG8_SA(0, 1), a2 + hstep, voffA);
            PG8_WAIT_L(8); PG8_BAR; PG8_WAIT_L(0); PG8_MMA(0, 0, At, B0); PG8_BAR; PG8_SCHED;
            PG8_LDB(B1, 1, 1); PG8_STAGE(PG8_SB(1, 0), b3, voffB);
            PG8_BAR; PG8_WAIT_L(0); PG8_MMA(0, 1, At, B1); PG8_BAR;
            PG8_LDA(At, 1, 1); PG8_STAGE(PG8_SA(1, 0), a3, voffA);
            PG8_BAR; PG8_WAIT_L(0); PG8_MMA(1, 0, At, B0); PG8_BAR; PG8_SCHED;
            PG8_STAGE(PG8_SB(1, 1), b3 + hstep, voffB);
            PG8_WAIT_V(6); PG8_BAR; PG8_MMA(1, 1, At, B1); PG8_BAR;
            }
        }
        if constexpr (ALIGN_EPI) { if (wr == 0) PG8_BAR; }
        if constexpr (!Epi::AFTER_DRAIN) { E(acc, cur, wr, wc, fr, fq); S.done(cur); }
        if (!has_next) break;
#pragma unroll
        for (int a = 0; a < 2; ++a)
#pragma unroll
            for (int b = 0; b < 2; ++b)
#pragma unroll
                for (int m = 0; m < 4; ++m)
#pragma unroll
                    for (int n = 0; n < 2; ++n) acc[a][b][m][n] = (f32x4){0.f, 0.f, 0.f, 0.f};
        cur = nxt; cA = nA; cB = nB; ++ui;
        if constexpr (ALIGN_EPI) { if (wr == 1) PG8_BAR; }
    }
    PG8_WAIT_V(0);
    if constexpr (!ALIGN_EPI) { if (wr == 0) PG8_BAR; }
    PG8_BAR;
    if constexpr (Epi::AFTER_DRAIN) { E.fused(acc, cur, wr, wc, fr, fq, lds, wid, lane); S.done(cur); }
#undef PG8_SA
#undef PG8_SB
#undef PG8_STAGE
#undef PG8_LDA
#undef PG8_LDB
#undef PG8_MMA
#undef PG8_WAIT_V
#undef PG8_WAIT_L
#undef PG8_BAR
#undef PG8_SCHED
}
}

namespace pg8 {
template <int ACT> struct EpiBf16 {
    static constexpr bool PERM = true, AFTER_DRAIN = false;
    bf16_t* O; int ldc;
    __device__ __forceinline__ void operator()(const f32x4 (&acc)[2][2][4][2], const Unit& u, int wr, int wc, int fr, int fq) const {
        const int row0 = u.pm * BM + wr * 64 + fr; const int col0 = u.pn * BM + wc * 32 + 8 * fq;
#pragma unroll
        for (int ai = 0; ai < 2; ++ai)
#pragma unroll
            for (int m = 0; m < 4; ++m) { bf16_t* rowp = O + (size_t)(row0 + ai * HALF + m * 16) * ldc + col0;
#pragma unroll
                for (int bj = 0; bj < 2; ++bj) { f32x4 v0 = acc[ai][bj][m][0], v1 = acc[ai][bj][m][1];
                    if (ACT == 2) {
#pragma unroll
                        for (int e = 0; e < 4; ++e) { float a = fmaxf(v0[e], 0.f), b = fmaxf(v1[e], 0.f); v0[e] = a * a; v1[e] = b * b; } }
                    u32x4 w; w.x = ::pk2(v0[0], v0[1]); w.y = ::pk2(v0[2], v0[3]); w.z = ::pk2(v1[0], v1[1]); w.w = ::pk2(v1[2], v1[3]);
                    *(u32x4*)(rowp + bj * HALF) = w; } }
    }
};
template <bool BASE_BF> struct EpiRes {
    static constexpr bool PERM = false, AFTER_DRAIN = false;
    const void* base_lat; const void* base_ctx; bf16_t* out_lat; bf16_t* out_ctx; const float* gate  ; int pm_off  ;
    __device__ __forceinline__ void operator()(const f32x4 (&acc)[2][2][4][2], const Unit& u0, int wr, int wc, int fr, int fq) const {
        Unit u = u0; u.pm += pm_off;
        const bool lat = u.pm < (ML / BM); const int mi = lat ? (u.pm >> 5) : 4;
        const float* gv = gate + (size_t)mi * 6144;
        const size_t tile_off = lat ? (size_t)u.pm * BM * DM : (size_t)(u.pm - ML / BM) * BM * DM;
        const void* bpv = lat ? base_lat : base_ctx; bf16_t* op = (lat ? out_lat : out_ctx) + tile_off;
        const int col0 = u.pn * BM + wc * 32 + 4 * fq;
        f32x4 g4[2][2];
#pragma unroll
        for (int bj = 0; bj < 2; ++bj)
#pragma unroll
            for (int n = 0; n < 2; ++n) g4[bj][n] = *(const f32x4*)(gv + col0 + bj * HALF + n * 16);
#pragma unroll
        for (int ai = 0; ai < 2; ++ai)
#pragma unroll
            for (int m = 0; m < 4; ++m) { const size_t off = tile_off + (size_t)(ai * HALF + wr * 64 + m * 16 + fr) * DM + col0;
#pragma unroll
                for (int bj = 0; bj < 2; ++bj)
#pragma unroll
                    for (int n = 0; n < 2; ++n) { f32x4 bs;
                        if (BASE_BF) { const u32x2 b2 = *(const u32x2*)((const bf16_t*)bpv + off + bj * HALF + n * 16); const f32x2 lo = bfx2(b2.x), hi = bfx2(b2.y); bs = (f32x4){lo.x, lo.y, hi.x, hi.y}; }
                        else bs = *(const f32x4*)((const float*)bpv + off + bj * HALF + n * 16);
                        const f32x4 o = bs + g4[bj][n] * acc[ai][bj][m][n];
                        *(u32x2*)(op + (off - tile_off) + bj * HALF + n * 16) = (u32x2){pk2(o.x, o.y), pk2(o.z, o.w)}; } }
    }
};
struct EpiPart {
    static constexpr bool PERM = false, AFTER_DRAIN = false;
    float* out;
    __device__ __forceinline__ void operator()(const f32x4 (&acc)[2][2][4][2], const Unit& u, int wr, int wc, int fr, int fq) const {
        asm volatile("" : "+v"(fr), "+v"(fq), "+s"(wr), "+s"(wc));
        const int col0 = u.pn * BM + wc * 32 + 4 * fq;
#pragma unroll
        for (int ai = 0; ai < 2; ++ai)
#pragma unroll
            for (int m = 0; m < 4; ++m) { float* orow = out + ((size_t)u.pm * BM + ai * HALF + wr * 64 + m * 16 + fr) * DM + col0;
#pragma unroll
                for (int bj = 0; bj < 2; ++bj)
#pragma unroll
                    for (int n = 0; n < 2; ++n) *(f32x4*)(orow + bj * HALF + n * 16) = acc[ai][bj][m][n]; }
    }
};
template <bool BASE_BF, int MODE> struct EpiResNorm {
    static constexpr bool PERM = true, AFTER_DRAIN = false;
    const void* base_lat; const void* base_ctx; bf16_t* out_lat; bf16_t* out_ctx; const float* gate; int pm_off;
    const float* g; const float* modl; int shift_idx, scale_idx; bf16_t* An; float* outf;
    unsigned* xbuf; unsigned* cnt; PG8_LAS unsigned char* sp;
    __device__ __forceinline__ void operator()(const f32x4 (&acc)[2][2][4][2], const Unit& u0, int wr, int wc, int fr, int fq) const {
        asm volatile("" : "+v"(fr), "+v"(fq), "+s"(wr), "+s"(wc));
        Unit u = u0; u.pm += pm_off;
        const bool lat = u.pm < (ML / BM); const int mi = lat ? (u.pm >> 5) : 4;
        const float* gv = gate + (size_t)mi * 6144;
        const size_t tile_off = lat ? (size_t)u.pm * BM * DM : (size_t)(u.pm - ML / BM) * BM * DM;
        const void* bpv = lat ? base_lat : base_ctx; bf16_t* op = lat ? out_lat : out_ctx;
        const int col0 = u.pn * BM + wc * 32 + 8 * fq;
        const int wid = wr * 4 + wc, lane = fq * 16 + fr, tid = wid * 64 + lane;
        PG8_LAS float* P = (PG8_LAS float*)sp; PG8_LAS float* Sr = P + 1024;
        u32x4 xp[2][2][4];
        { f32x4 g8[2][2];
#pragma unroll
          for (int bj = 0; bj < 2; ++bj)
#pragma unroll
            for (int n = 0; n < 2; ++n) g8[bj][n] = *(const f32x4*)(gv + col0 + bj * HALF + n * 4);
          f32x4 bq[2][2][2];
          auto ldslot = [&](int s, f32x4 (&d)[2][2]) { const size_t off = tile_off + (size_t)((s >> 2) * HALF + wr * 64 + (s & 3) * 16 + fr) * DM + col0;
#pragma unroll
              for (int bj = 0; bj < 2; ++bj) {
                  if (BASE_BF) d[bj][0] = __builtin_bit_cast(f32x4, *(const u32x4*)((const bf16_t*)bpv + off + bj * HALF));
                  else { d[bj][0] = *(const f32x4*)((const float*)bpv + off + bj * HALF); d[bj][1] = *(const f32x4*)((const float*)bpv + off + bj * HALF + 4); } } };
          ldslot(0, bq[0]);
#pragma unroll
          for (int s8 = 0; s8 < 8; ++s8) { const int ai = s8 >> 2, m = s8 & 3; const size_t off = tile_off + (size_t)(ai * HALF + wr * 64 + m * 16 + fr) * DM + col0; float s = 0.f;
              if (s8 + 1 < 8) ldslot(s8 + 1, bq[(s8 + 1) & 1]);
#pragma unroll
              for (int bj = 0; bj < 2; ++bj) { f32x4 b0, b1;
                  if (BASE_BF) { const u32x4 r = __builtin_bit_cast(u32x4, bq[s8 & 1][bj][0]); const f32x2 a0 = bfx2(r.x), a1 = bfx2(r.y), a2 = bfx2(r.z), a3 = bfx2(r.w); b0 = (f32x4){a0.x, a0.y, a1.x, a1.y}; b1 = (f32x4){a2.x, a2.y, a3.x, a3.y}; }
                  else { b0 = bq[s8 & 1][bj][0]; b1 = bq[s8 & 1][bj][1]; }
                  const f32x4 o0 = b0 + g8[bj][0] * acc[ai][bj][m][0], o1 = b1 + g8[bj][1] * acc[ai][bj][m][1];
                  const u32x4 pk = {pk2(o0.x, o0.y), pk2(o0.z, o0.w), pk2(o1.x, o1.y), pk2(o1.z, o1.w)}; xp[ai][bj][m] = pk;
                  s += ((o0.x * o0.x + o0.y * o0.y) + (o0.z * o0.z + o0.w * o0.w)) + ((o1.x * o1.x + o1.y * o1.y) + (o1.z * o1.z + o1.w * o1.w));
                  if (op) *(u32x4*)(op + off + bj * HALF) = pk; }
              s += __shfl_xor(s, 16); s += __shfl_xor(s, 32);
              if (fq == 0) P[(ai * HALF + wr * 64 + m * 16 + fr) * 4 + wc] = s; } }
        asm volatile("s_waitcnt lgkmcnt(0)" ::: "memory"); __builtin_amdgcn_s_barrier(); asm volatile("" ::: "memory");
        if (tid < 256) { const f32x4 p4 = *(const PG8_LAS f32x4*)(P + tid * 4);
            __hip_atomic_store(xbuf + ((size_t)u.pm * BM + tid) * 4 + u.pn, __float_as_uint((p4.x + p4.y) + (p4.z + p4.w)), __ATOMIC_RELAXED, __HIP_MEMORY_SCOPE_AGENT); }
        asm volatile("s_waitcnt vmcnt(0)" ::: "memory");
        if (tid < 256 && lane == 0) __hip_atomic_fetch_add(cnt + 16 * u.pm, 1u, __ATOMIC_RELAXED, __HIP_MEMORY_SCOPE_AGENT);
        if (wid == 0) {
            unsigned spn = 0;
            while ((unsigned)__builtin_amdgcn_readfirstlane(__hip_atomic_load(cnt + 16 * u.pm, __ATOMIC_RELAXED, __HIP_MEMORY_SCOPE_AGENT)) < 16u) { __builtin_amdgcn_s_sleep(2); if (++spn > (1u << 22)) break; }
            __builtin_amdgcn_fence(__ATOMIC_ACQUIRE, "agent");
        }
        asm volatile("s_waitcnt vmcnt(0) lgkmcnt(0)" ::: "memory"); __builtin_amdgcn_s_barrier(); asm volatile("" ::: "memory");
        if (tid < 256) { const unsigned* sl = xbuf + ((size_t)u.pm * BM + tid) * 4; float q = 0.f;
#pragma unroll
            for (int t = 0; t < 4; ++t) q += __uint_as_float(__hip_atomic_load(sl + t, __ATOMIC_RELAXED, __HIP_MEMORY_SCOPE_AGENT));
            Sr[tid] = rsqrtf(q * (1.f / DM) + 1e-6f); }
        asm volatile("s_waitcnt lgkmcnt(0)" ::: "memory"); __builtin_amdgcn_s_barrier(); asm volatile("" ::: "memory");
        f32x4 gs[2][2], sh[2][2];
        { const float* mv = modl + (size_t)mi * 6144;
#pragma unroll
          for (int bj = 0; bj < 2; ++bj)
#pragma unroll
            for (int n = 0; n < 2; ++n) { const int col = col0 + bj * HALF + n * 4; gs[bj][n] = *(const f32x4*)(g + col);
                if (MODE == 0) { gs[bj][n] = gs[bj][n] * (*(const f32x4*)(mv + scale_idx * 1024 + col) + 1.0f); sh[bj][n] = *(const f32x4*)(mv + shift_idx * 1024 + col); } } }
#pragma unroll
        for (int ai = 0; ai < 2; ++ai)
#pragma unroll
            for (int m = 0; m < 4; ++m) { const int r = ai * HALF + wr * 64 + m * 16 + fr; const float rr = Sr[r]; const size_t off = ((size_t)u.pm * BM + r) * DM + col0;
#pragma unroll
                for (int bj = 0; bj < 2; ++bj) { const u32x4 pk = xp[ai][bj][m]; const f32x2 a0 = bfx2(pk.x), a1 = bfx2(pk.y), a2 = bfx2(pk.z), a3 = bfx2(pk.w);
                    const f32x4 x0 = {a0.x, a0.y, a1.x, a1.y}, x1 = {a2.x, a2.y, a3.x, a3.y};
                    if (MODE == 0) { const f32x4 y0 = x0 * rr * gs[bj][0] + sh[bj][0], y1 = x1 * rr * gs[bj][1] + sh[bj][1];
                        *(u32x4*)(An + off + bj * HALF) = (u32x4){pk2(y0.x, y0.y), pk2(y0.z, y0.w), pk2(y1.x, y1.y), pk2(y1.z, y1.w)}; }
                    else { *(f32x4*)(outf + off + bj * HALF) = x0 * rr * gs[bj][0]; *(f32x4*)(outf + off + bj * HALF + 4) = x1 * rr * gs[bj][1]; } } }
    }
};
}

struct Args { const float* in[29]; float* out; unsigned char* ws; int ph_lo, ph_hi; };
enum { I_X = 0, I_C, I_CTX, I_CCTX, I_FNG, I_MODW, I_MODB, I_N1G, I_N2G, I_WIN, I_WOUT, I_W1, I_W2, I_GGW2, I_GGB, I_GNG, I_RMU, I_RW0, I_RW2, I_RA0, I_RA2, I_RG2,
       I_RKK, I_RKA, I_RRK, I_RLNG, I_RLNB, I_RETLR, I_RETNG };

typedef const __attribute__((address_space(4))) Args* CArgs;
struct Frame {
    LAS unsigned char* lds;
    int tid, lane, wave, bid, G;
    CArgs ap; float* out; unsigned char* ws;
    float* mod; bf16_t *Win_t, *Wout_t, *W1_t, *W2_t; float* xc; bf16_t *A, *Z, *PREP, *H;
};

__device__ __forceinline__ int mod_index(int m) { return m < ML ? (m >> 13) : 4; }
__device__ __forceinline__ int seq_row(int b, int dir, int s) {
    if (s < CTXL) { const int tc = dir ? (CTXL - 1 - s) : s; return ML + b * CTXL + tc; }
    const int tl = s - CTXL; const int t = dir ? (SEQ - 1 - tl) : tl; return b * SEQ + t;
}
__device__ __forceinline__ float zshift(const bf16_t* Z, int m, int col, float mu) {
    const bf16_t* p = Z + (size_t)m * ZP + col;
    const float z0 = bf2f(*p); float nb;
    if (m < ML) { const int t = m & (SEQ - 1), gr = t >> 6, gc = t & 63; float s = 0.f;
        if (gr > 0) s += bf2f(*(p - (ptrdiff_t)64 * ZP)); if (gr < 127) s += bf2f(*(p + (ptrdiff_t)64 * ZP));
        if (gc > 0) s += bf2f(*(p - (ptrdiff_t)ZP)); if (gc < 63) s += bf2f(*(p + (ptrdiff_t)ZP));
        nb = 0.25f * s;
    } else { const int t = (m - ML) & (CTXL - 1); float s = 0.f;
        if (t > 0) s += bf2f(*(p - (ptrdiff_t)ZP)); if (t < CTXL - 1) s += bf2f(*(p + (ptrdiff_t)ZP));
        nb = 0.5f * s; }
    return z0 + mu * (nb - z0);
}


struct ZNb { ptrdiff_t o[4]; float w[4]; };
__device__ __forceinline__ ZNb znb(int m) { ZNb n;
    if (m < ML) { const int t = m & (SEQ - 1), gr = t >> 6, gc = t & 63;
        n.o[0] = gr > 0 ? -(ptrdiff_t)64 * ZP : 0; n.o[1] = gr < 127 ? (ptrdiff_t)64 * ZP : 0; n.o[2] = gc > 0 ? -(ptrdiff_t)ZP : 0; n.o[3] = gc < 63 ? (ptrdiff_t)ZP : 0;
        n.w[0] = gr > 0 ? 0.25f : 0.f; n.w[1] = gr < 127 ? 0.25f : 0.f; n.w[2] = gc > 0 ? 0.25f : 0.f; n.w[3] = gc < 63 ? 0.25f : 0.f;
    } else { const int t = (m - ML) & (CTXL - 1);
        n.o[0] = 0; n.o[1] = 0; n.o[2] = t > 0 ? -(ptrdiff_t)ZP : 0; n.o[3] = t < CTXL - 1 ? (ptrdiff_t)ZP : 0;
        n.w[0] = 0.f; n.w[1] = 0.f; n.w[2] = t > 0 ? 0.5f : 0.f; n.w[3] = t < CTXL - 1 ? 0.5f : 0.f; }
    return n; }
struct ZRaw { bf16_t c, n0, n1, n2, n3; };
__device__ __forceinline__ ZRaw zload(const bf16_t* p, const ZNb& n) { ZRaw r; r.c = *p; r.n0 = *(p + n.o[0]); r.n1 = *(p + n.o[1]); r.n2 = *(p + n.o[2]); r.n3 = *(p + n.o[3]); return r; }
__device__ __forceinline__ float zmix(const ZRaw& r, const ZNb& n, float mu) { const float z0 = bf2f(r.c);
    const float nb = (bf2f(r.n0) * n.w[0] + bf2f(r.n1) * n.w[1]) + (bf2f(r.n2) * n.w[2] + bf2f(r.n3) * n.w[3]); return z0 + mu * (nb - z0); }
__device__ __forceinline__ float fast_tanh(float x) { const float e = __expf(2.0f * x); return 1.0f - 2.0f * __builtin_amdgcn_rcpf(e + 1.0f); }

__device__ __forceinline__ void phase_mod(Frame& F) {
    LAS float* sc = (LAS float*)F.lds;
    LAS float* red = sc + 5 * 1024;
    for (int i = F.tid; i < 5 * 1024; i += NTHR) { const int j = i >> 10, k = i & 1023; const float v = j < 4 ? F.ap->in[I_C][j * 1024 + k] : F.ap->in[I_CCTX][k]; sc[i] = siluf_(v); }
    __syncthreads();
    const int kg = F.tid >> 5, c = F.tid & 31;
    for (int it = F.bid; it < DEPTH * 96; it += F.G) {
        const int l = it / 96, cgp = it % 96, col = cgp * 64 + 2 * c;
        const float* W = F.ap->in[I_MODW] + (size_t)l * DM * 6144 + col;
        f32x2 a0 = {0.f, 0.f}, a1 = a0, a2 = a0, a3 = a0, a4 = a0;
#pragma unroll 1
        for (int k0 = kg * 64; k0 < kg * 64 + 64; k0 += 32) { f32x2 w[32];
#pragma unroll
            for (int u = 0; u < 32; ++u) w[u] = *(const f32x2*)(W + (size_t)(k0 + u) * 6144);
#pragma unroll
            for (int u = 0; u < 32; ++u) { const int k = k0 + u; a0 += w[u] * sc[k]; a1 += w[u] * sc[1024 + k]; a2 += w[u] * sc[2048 + k]; a3 += w[u] * sc[3072 + k]; a4 += w[u] * sc[4096 + k]; } }
        LAS f32x2* red2 = (LAS f32x2*)red;
        red2[(kg * 5 + 0) * 32 + c] = a0; red2[(kg * 5 + 1) * 32 + c] = a1; red2[(kg * 5 + 2) * 32 + c] = a2; red2[(kg * 5 + 3) * 32 + c] = a3; red2[(kg * 5 + 4) * 32 + c] = a4;
        __syncthreads();
        if (F.tid < 160) { const int j = F.tid >> 5; f32x2 s = {0.f, 0.f};
#pragma unroll
            for (int g = 0; g < 16; ++g) s += red2[(g * 5 + j) * 32 + c];
            *(f32x2*)(F.mod + ((size_t)l * 5 + j) * 6144 + col) = s + *(const f32x2*)(F.ap->in[I_MODB] + l * 6144 + col); }
        __syncthreads();
    }
}

__device__ __forceinline__ void transpose_item(const float* W, int K, int N, bf16_t* WT, LAS float* scr, int item, int lane) {
    const int nblk = N / 32, kb = item / nblk, nb = item % nblk, k0 = 64 * kb, n0 = 32 * nb;
#pragma unroll 8
    for (int i = 0; i < 32; ++i) { const int kk = 2 * i + (lane >> 5); scr[kk * 33 + (lane & 31)] = W[(size_t)(k0 + kk) * N + n0 + (lane & 31)]; }
    LDS_WAIT(); asm volatile("" ::: "memory");
    const int c = lane & 7;
#pragma unroll
    for (int j = 0; j < 4; ++j) { const int n = (lane >> 3) + 8 * j; const LAS float* s = scr + (8 * c) * 33 + n;
        u32x4 o; o.x = pk2(s[0 * 33], s[1 * 33]); o.y = pk2(s[2 * 33], s[3 * 33]); o.z = pk2(s[4 * 33], s[5 * 33]); o.w = pk2(s[6 * 33], s[7 * 33]);
        *(u32x4*)(WT + (size_t)(n0 + n) * K + k0 + 8 * c) = o; }
    LDS_WAIT(); asm volatile("" ::: "memory");
}
__device__ __forceinline__ void phase_wconv(Frame& F, int l, int which = 3, int blk_lo = 0, int nblk = 0) {
    if (nblk == 0) nblk = F.G;
    if (F.bid < blk_lo) return;
    LAS float* scr = (LAS float*)(F.lds + F.wave * 16384);
    const int gw = (F.bid - blk_lo) * NWAVES + F.wave, NGW = nblk * NWAVES;
    constexpr int I_IN = (DM / 64) * (INC / 32), I_O = (DM / 64) * (DM / 32), I_1 = (DM / 64) * (DFF / 32), I_2 = (DFF / 64) * (DM / 32);
    const float* Win = F.ap->in[I_WIN] + (size_t)l * DM * INC; const float* Wout = F.ap->in[I_WOUT] + (size_t)l * DM * DM;
    const float* W1 = F.ap->in[I_W1] + (size_t)l * DM * DFF; const float* W2 = F.ap->in[I_W2] + (size_t)l * DFF * DM;
    const int it_lo = (which & 1) ? 0 : I_IN + I_O + I_1, it_hi = (which & 2) ? I_IN + I_O + I_1 + I_2 : I_IN + I_O + I_1;
    for (int it = it_lo + gw; it < it_hi; it += NGW) {
        int r = it;
        if (r < I_IN) { transpose_item(Win, DM, INC, F.Win_t, scr, r, F.lane); continue; } r -= I_IN;
        if (r < I_O) { transpose_item(Wout, DM, DM, F.Wout_t, scr, r, F.lane); continue; } r -= I_O;
        if (r < I_1) { transpose_item(W1, DM, DFF, F.W1_t, scr, r, F.lane); continue; } r -= I_1;
        transpose_item(W2, DFF, DM, (bf16_t*)(F.ws + ((l & 1) ? WS_W2B : WS_W2)), scr, r, F.lane);
    }
    if (which & 1) { u32x4* zp = (u32x4*)(F.Win_t + (size_t)INC * DM); const int n16 = (ZP - INC) * DM * 2 / 16;
      for (int i = (F.bid - blk_lo) * NTHR + F.tid; i < n16; i += nblk * NTHR) zp[i] = (u32x4){0u, 0u, 0u, 0u}; }
}

template <bool SRC_BF> __device__ __forceinline__ void phase_norm(Frame& F, const void* src_lat, const void* src_ctx, const float* g, const float* modl, int shift_idx, int scale_idx, int Mrows, int row_lo = 0, int blk_lo = 0, int nblk = 0) {
    if (nblk == 0) nblk = F.G;
    if (F.bid < blk_lo) return;
    const int gw = (F.bid - blk_lo) * NWAVES + F.wave, NGW = nblk * NWAVES;
    for (int m = row_lo + gw; m < Mrows; m += NGW) {
        const size_t roff = m < ML ? (size_t)m * DM : (size_t)(m - ML) * DM; const void* xbase = m < ML ? src_lat : src_ctx;
        const float* mv = modl + (size_t)mod_index(m) * 6144;
        f32x4 v[4]; float ss = 0.f;
        if (SRC_BF) { const u32x2* xr = (const u32x2*)((const bf16_t*)xbase + roff) + F.lane; u32x2 q[4];
#pragma unroll
            for (int j = 0; j < 4; ++j) q[j] = xr[64 * j];
#pragma unroll
            for (int j = 0; j < 4; ++j) { const f32x2 lo = bfx2(q[j].x), hi = bfx2(q[j].y); v[j] = (f32x4){lo.x, lo.y, hi.x, hi.y}; }
        } else { const f32x4* xr = (const f32x4*)((const float*)xbase + roff) + F.lane;
#pragma unroll
            for (int j = 0; j < 4; ++j) v[j] = xr[64 * j]; }
#pragma unroll
        for (int j = 0; j < 4; ++j) ss += (v[j].x * v[j].x + v[j].y * v[j].y) + (v[j].z * v[j].z + v[j].w * v[j].w);
        const float r = rsqrtf(wave_sum(ss) * (1.f / DM) + 1e-6f);
        u32x2* o8 = (u32x2*)(F.A + (size_t)m * DM) + F.lane;
#pragma unroll
        for (int j = 0; j < 4; ++j) { const int col = 4 * F.lane + 256 * j;
            const f32x4 gg = *(const f32x4*)(g + col), sh = *(const f32x4*)(mv + shift_idx * 1024 + col), sc = *(const f32x4*)(mv + scale_idx * 1024 + col);
            const f32x4 y = v[j] * r * gg * (sc + 1.0f) + sh;
            u32x2 w; w.x = pk2(y.x, y.y); w.y = pk2(y.z, y.w); o8[64 * j] = w; }
    }
}
__device__ __forceinline__ void phase_norm_ctxsum(Frame& F, bf16_t* xc, const float* P, const float* gate, const float* g, const float* modl, int shift_idx, int scale_idx, int nblk) {
    const int gw = F.bid * NWAVES + F.wave, NGW = nblk * NWAVES;
    for (int rr = gw; rr < MC; rr += NGW) {
        const float* mv = modl + (size_t)4 * 6144;
        u32x2* xr = (u32x2*)(xc + (size_t)rr * DM) + F.lane;
        f32x4 v[4]; float ss = 0.f;
#pragma unroll
        for (int j = 0; j < 4; ++j) { const int col = 4 * F.lane + 256 * j; const u32x2 q = xr[64 * j]; const f32x2 lo = bfx2(q.x), hi = bfx2(q.y);
            const float* pp = P + (size_t)rr * DM + col; const f32x4 s4 = (*(const f32x4*)pp + *(const f32x4*)(pp + (size_t)MC * DM)) + (*(const f32x4*)(pp + (size_t)2 * MC * DM) + *(const f32x4*)(pp + (size_t)3 * MC * DM));
            f32x4 x = (f32x4){lo.x, lo.y, hi.x, hi.y} + *(const f32x4*)(gate + col) * s4;
            const u32x2 pk = {pk2(x.x, x.y), pk2(x.z, x.w)}; xr[64 * j] = pk;
            { const f32x2 l2 = bfx2(pk.x), h2 = bfx2(pk.y); x = (f32x4){l2.x, l2.y, h2.x, h2.y}; }
            v[j] = x; ss += (x.x * x.x + x.y * x.y) + (x.z * x.z + x.w * x.w); }
        const float r = rsqrtf(wave_sum(ss) * (1.f / DM) + 1e-6f);
        u32x2* o8 = (u32x2*)(F.A + (size_t)(ML + rr) * DM) + F.lane;
#pragma unroll
        for (int j = 0; j < 4; ++j) { const int col = 4 * F.lane + 256 * j;
            const f32x4 gg = *(const f32x4*)(g + col), sh = *(const f32x4*)(mv + shift_idx * 1024 + col), sc = *(const f32x4*)(mv + scale_idx * 1024 + col);
            const f32x4 y = v[j] * r * gg * (sc + 1.0f) + sh;
            u32x2 w; w.x = pk2(y.x, y.y); w.y = pk2(y.z, y.w); o8[64 * j] = w; }
    }
}
__device__ __forceinline__ void phase_final(Frame& F) {
    const int gw = F.bid * NWAVES + F.wave, NGW = F.G * NWAVES; const float* g = F.ap->in[I_FNG];
    for (int m = gw; m < ML; m += NGW) {
        const u32x2* xr = (const u32x2*)(F.A + (size_t)m * DM) + F.lane; f32x4* orow = (f32x4*)(F.out + (size_t)m * DM) + F.lane;
        u32x2 q[4]; f32x4 v[4]; float ss = 0.f;
#pragma unroll
        for (int j = 0; j < 4; ++j) q[j] = xr[64 * j];
#pragma unroll
        for (int j = 0; j < 4; ++j) { const f32x2 lo = bfx2(q[j].x), hi = bfx2(q[j].y); v[j] = (f32x4){lo.x, lo.y, hi.x, hi.y}; ss += (v[j].x * v[j].x + v[j].y * v[j].y) + (v[j].z * v[j].z + v[j].w * v[j].w); }
        const float r = rsqrtf(wave_sum(ss) * (1.f / DM) + 1e-6f);
#pragma unroll
        for (int j = 0; j < 4; ++j) { const f32x4 gg = *(const f32x4*)(g + 4 * F.lane + 256 * j); orow[64 * j] = v[j] * r * gg; }
    }
}

#ifndef SCAN_GLA_V0
#define SCAN_GLA_V0 0
#endif
__device__ __forceinline__ void gla_scan_block(Frame& F, int l, int chain) {
    constexpr int TS = 64;
    const int dir = chain & 1, h = (chain >> 1) & 3, b = chain >> 3;
    LAS float* q = (LAS float*)F.lds;
    LAS float* k = q + TS * 48; LAS float* g = k + TS * 48;
    LAS float* v = g + TS * 48;
    LAS float* y = v + TS * 96;
    const float* W2 = F.ap->in[I_GGW2] + (size_t)(l * 2 + dir) * 16 * 192 + h * 48; const float* Bg = F.ap->in[I_GGB] + (l * 2 + dir) * 192 + h * 48;
    const float qs = 0.14433756729740643f;
    float S[48];
#pragma unroll
    for (int j = 0; j < 48; ++j) S[j] = 0.f;
    for (int tile = 0; tile < SEQT / TS; ++tile) {
        const int sbase = tile * TS;
        for (int i = F.tid; i < TS * 48; i += NTHR) { const int st = i / 48, j = i % 48; const int m = seq_row(b, dir, sbase + st); const bf16_t* zr = F.Z + (size_t)m * ZP;
            q[i] = bf2f(zr[GLA_OFF + h * 48 + j]) * qs; k[i] = bf2f(zr[GLA_OFF + 192 + h * 48 + j]);
            float x = Bg[j];
#pragma unroll
            for (int r = 0; r < 16; ++r) x += bf2f(zr[GLA_OFF + 1152 + dir * 16 + r]) * W2[r * 192 + j];
            const float ls = fminf(x, 0.f) - log1pf(__expf(-fabsf(x)));
            g[i] = __expf(ls * (1.0f / 16.0f)); }
        for (int i = F.tid; i < TS * 96; i += NTHR) { const int st = i / 96, n = i % 96; const int m = seq_row(b, dir, sbase + st); v[i] = bf2f(F.Z[(size_t)m * ZP + GLA_OFF + 384 + h * 96 + n]); }
        __syncthreads();
        if (F.tid < 96) {
            for (int st = 0; st < TS; ++st) { const float vn = v[st * 96 + F.tid]; float o = 0.f;
#pragma unroll
                for (int j = 0; j < 48; ++j) { S[j] = S[j] * g[st * 48 + j] + k[st * 48 + j] * vn; o += q[st * 48 + j] * S[j]; }
                y[st * 96 + F.tid] = o; }
        }
        __syncthreads();
        for (int i = F.tid; i < TS * 96; i += NTHR) { const int st = i / 96, n = i % 96; const int m = seq_row(b, dir, sbase + st); const bf16_t o = f2bf(y[i]);
            if (dir == 0) F.A[(size_t)m * DM + h * 96 + n] = o; else F.Z[(size_t)m * ZP + YB_OFF + h * 96 + n] = o; }
        __syncthreads();
    }
}
__device__ __forceinline__ void gla_gate_units(Frame& F, int l, int first, int nblk) {
    LAS float* lrs = (LAS float*)F.lds;
    LAS float* qsum = lrs + 2 * 64 * 16;
    const int dp = F.tid % 96, tq = F.tid / 96;
    const int dir = first & 1, nit = NB * (SEQT / 64), step = nblk >> 1;
    f32x2 w[16], bias = {0.f, 0.f};
    if (tq < 4) { const float* W2 = F.ap->in[I_GGW2] + (size_t)(l * 2 + dir) * 16 * 192 + 2 * dp;
#pragma unroll
        for (int r = 0; r < 16; ++r) w[r] = *(const f32x2*)(W2 + r * 192);
        bias = *(const f32x2*)(F.ap->in[I_GGB] + (l * 2 + dir) * 192 + 2 * dp); }
    bf16_t nx[2];
    auto fetch = [&](int it) { const int b = it / (SEQT / 64), cs = it - b * (SEQT / 64);
#pragma unroll
        for (int q = 0; q < 2; ++q) { const int idx = F.tid + NTHR * q, tok = idx >> 4, r = idx & 15; const int m = seq_row(b, dir, cs * 64 + tok);
            nx[q] = F.Z[(size_t)m * ZP + GLA_OFF + 1152 + dir * 16 + r]; } };
    int it = first >> 1, par = 0;
    if (it < nit) fetch(it);
    for (; it < nit; it += step, par ^= 1) {
        const int b = it / (SEQT / 64), cs = it - b * (SEQT / 64);
        LAS float* lr = lrs + par * 1024;
        lr[F.tid] = bf2f(nx[0]); lr[F.tid + NTHR] = bf2f(nx[1]);
        if (it + step < nit) fetch(it + step);
        __syncthreads();
        f32x2 Gv[16]; f32x2 run = {0.f, 0.f};
        if (tq < 4) {
#pragma unroll
            for (int i = 0; i < 16; ++i) { const LAS f32x4* lp = (const LAS f32x4*)(lr + (tq * 16 + i) * 16); f32x2 x = bias;
#pragma unroll
                for (int r4 = 0; r4 < 4; ++r4) { const f32x4 l4 = lp[r4]; x += w[4 * r4] * l4.x; x += w[4 * r4 + 1] * l4.y; x += w[4 * r4 + 2] * l4.z; x += w[4 * r4 + 3] * l4.w; }
                f32x2 ls; ls.x = (fminf(x.x, 0.f) - __logf(1.0f + __expf(-fabsf(x.x)))) * (1.0f / 16.0f); ls.y = (fminf(x.y, 0.f) - __logf(1.0f + __expf(-fabsf(x.y)))) * (1.0f / 16.0f);
                run += ls; Gv[i] = run; }
            *(LAS f32x2*)(qsum + tq * 192 + 2 * dp) = run;
        }
        __syncthreads();
        if (tq < 4) { f32x2 off = {0.f, 0.f};
#pragma unroll
            for (int q = 0; q < 3; ++q) if (q < tq) off += *(const LAS f32x2*)(qsum + q * 192 + 2 * dp);
#pragma unroll
            for (int i = 0; i < 16; ++i) { const int m = seq_row(b, dir, cs * 64 + tq * 16 + i);
                float* dst = (dir == 0 ? (float*)(F.A + (size_t)m * DM) : (float*)(F.Z + (size_t)m * ZP + YB_OFF)) + 2 * dp;
                const f32x2 gv = Gv[i] + off;
                __hip_atomic_store((unsigned long long*)dst, ((unsigned long long)__float_as_uint(gv.y) << 32) | __float_as_uint(gv.x), __ATOMIC_RELAXED, __HIP_MEMORY_SCOPE_AGENT); }
        }
    }
}


__device__ __forceinline__ void group_arrive(unsigned* cnt, unsigned target, bool wait) {
    asm volatile("s_waitcnt vmcnt(0)" ::: "memory");
    __syncthreads();
    if (threadIdx.x == 0) {
        __hip_atomic_fetch_add(cnt, 1u, __ATOMIC_RELAXED, __HIP_MEMORY_SCOPE_AGENT);
        if (wait) { unsigned sp = 0; while (__hip_atomic_load(cnt, __ATOMIC_RELAXED, __HIP_MEMORY_SCOPE_AGENT) < target) { __builtin_amdgcn_s_sleep(4); if (++sp > (1u << 22)) break; }
            __builtin_amdgcn_fence(__ATOMIC_ACQUIRE, "agent"); asm volatile("s_waitcnt vmcnt(0)" ::: "memory"); }
    }
    __syncthreads();
}
typedef short bf16x8 __attribute__((ext_vector_type(8)));
#define LDS_BARRIER() do { asm volatile("s_waitcnt lgkmcnt(0)" ::: "memory"); __builtin_amdgcn_s_barrier(); asm volatile("" ::: "memory"); } while (0)
typedef _Float16 h2 __attribute__((ext_vector_type(2)));
typedef _Float16 h4 __attribute__((ext_vector_type(4)));
typedef _Float16 h8 __attribute__((ext_vector_type(8)));
constexpr int YPE = 20, YPS = 16 * YPE;
struct RwRaw { u32x4 raw[5]; bf16_t vraw[2]; };
struct RwCtx { const unsigned char* pv[5]; const unsigned char* pvv; unsigned char* py; unsigned cvec, cv0, cv1, cy0, cy1, yrow; int st, s20, s21, sg; };
__device__ __forceinline__ RwCtx rwkv_ctx(const Frame& F, int dir, int h, int quarter, int lt) {
    RwCtx C; const unsigned char* P = (const unsigned char*)F.PREP; const int wsel = dir ? PR_WB : PR_WF;
    C.pv[0] = P + (size_t)PR_KK * PREP_STRIDE * 2; C.pv[1] = P + (size_t)wsel * PREP_STRIDE * 2; C.pv[2] = P + (size_t)PR_B * PREP_STRIDE * 2; C.pv[3] = P + (size_t)PR_K * PREP_STRIDE * 2; C.pv[4] = P + (size_t)PR_R * PREP_STRIDE * 2;
    C.pvv = P + (size_t)PR_V * PREP_STRIDE * 2 + (h * 64 + quarter * 16) * 2;
    C.py = dir == 0 ? (unsigned char*)F.A + (384 + h * 64 + quarter * 16) * 2 : (unsigned char*)F.Z + (YB_OFF + 384 + h * 64 + quarter * 16) * 2;
    C.yrow = dir == 0 ? DM * 2 : ZP * 2; C.sg = dir ? -1 : 1;
    C.st = (lt >> 4) * 2; C.cvec = (h * 64 + (lt & 15) * 4) * 2; C.s20 = lt >> 4; C.s21 = (lt + 256) >> 4; C.cv0 = (lt & 15) * 2; C.cv1 = C.cv0; C.cy0 = C.cv0; C.cy1 = C.cv0;
    return C;
}
__device__ __forceinline__ void rwkv_load(RwRaw& R, const RwCtx& C, int b, int dir, int sbase) {
    const int m0 = __builtin_amdgcn_readfirstlane(seq_row(b, dir, sbase));
    const unsigned voa = (unsigned)(m0 + C.sg * C.st) * 768u + C.cvec, vob = voa + (unsigned)(C.sg * 768);
#pragma unroll
    for (int vi = 0; vi < 5; ++vi) { const u32x2 a = *(const u32x2*)(C.pv[vi] + voa), bb = *(const u32x2*)(C.pv[vi] + vob); R.raw[vi] = (u32x4){a.x, a.y, bb.x, bb.y}; }
    R.vraw[0] = *(const bf16_t*)(C.pvv + ((unsigned)(m0 + C.sg * C.s20) * 768u + C.cv0));
    R.vraw[1] = *(const bf16_t*)(C.pvv + ((unsigned)(m0 + C.sg * C.s21) * 768u + C.cv1));
}
__device__ __forceinline__ void rwkv_store(const RwRaw& R, LAS _Float16* vecb, LAS unsigned* vvb, int lt) {
    constexpr int TS = 32;
    LAS unsigned char* dst0 = (LAS unsigned char*)vecb + lt * 16;
#pragma unroll
    for (int vi = 0; vi < 5; ++vi) *(LAS u32x4*)(dst0 + vi * (TS / 2) * 16 * 8 * 2) = R.raw[vi];
#pragma unroll
    for (int q = 0; q < 2; ++q) { const int idx = lt + 256 * q, s2 = idx >> 4, rr = idx & 15; const unsigned v = R.vraw[q]; vvb[((s2 >> 1) * 16 + rr) * 2 + (s2 & 1)] = v | (v << 16); }
}
template <bool STORE = true> __device__ __forceinline__ void rwkv_flush(const RwCtx& C, const LAS float* ypb, int b, int dir, int sbase, int lt) {
    const int m0 = __builtin_amdgcn_readfirstlane(seq_row(b, dir, sbase));
#pragma unroll
    for (int q = 0; q < 2; ++q) { const int idx = lt + 256 * q;
        const LAS f32x4* pp = (const LAS f32x4*)(ypb + idx * YPE); const f32x4 a0 = pp[0], a1 = pp[1], a2 = pp[2], a3 = pp[3];
        const f32x4 t = (a0 + a1) + (a2 + a3); const bf16_t o = f2bf((t.x + t.y) + (t.z + t.w));
        if (STORE) *(bf16_t*)(C.py + ((unsigned)(m0 + C.sg * (q ? C.s21 : C.s20)) * C.yrow + C.cy0)) = o; else asm volatile("" :: "v"((unsigned)o), "v"(m0)); }
}
__device__ __forceinline__ float dot2_f16_z(h2 a, h2 b) { float d; asm("v_dot2_f32_f16 %0, %1, %2, 0" : "=v"(d) : "v"(a), "v"(b)); return d; }
template <int VAR> __device__ __forceinline__ void rwkv_compute_tile(const LAS _Float16* vb, const LAS u32x2* vvb, LAS float* ypp, h2& sA, h2& sB) {
    constexpr int TS = 32;
#define RW_FETCH(P, j_) do { if (VAR == 3) { P##kk.lo = *(const LAS h4*)(vb + (0 * (TS / 2) + (j_)) * 128); P##w.lo = *(const LAS h4*)(vb + (1 * (TS / 2) + (j_)) * 128); P##b.lo = *(const LAS h4*)(vb + (2 * (TS / 2) + (j_)) * 128); \
                P##k.lo = *(const LAS h4*)(vb + (3 * (TS / 2) + (j_)) * 128); P##r.lo = *(const LAS h4*)(vb + (4 * (TS / 2) + (j_)) * 128); P##kk.hi = P##kk.lo; P##w.hi = P##w.lo; P##b.hi = P##b.lo; P##k.hi = P##k.lo; P##r.hi = P##r.lo; P##v = vvb[(j_) * 16]; break; } \
                P##kk = *(const LAS h8*)(vb + (0 * (TS / 2) + (j_)) * 128); P##w = *(const LAS h8*)(vb + (1 * (TS / 2) + (j_)) * 128); P##b = *(const LAS h8*)(vb + (2 * (TS / 2) + (j_)) * 128); \
                P##k = *(const LAS h8*)(vb + (3 * (TS / 2) + (j_)) * 128); P##r = *(const LAS h8*)(vb + (4 * (TS / 2) + (j_)) * 128); P##v = vvb[(j_) * 16]; } while (0)
    h8 n_kk, n_w, n_b, n_k, n_r; u32x2 n_v;
    RW_FETCH(n_, 0);
    h4 r_p = n_r.lo;
#pragma unroll
    for (int j = 0; j < TS / 2; ++j) {
        const h4 kka = n_kk.lo, wa = n_w.lo, ba = n_b.lo, ka = n_k.lo, ra = n_r.lo, kkb = n_kk.hi, wb = n_w.hi, bb = n_b.hi, kb = n_k.hi, rb = n_r.hi;
        const unsigned vxa_ = n_v.x, vxb_ = n_v.y;
        const h2 vha = __builtin_bit_cast(h2, vxa_), vhb = __builtin_bit_cast(h2, vxb_);
        if (j + 1 < TS / 2) RW_FETCH(n_, j + 1);
        __builtin_amdgcn_sched_barrier(0);
        __builtin_amdgcn_s_waitcnt(0xC67F);
        float p = dot2_f16_z(sA, kka.xy); p = __builtin_amdgcn_fdot2(sB, kka.zw, p, false);
        if (j > 0) { float yq = dot2_f16_z(sA, r_p.xy); yq = __builtin_amdgcn_fdot2(sB, r_p.zw, yq, false); ypp[(2 * j - 1) * YPS] = yq; }
        sA = sA * wa.xy + ka.xy * vha; sB = sB * wa.zw + ka.zw * vha;
        if (VAR != 4) p = reduce16(p);
        { const _Float16 ph = (_Float16)p; const h2 p2 = {ph, ph}; sA = sA - ba.xy * p2; sB = sB - ba.zw * p2; }
        float pb = dot2_f16_z(sA, kkb.xy); pb = __builtin_amdgcn_fdot2(sB, kkb.zw, pb, false);
        { float yq = dot2_f16_z(sA, ra.xy); yq = __builtin_amdgcn_fdot2(sB, ra.zw, yq, false); ypp[(2 * j) * YPS] = yq; }
        sA = sA * wb.xy + kb.xy * vhb; sB = sB * wb.zw + kb.zw * vhb;
        if (VAR != 4) pb = reduce16(pb);
        { const _Float16 ph = (_Float16)pb; const h2 p2 = {ph, ph}; sA = sA - bb.xy * p2; sB = sB - bb.zw * p2; }
        r_p = rb;
    }
    { float yq = dot2_f16_z(sA, r_p.xy); yq = __builtin_amdgcn_fdot2(sB, r_p.zw, yq, false); ypp[(TS - 1) * YPS] = yq; }
#undef RW_FETCH
}
#ifndef PROBE_T
#define PROBE_T 0
#endif
__device__ unsigned long long g_probe_acc;
#ifndef RW_VAR
#define RW_VAR 0
#endif
template <int VAR = 0> __device__ __forceinline__ void rwkv_scan_block(Frame& F, int chain, int quarter) {
    constexpr int TS = 32, NT = SEQT / TS;
    const int dir = chain & 1, h = (chain >> 1) % 6, b = (chain >> 1) / 6;
    LAS _Float16* vec = (LAS _Float16*)F.lds;
    LAS unsigned* vv = (LAS unsigned*)(vec + 2 * 5 * TS * 64);
    LAS float* yp = (LAS float*)(vv + 2 * TS * 16);
#ifndef RW_ROLE
#define RW_ROLE 0
#endif
    const bool comp = RW_ROLE ? (F.wave & 1) == 0 : F.wave < 4; const int rw = RW_ROLE ? F.wave >> 1 : F.wave & 3;
    const int rg = F.lane >> 4, lrow = rw * 4 + rg, lt = rw * 64 + F.lane; const int cgp = F.lane & 15;
    h2 sA = {(_Float16)0.f, (_Float16)0.f}, sB = sA;
    RwRaw RE, RO;
    const RwCtx C = rwkv_ctx(F, dir, h, quarter, lt);
    if (!comp && VAR != 1 && VAR != 6 && VAR != 11 && VAR != 16) { rwkv_load(RE, C, b, dir, 0); rwkv_store(RE, vec, vv, lt); rwkv_load(RO, C, b, dir, TS); rwkv_load(RE, C, b, dir, 2 * TS); }
    __syncthreads();
#define RW_TILE(tile, cur, RS) do { \
        if (comp) { if (VAR != 2) rwkv_compute_tile<VAR>(vec + (cur) * 5 * TS * 64 + cgp * 8, (const LAS u32x2*)(vv + (cur) * TS * 16) + lrow, yp + (cur) * TS * YPS + lrow * YPE + cgp, sA, sB); } \
        else if (VAR != 1 && VAR != 11) { \
            if (VAR != 6 && VAR != 16) { rwkv_store(RS, vec + ((cur) ^ 1) * 5 * TS * 64, vv + ((cur) ^ 1) * TS * 16, lt);     \
                rwkv_load(RS, C, b, dir, min((tile) + 3, NT - 1) * TS); } \
            if ((tile) > 0 && VAR != 5 && VAR != 15) rwkv_flush<(VAR < 10)>(C, yp + ((cur) ^ 1) * TS * YPS, b, dir, ((tile) - 1) * TS, lt); } \
        LDS_BARRIER(); } while (0)
    for (int tile = 0; tile < NT; tile += 2) { RW_TILE(tile, 0, RO); RW_TILE(tile + 1, 1, RE); }
#undef RW_TILE
    if (!comp && VAR != 1 && VAR != 11) rwkv_flush<(VAR < 10)>(C, yp + ((NT - 1) & 1) * TS * YPS, b, dir, (NT - 1) * TS, lt);
}

namespace ce {
constexpr int PITCH = 72, IMG = 64 * PITCH * 2;
constexpr int VTB = 96 * PITCH * 2;
constexpr int O_QG = 0, O_KG = 2 * IMG, O_KET = 4 * IMG, O_VT = 6 * IMG, O_PB = O_VT + 2 * VTB, O_ST = O_PB + IMG, O_DEC = O_ST + 2 * VTB, O_WSUM = O_DEC + 512, O_END = O_WSUM + 8 * 48 * 4, O_W2 = O_END, O_END2 = O_W2 + 17 * 48 * 4;
static_assert(O_END2 <= 131072, "chunk engine LDS");
__device__ __forceinline__ bf16x8 frag(const LAS unsigned char* img, int row, int col) { return *(const LAS bf16x8*)(img + (row * PITCH + col) * 2); }
__device__ __forceinline__ void st4(LAS unsigned char* img, int row, int col, f32x4 v) { u32x2 w; w.x = pk2(v.x, v.y); w.y = pk2(v.z, v.w); *(LAS u32x2*)(img + (row * PITCH + col) * 2) = w; }
__device__ __forceinline__ f32x2 up2(unsigned u) { f32x2 r; r.x = __uint_as_float(u << 16); r.y = __uint_as_float(u & 0xffff0000u); return r; }

template <int DV> __device__ __forceinline__ void chunk_mma(Frame& F, LAS unsigned char* L, int cb, int sb, f32x4 (&acc_s)[DV / 32], int b, int dir, int cs, int ycol0) {
    constexpr int NQ = DV / 32;
    const int lane = F.lane, w = F.wave, lr = lane & 15, lq = lane >> 4;
    LAS unsigned char* Qg = L + O_QG + cb * IMG; LAS unsigned char* Kg = L + O_KG + cb * IMG; LAS unsigned char* KeT = L + O_KET + cb * IMG;
    LAS unsigned char* Vt = L + O_VT + cb * VTB; LAS unsigned char* Pb = L + O_PB; LAS unsigned char* St = L + O_ST + sb * VTB; LAS unsigned char* Sn = L + O_ST + (sb ^ 1) * VTB;
    const LAS float* dec = (const LAS float*)(L + O_DEC + cb * 256);
#pragma unroll
    for (int q = 0; q < 2; ++q) { const int idx = w + 8 * q; if (idx < 10) {
            const int jt = idx < 4 ? 0 : idx < 7 ? 1 : idx < 9 ? 2 : 3; const int it = idx < 4 ? idx : idx < 7 ? idx - 3 : idx < 9 ? idx - 5 : 3;
            f32x4 acc = {0.f, 0.f, 0.f, 0.f};
#pragma unroll
            for (int ks = 0; ks < 2; ++ks) acc = __builtin_amdgcn_mfma_f32_16x16x32_bf16(frag(Kg, jt * 16 + lr, 32 * ks + 8 * lq), frag(Qg, it * 16 + lr, 32 * ks + 8 * lq), acc, 0, 0, 0);
            if (jt == it) {
#pragma unroll
                for (int r = 0; r < 4; ++r) if (4 * lq + r > lr) acc[r] = 0.f; }
            st4(Pb, it * 16 + lr, jt * 16 + 4 * lq, acc); } }
    LDS_BARRIER();
#pragma unroll
    for (int q = 0; q < NQ; ++q) { const int id = w + 8 * q, nt = id >> 2, it = id & 3;
        f32x4 acc = {0.f, 0.f, 0.f, 0.f};
#pragma unroll
        for (int ks = 0; ks < 2; ++ks) acc = __builtin_amdgcn_mfma_f32_16x16x32_bf16(frag(St, nt * 16 + lr, 32 * ks + 8 * lq), frag(Qg, it * 16 + lr, 32 * ks + 8 * lq), acc, 0, 0, 0);
#pragma unroll
        for (int ks = 0; ks < 2; ++ks) acc = __builtin_amdgcn_mfma_f32_16x16x32_bf16(frag(Vt, nt * 16 + lr, 32 * ks + 8 * lq), frag(Pb, it * 16 + lr, 32 * ks + 8 * lq), acc, 0, 0, 0);
        const int m = seq_row(b, dir, cs * 64 + it * 16 + lr); const int col = ycol0 + nt * 16 + 4 * lq;
        u32x2 o; o.x = pk2(acc.x, acc.y); o.y = pk2(acc.z, acc.w);
        if (dir == 0) *(u32x2*)(F.A + (size_t)m * DM + col) = o; else *(u32x2*)(F.Z + (size_t)m * ZP + YB_OFF + col) = o; }
#pragma unroll
    for (int q = 0; q < NQ; ++q) { const int id = w + 8 * q, kt = id & 3, nt = id >> 2;
        const f32x4 d4 = *(const LAS f32x4*)(dec + kt * 16 + 4 * lq);
        f32x4 acc = acc_s[q] * d4;
#pragma unroll
        for (int ks = 0; ks < 2; ++ks) acc = __builtin_amdgcn_mfma_f32_16x16x32_bf16(frag(KeT, kt * 16 + lr, 32 * ks + 8 * lq), frag(Vt, nt * 16 + lr, 32 * ks + 8 * lq), acc, 0, 0, 0);
        acc_s[q] = acc;
        st4(Sn, nt * 16 + lr, kt * 16 + 4 * lq, acc); }
}

__device__ __forceinline__ void ret_chain(Frame& F, int l, int chain) {
    constexpr int DV = 64, NCH = SEQT / 64;
    const int dir = chain & 1, h = (chain >> 1) & 3, b = chain >> 3;
    LAS unsigned char* L = F.lds;
    const int tp = F.tid >> 4, jj = F.tid & 15, t0 = 2 * tp, t1 = t0 + 1;
    const float lgam = -__expf(F.ap->in[I_RETLR][(l * 2 + dir) * 4 + h]);
    float eq[2], ek[2], ee[2];
#pragma unroll
    for (int e = 0; e < 2; ++e) { const float G = (float)(t0 + e + 1) * lgam; eq[e] = __expf(G); ek[e] = 0.125f * __expf(-G); ee[e] = 0.125f * __expf(64.0f * lgam - G); }
    const int d0 = 2 * jj;
    const bool rowb = d0 < 16; float inv[2];
#pragma unroll
    for (int e = 0; e < 2; ++e) inv[e] = powf(10000.0f, -(float)((d0 + e) & 15) * (1.0f / 16.0f));
    float ccs[2][2], csn[2][2];
#pragma unroll
    for (int tk = 0; tk < 2; ++tk)
#pragma unroll
        for (int e = 0; e < 2; ++e) { const float pos = (float)(dir ? 63 - (t0 + tk) : (t0 + tk)); sincosf(pos * inv[e], &csn[tk][e], &ccs[tk][e]); }
    for (int i = F.tid; i < IMG / 4; i += NTHR) ((LAS unsigned*)(L + O_PB))[i] = 0u;
    for (int i = F.tid; i < VTB / 4; i += NTHR) ((LAS unsigned*)(L + O_ST))[i] = 0u;
    if (F.tid < 128) ((LAS float*)(L + O_DEC))[F.tid] = __expf(64.0f * lgam);
    f32x4 acc_s[DV / 32];
#pragma unroll
    for (int q = 0; q < DV / 32; ++q) acc_s[q] = (f32x4){0.f, 0.f, 0.f, 0.f};
    unsigned rq[2][2], rk[2][2], rv[2][2];
    const bf16_t* Zc = F.Z + RET_OFF + h * 64 + d0;
#define RET_LOAD(cs_) do { _Pragma("unroll") for (int tk = 0; tk < 2; ++tk) { const int m = seq_row(b, dir, (cs_) * 64 + t0 + tk); const bf16_t* zr = Zc + (size_t)m * ZP; \
        rq[tk][0] = *(const unsigned*)(zr); rq[tk][1] = *(const unsigned*)(zr + 32); rk[tk][0] = *(const unsigned*)(zr + 256); rk[tk][1] = *(const unsigned*)(zr + 288); \
        rv[tk][0] = *(const unsigned*)(zr + 512); rv[tk][1] = *(const unsigned*)(zr + 544); } } while (0)
#define RET_STAGE(cs_, cb_) do { \
        LAS unsigned char* Qg = L + O_QG + (cb_) * IMG; LAS unsigned char* Kg = L + O_KG + (cb_) * IMG; LAS unsigned char* KeT = L + O_KET + (cb_) * IMG; LAS unsigned char* Vt = L + O_VT + (cb_) * VTB; \
        const bool lat = (cs_) >= 4; float rc[2] = {1.f, 1.f}, rs[2] = {0.f, 0.f}; \
        if (lat && rowb) { const float row = (float)(dir ? 127 - ((cs_) - 4) : (cs_) - 4); _Pragma("unroll") for (int e = 0; e < 2; ++e) { rs[e] = __sinf(row * inv[e]); rc[e] = __cosf(row * inv[e]); } } \
        f32x2 ke_lo[2], ke_hi[2], v_lo[2], v_hi[2]; \
        _Pragma("unroll") for (int tk = 0; tk < 2; ++tk) { \
            f32x2 q1 = up2(rq[tk][0]), q2 = up2(rq[tk][1]), k1 = up2(rk[tk][0]), k2 = up2(rk[tk][1]); \
            f32x2 c, s; if (rowb) { c.x = rc[0]; c.y = rc[1]; s.x = rs[0]; s.y = rs[1]; } else { c.x = lat ? ccs[tk][0] : 1.f; c.y = lat ? ccs[tk][1] : 1.f; s.x = lat ? csn[tk][0] : 0.f; s.y = lat ? csn[tk][1] : 0.f; } \
            const f32x2 qa = q1 * c - q2 * s, qb = q1 * s + q2 * c, ka = k1 * c - k2 * s, kb = k1 * s + k2 * c; \
            const int t = t0 + tk; \
            *(LAS unsigned*)(Qg + (t * PITCH + d0) * 2) = pk2(qa.x * eq[tk], qa.y * eq[tk]); *(LAS unsigned*)(Qg + (t * PITCH + d0 + 32) * 2) = pk2(qb.x * eq[tk], qb.y * eq[tk]); \
            *(LAS unsigned*)(Kg + (t * PITCH + d0) * 2) = pk2(ka.x * ek[tk], ka.y * ek[tk]); *(LAS unsigned*)(Kg + (t * PITCH + d0 + 32) * 2) = pk2(kb.x * ek[tk], kb.y * ek[tk]); \
            ke_lo[tk] = ka * ee[tk]; ke_hi[tk] = kb * ee[tk]; v_lo[tk] = up2(rv[tk][0]); v_hi[tk] = up2(rv[tk][1]); } \
        *(LAS unsigned*)(KeT + ((d0) * PITCH + t0) * 2) = pk2(ke_lo[0].x, ke_lo[1].x); *(LAS unsigned*)(KeT + ((d0 + 1) * PITCH + t0) * 2) = pk2(ke_lo[0].y, ke_lo[1].y); \
        *(LAS unsigned*)(KeT + ((d0 + 32) * PITCH + t0) * 2) = pk2(ke_hi[0].x, ke_hi[1].x); *(LAS unsigned*)(KeT + ((d0 + 33) * PITCH + t0) * 2) = pk2(ke_hi[0].y, ke_hi[1].y); \
        *(LAS unsigned*)(Vt + ((d0) * PITCH + t0) * 2) = pk2(v_lo[0].x, v_lo[1].x); *(LAS unsigned*)(Vt + ((d0 + 1) * PITCH + t0) * 2) = pk2(v_lo[0].y, v_lo[1].y); \
        *(LAS unsigned*)(Vt + ((d0 + 32) * PITCH + t0) * 2) = pk2(v_hi[0].x, v_hi[1].x); *(LAS unsigned*)(Vt + ((d0 + 33) * PITCH + t0) * 2) = pk2(v_hi[0].y, v_hi[1].y); \
    } while (0)
    RET_LOAD(0); RET_STAGE(0, 0);
    __syncthreads();
    for (int cs = 0; cs < NCH; ++cs) { const int cb = cs & 1;
        if (cs + 1 < NCH) RET_LOAD(cs + 1);
        chunk_mma<DV>(F, L, cb, cb, acc_s, b, dir, cs, 768 + h * 64);
        if (cs + 1 < NCH) RET_STAGE(cs + 1, cb ^ 1);
        LDS_BARRIER();
    }
#undef RET_LOAD
#undef RET_STAGE
}

__device__ __forceinline__ void gla_chain(Frame& F, int l, int chain) {
    constexpr int DV = 96, NCH = SEQT / 64;
    const int dir = chain & 1, h = (chain >> 1) & 3, b = chain >> 3;
    LAS unsigned char* L = F.lds;
    const int t = F.tid >> 3, j8 = F.tid & 7, d0 = 2 * j8;
    const float qs = 0.14433756729740643f;
    for (int i = F.tid; i < O_END / 4; i += NTHR) ((LAS unsigned*)L)[i] = 0u;
    f32x4 acc_s[DV / 32];
#pragma unroll
    for (int q = 0; q < DV / 32; ++q) acc_s[q] = (f32x4){0.f, 0.f, 0.f, 0.f};
    unsigned rq[3], rk[3], rv[6]; f32x2 rg[3], rge[3];
    const bf16_t* Zc = F.Z + GLA_OFF + h * 48 + d0;
#define GLA_GP(m_) ((dir == 0 ? (const float*)(F.A + (size_t)(m_) * DM) : (const float*)(F.Z + (size_t)(m_) * ZP + YB_OFF)) + h * 48 + d0)
#define GLA_LOAD(cs_) do { const int m = seq_row(b, dir, (cs_) * 64 + t); const bf16_t* zr = Zc + (size_t)m * ZP; const bf16_t* zv = F.Z + (size_t)m * ZP + GLA_OFF + 384 + h * 96 + d0; \
        _Pragma("unroll") for (int q = 0; q < 3; ++q) { rq[q] = *(const unsigned*)(zr + 16 * q); rk[q] = *(const unsigned*)(zr + 192 + 16 * q); } \
        _Pragma("unroll") for (int q = 0; q < 6; ++q) rv[q] = *(const unsigned*)(zv + 16 * q); \
        const float* gp = GLA_GP(m); const float* ge = GLA_GP(seq_row(b, dir, (cs_) * 64 + 63)); \
        _Pragma("unroll") for (int q = 0; q < 3; ++q) { rg[q] = *(const f32x2*)(gp + 16 * q); rge[q] = *(const f32x2*)(ge + 16 * q); } } while (0)
#define GLA_STAGE(cs_, cb_) do { \
        LAS unsigned char* Qg = L + O_QG + (cb_) * IMG; LAS unsigned char* Kg = L + O_KG + (cb_) * IMG; LAS unsigned char* KeT = L + O_KET + (cb_) * IMG; LAS unsigned char* Vt = L + O_VT + (cb_) * VTB; \
        if (t == 0) { _Pragma("unroll") for (int q = 0; q < 3; ++q) *(LAS f32x2*)((LAS float*)(L + O_DEC + (cb_) * 256) + d0 + 16 * q) = (f32x2){__expf(rge[q].x), __expf(rge[q].y)}; } \
        _Pragma("unroll") for (int q = 0; q < 3; ++q) { const f32x2 qv = up2(rq[q]), kv = up2(rk[q]); const int d = d0 + 16 * q; const float g0 = rg[q].x, g1 = rg[q].y; \
            const float eq0 = __expf(g0) * qs, eq1 = __expf(g1) * qs, ek0 = __expf(-g0), ek1 = __expf(-g1), ee0 = __expf(rge[q].x - g0), ee1 = __expf(rge[q].y - g1); \
            *(LAS unsigned*)(Qg + (t * PITCH + d) * 2) = pk2(qv.x * eq0, qv.y * eq1); *(LAS unsigned*)(Kg + (t * PITCH + d) * 2) = pk2(kv.x * ek0, kv.y * ek1); \
            *(LAS bf16_t*)(KeT + (d * PITCH + t) * 2) = f2bf(kv.x * ee0); *(LAS bf16_t*)(KeT + ((d + 1) * PITCH + t) * 2) = f2bf(kv.y * ee1); } \
        _Pragma("unroll") for (int q = 0; q < 6; ++q) { const int d = d0 + 16 * q; *(LAS bf16_t*)(Vt + (d * PITCH + t) * 2) = (bf16_t)(rv[q] & 0xffffu); *(LAS bf16_t*)(Vt + ((d + 1) * PITCH + t) * 2) = (bf16_t)(rv[q] >> 16); } \
    } while (0)
    __syncthreads();
    GLA_LOAD(0); GLA_STAGE(0, 0);
    __syncthreads();
    for (int cs = 0; cs < NCH; ++cs) { const int cb = cs & 1;
        if (cs + 1 < NCH) GLA_LOAD(cs + 1);
        chunk_mma<DV>(F, L, cb, cb, acc_s, b, dir, cs, h * 96);
        if (cs + 1 < NCH) GLA_STAGE(cs + 1, cb ^ 1);
        LDS_BARRIER();
    }
#undef GLA_LOAD
#undef GLA_STAGE
#undef GLA_GP
}
}

#ifndef PROBE_DUP
#define PROBE_DUP 0
#endif
__device__ __forceinline__ void phase_scan(Frame& F, int l) {
    for (int task = F.bid; task < 256; task += F.G) {
        const int rw_chain = (task & 7) * 6 + (task >> 5), rw_quarter = (task >> 3) & 3;
        if ((PROBE_DUP & 32) && task < 192) { rwkv_scan_block<RW_VAR>(F, rw_chain, rw_quarter); __syncthreads(); }
        if ((PROBE_DUP & 64) && task >= 192 && task < 224) { ce::gla_chain(F, l, task - 192); __syncthreads(); }
        if ((PROBE_DUP & 128) && task >= 224) { ce::ret_chain(F, l, task - 224); __syncthreads(); }
        if (task >= 192 && F.G == 256) {
            if (PROBE_T == 18 && blockIdx.x == 192 && threadIdx.x == 0) *(volatile LAS unsigned long long*)(F.lds + LDS_BYTES - 128) = __builtin_amdgcn_s_memrealtime();
            gla_gate_units(F, l, task - 192, 64);
            group_arrive((unsigned*)(F.ws + WS_CTL) + 8192 + l * 64, 64u, task < 224);
            if (PROBE_T == 18 && blockIdx.x == 192 && threadIdx.x == 0) { volatile LAS unsigned long long* tp = (volatile LAS unsigned long long*)(F.lds + LDS_BYTES - 128); tp[1] = tp[1] + (__builtin_amdgcn_s_memrealtime() - tp[0]); }
        }
        if (task < 192) { rwkv_scan_block(F, rw_chain, rw_quarter); if (PROBE_DUP & 256) { __syncthreads(); rwkv_scan_block<RW_VAR>(F, rw_chain, rw_quarter); } }
        else if (task < 224) {
#if SCAN_GLA_V0
            gla_scan_block(F, l, task - 192);
#else
            ce::gla_chain(F, l, task - 192);
#endif
        } else ce::ret_chain(F, l, task - 224);
        __syncthreads();
    }
}
namespace pp {
template <int N> struct IC { static constexpr int value = N; };
constexpr int OSP = 392;
__device__ __forceinline__ bf16x8 pack8(const float (&w)[8]) { u32x4 u; u.x = pk2(w[0], w[1]); u.y = pk2(w[2], w[3]); u.z = pk2(w[4], w[5]); u.w = pk2(w[6], w[7]); return __builtin_bit_cast(bf16x8, u); }
__device__ __forceinline__ void unpack8(u32x4 r, float (&o)[8]) {
    o[0] = __uint_as_float(r.x << 16); o[1] = __uint_as_float(r.x & 0xffff0000u); o[2] = __uint_as_float(r.y << 16); o[3] = __uint_as_float(r.y & 0xffff0000u);
    o[4] = __uint_as_float(r.z << 16); o[5] = __uint_as_float(r.z & 0xffff0000u); o[6] = __uint_as_float(r.w << 16); o[7] = __uint_as_float(r.w & 0xffff0000u); }
__device__ __forceinline__ u32x4 pack8h(const float (&w)[8]) { u32x4 u; u.x = pkh2(w[0], w[1]); u.y = pkh2(w[2], w[3]); u.z = pkh2(w[4], w[5]); u.w = pkh2(w[6], w[7]); return u; }
__device__ __forceinline__ u32x4 pack8u(const float (&w)[8]) { u32x4 u; u.x = pk2(w[0], w[1]); u.y = pk2(w[2], w[3]); u.z = pk2(w[4], w[5]); u.w = pk2(w[6], w[7]); return u; }
struct Z5 { u32x4 c, n0, n1, n2, n3; };
__device__ __forceinline__ Z5 load5(const bf16_t* p, const ZNb& n) { Z5 z; z.c = *(const u32x4*)p; z.n0 = *(const u32x4*)(p + n.o[0]); z.n1 = *(const u32x4*)(p + n.o[1]); z.n2 = *(const u32x4*)(p + n.o[2]); z.n3 = *(const u32x4*)(p + n.o[3]); return z; }
__device__ __forceinline__ void mix8(const Z5& z, const ZNb& n, const float* mu8, float (&o)[8]) {
    float zc[8], a0[8], a1[8], a2[8], a3[8]; unpack8(z.c, zc); unpack8(z.n0, a0); unpack8(z.n1, a1); unpack8(z.n2, a2); unpack8(z.n3, a3);
#pragma unroll
    for (int e = 0; e < 8; ++e) { const float nb = (a0[e] * n.w[0] + a1[e] * n.w[1]) + (a2[e] * n.w[2] + a3[e] * n.w[3]); o[e] = zc[e] + mu8[e] * (nb - zc[e]); }
}
__device__ __forceinline__ void shift8(const bf16_t* p, const ZNb& n, const float* mu8, float (&o)[8]) { const Z5 z = load5(p, n); mix8(z, n, mu8, o); }

__device__ __forceinline__ void phase_prep(Frame& F, int l) {
    constexpr int ZSP = 488;
    LAS unsigned char* L = F.lds;
    LAS bf16_t* zs = (LAS bf16_t*)L;
    LAS bf16_t* os = (LAS bf16_t*)(L + 16 * ZSP * 2);
    LAS float* mus = (LAS float*)(L + 16 * ZSP * 2 + 5 * 16 * OSP * 2);
    LAS float* cst = mus + 1248;
    const float* mu = F.ap->in[I_RMU] + l * 1312;
    for (int i = F.tid; i < 1248; i += NTHR) mus[i] = mu[i];
    for (int i = F.tid; i < 384; i += NTHR) { cst[i] = F.ap->in[I_RW0][(l * 2 + 0) * 384 + i]; cst[384 + i] = F.ap->in[I_RW0][(l * 2 + 1) * 384 + i]; cst[768 + i] = F.ap->in[I_RA0][l * 384 + i];
        cst[1152 + i] = F.ap->in[I_RKK][l * 384 + i]; cst[1536 + i] = F.ap->in[I_RKA][l * 384 + i]; }
    const int lr = F.lane & 15, lq = F.lane >> 4, h = F.wave;
    bf16x8 Bf[4], Bb[4], Ba[4];
    if (h < 6) {
#pragma unroll
        for (int nt = 0; nt < 4; ++nt) { const int col = h * 64 + 16 * nt + lr; float t0[8], t1[8], t2[8];
#pragma unroll
            for (int j = 0; j < 8; ++j) { const int k = 8 * lq + j; t0[j] = F.ap->in[I_RW2][((size_t)(l * 2 + 0) * 32 + k) * 384 + col]; t1[j] = F.ap->in[I_RW2][((size_t)(l * 2 + 1) * 32 + k) * 384 + col]; t2[j] = F.ap->in[I_RA2][((size_t)l * 32 + k) * 384 + col]; }
            Bf[nt] = pack8(t0); Bb[nt] = pack8(t1); Ba[nt] = pack8(t2);
 }
    }
    __syncthreads();
    auto unit = [&](const int m0, auto nt_) { constexpr int NTOK = decltype(nt_)::value;
        if (PROBE_T == 19 && blockIdx.x == 0 && threadIdx.x == 0) *(volatile LAS unsigned long long*)(F.lds + LDS_BYTES - 128) = __builtin_amdgcn_s_memrealtime();
        { constexpr int NP = NTOK * 156;
          const unsigned char* zb = (const unsigned char*)F.Z; Z5 zz[5];
          int tl = F.tid; asm volatile("" : "+v"(tl));
#pragma unroll
          for (int k = 0; k < 5; ++k) { const int p = tl + NTHR * k; if (NTOK == 16 ? (k < 4 || p < NP) : (k < 2 && p < NP)) { const int tok = p / 156, gin = p - tok * 156, m = m0 + tok;
              const unsigned vo = ((unsigned)m * ZP + RW_OFF + gin * 8) * 2u; int d0, d1, d2, d3;
              if (m < ML) { const int t = m & (SEQ - 1), gr = t >> 6, gc = t & 63; d0 = gr > 0 ? -64 * ZP * 2 : 0; d1 = gr < 127 ? 64 * ZP * 2 : 0; d2 = gc > 0 ? -ZP * 2 : 0; d3 = gc < 63 ? ZP * 2 : 0; }
              else { const int t = (m - ML) & (CTXL - 1); d0 = 0; d1 = 0; d2 = t > 0 ? -ZP * 2 : 0; d3 = t < CTXL - 1 ? ZP * 2 : 0; }
              zz[k].c = *(const u32x4*)(zb + vo); zz[k].n0 = *(const u32x4*)(zb + (vo + d0)); zz[k].n1 = *(const u32x4*)(zb + (vo + d1)); zz[k].n2 = *(const u32x4*)(zb + (vo + d2)); zz[k].n3 = *(const u32x4*)(zb + (vo + d3)); } }
          asm volatile("" : "+v"(tl));
#pragma unroll
          for (int k = 0; k < 5; ++k) { const int p = tl + NTHR * k; if (NTOK == 16 ? (k < 4 || p < NP) : (k < 2 && p < NP)) { const int tok = p / 156, gin = p - tok * 156, col0 = gin * 8, m = m0 + tok;
              const ZNb nbv = znb(m);
              float o[8]; float mu8[8];
#pragma unroll
              for (int e = 0; e < 8; ++e) mu8[e] = mus[col0 + e];
              mix8(zz[k], nbv, mu8, o);
              if (col0 < 384) *(u32x4*)(F.PREP + PR_R * PREP_STRIDE + (size_t)m * 384 + col0) = pack8h(o);
              else if (col0 < 768) *(LAS u32x4*)(zs + tok * ZSP + (col0 - 384)) = pack8u(o);
              else if (col0 < 1152) *(u32x4*)(F.PREP + PR_V * PREP_STRIDE + (size_t)m * 384 + (col0 - 768)) = pack8h(o);
              else { if (col0 < 1216) {
#pragma unroll
                      for (int e = 0; e < 8; ++e) o[e] = fast_tanh(o[e]); }
                  *(LAS u32x4*)(zs + tok * ZSP + 384 + (col0 - 1152)) = pack8u(o); } } }
        }
        __syncthreads();
        if (PROBE_T == 19 && blockIdx.x == 0 && threadIdx.x == 0) { volatile LAS unsigned long long* tp = (volatile LAS unsigned long long*)(F.lds + LDS_BYTES - 128); tp[1] = tp[1] + (__builtin_amdgcn_s_memrealtime() - tp[0]); }
        if (h < 6) {
            const bf16x8 af = *(const LAS bf16x8*)(zs + lr * ZSP + 384 + 8 * lq), ab = *(const LAS bf16x8*)(zs + lr * ZSP + 416 + 8 * lq), aa = *(const LAS bf16x8*)(zs + lr * ZSP + 448 + 8 * lq);
            float kv[4][4], kkv[4][4], av[4][4]; float ss = 0.f; const size_t orow = (size_t)(m0 + lr) * 384;
#pragma unroll
            for (int nt = 0; nt < 4; ++nt) { const f32x4 z4 = {0.f, 0.f, 0.f, 0.f};
                const f32x4 xf = __builtin_amdgcn_mfma_f32_16x16x32_bf16(Bf[nt], af, z4, 0, 0, 0), xb = __builtin_amdgcn_mfma_f32_16x16x32_bf16(Bb[nt], ab, z4, 0, 0, 0), xa = __builtin_amdgcn_mfma_f32_16x16x32_bf16(Ba[nt], aa, z4, 0, 0, 0);
                const int cl = h * 64 + 16 * nt + 4 * lq;
                const f32x4 c_w0f = *(const LAS f32x4*)(cst + cl), c_w0b = *(const LAS f32x4*)(cst + 384 + cl), c_a0 = *(const LAS f32x4*)(cst + 768 + cl), c_kk = *(const LAS f32x4*)(cst + 1152 + cl);
                const u32x2 kraw = *(const LAS u32x2*)(zs + lr * ZSP + cl); const f32x2 k01 = ce::up2(kraw.x), k23 = ce::up2(kraw.y); const float kq[4] = {k01.x, k01.y, k23.x, k23.y};
                float dwf[4], dwb[4];
#pragma unroll
                for (int r = 0; r < 4; ++r) {
                    const float ef = sigmoidf_(xf[r] + c_w0f[r]) * 0.6065306597f, eb = sigmoidf_(xb[r] + c_w0b[r]) * 0.6065306597f;
                    dwf[r] = __expf(-ef); dwb[r] = __expf(-eb);
                    const float a = sigmoidf_(xa[r] + c_a0[r]); const float kx = kq[r] * c_kk[r];
                    kv[nt][r] = kq[r]; kkv[nt][r] = kx; av[nt][r] = a; ss += kx * kx; }
                if (NTOK == 16 || lr < NTOK) *(u32x2*)(F.PREP + (size_t)PR_WF * PREP_STRIDE + orow + cl) = (u32x2){pkh2(dwf[0], dwf[1]), pkh2(dwf[2], dwf[3])};
                if (NTOK == 16 || lr < NTOK) *(u32x2*)(F.PREP + (size_t)PR_WB * PREP_STRIDE + orow + cl) = (u32x2){pkh2(dwb[0], dwb[1]), pkh2(dwb[2], dwb[3])}; }
            { auto r1 = __builtin_amdgcn_permlane16_swap(__float_as_uint(ss), __float_as_uint(ss), false, false); ss = __uint_as_float(r1[0]) + __uint_as_float(r1[1]);
              auto r2 = __builtin_amdgcn_permlane32_swap(__float_as_uint(ss), __float_as_uint(ss), false, false); ss = __uint_as_float(r2[0]) + __uint_as_float(r2[1]); }
            const float rn = rsqrtf(ss + 1e-12f);
#pragma unroll
            for (int nt = 0; nt < 4; ++nt) { const int cl = h * 64 + 16 * nt + 4 * lq; float kp[4], kk[4], bb[4]; const f32x4 c_ka = *(const LAS f32x4*)(cst + 1536 + cl);
#pragma unroll
                for (int r = 0; r < 4; ++r) { kk[r] = kkv[nt][r] * rn; const float a = av[nt][r]; kp[r] = kv[nt][r] * (1.f + (a - 1.f) * c_ka[r]); bb[r] = kk[r] * a; }
                if (NTOK == 16 || lr < NTOK) *(u32x2*)(F.PREP + (size_t)PR_K * PREP_STRIDE + orow + cl) = (u32x2){pkh2(kp[0], kp[1]), pkh2(kp[2], kp[3])};
                if (NTOK == 16 || lr < NTOK) *(u32x2*)(F.PREP + (size_t)PR_KK * PREP_STRIDE + orow + cl) = (u32x2){pkh2(kk[0], kk[1]), pkh2(kk[2], kk[3])};
                if (NTOK == 16 || lr < NTOK) *(u32x2*)(F.PREP + (size_t)PR_B * PREP_STRIDE + orow + cl) = (u32x2){pkh2(bb[0], bb[1]), pkh2(bb[2], bb[3])}; }
        }
        __syncthreads();
    };
    if (F.G == 256) {
        for (int iu = 0; iu < 8; ++iu) { const int q = F.bid * 8 + iu, s = q >> 7, r = q & 127; unit((s >> 2) * SEQ + r * 64 + (s & 3) * 16, IC<16>{}); }
        unit(ML + F.bid * 4, IC<4>{});
    } else for (int it = F.bid; it < MT / 16; it += F.G) unit(it * 16, IC<16>{});
}

__device__ __forceinline__ void phase_post(Frame& F, int l, int Mrows) {
    constexpr int SGP = 72;
    LAS unsigned char* L = F.lds;
    LAS bf16_t* in5 = (LAS bf16_t*)L;
    LAS bf16_t* sgs = (LAS bf16_t*)(L + 5 * 16 * OSP * 2);
    LAS bf16_t* outs = (LAS bf16_t*)(L + 5 * 16 * OSP * 2 + 16 * SGP * 2);
    const float* mu = F.ap->in[I_RMU] + l * 1312 + 1248;
    const int lr = F.lane & 15, lq = F.lane >> 4, h = F.wave;
    bf16x8 Bg[4][2]; float lng[4][4], lnb[4][4], rk[4][4];
    if (h < 6) {
#pragma unroll
        for (int nt = 0; nt < 4; ++nt) { const int col = h * 64 + 16 * nt + lr;
#pragma unroll
            for (int ks = 0; ks < 2; ++ks) { float t0[8];
#pragma unroll
                for (int j = 0; j < 8; ++j) t0[j] = F.ap->in[I_RG2][((size_t)l * 64 + 32 * ks + 8 * lq + j) * 384 + col];
                Bg[nt][ks] = pack8(t0); }
#pragma unroll
            for (int r = 0; r < 4; ++r) { const int c2 = h * 64 + 16 * nt + 4 * lq + r; lng[nt][r] = F.ap->in[I_RLNG][l * 384 + c2]; lnb[nt][r] = F.ap->in[I_RLNB][l * 384 + c2]; rk[nt][r] = F.ap->in[I_RRK][l * 384 + c2]; } }
    }
    const bool strips = (F.G == 256);
    for (int iu = 0; iu < 9; ++iu) {
        int m0;
        if (strips) { if (iu < 8) { const int q = F.bid * 8 + iu, s = q >> 7, r = q & 127; m0 = (s >> 2) * SEQ + r * 64 + (s & 3) * 16; } else { if (Mrows <= ML || F.bid >= MC / 16) break; m0 = ML + F.bid * 16; } }
        else { if (iu > 0) break; m0 = -1; }
      for (int it = strips ? 0 : F.bid; it < (strips ? 1 : Mrows / 16); it += F.G) {
        if (!strips) m0 = it * 16;
        int tl = F.tid; asm volatile("" : "+v"(tl));
        u32x4 stg[8];
#pragma unroll
        for (int k = 0; k < 8; ++k) { const int p = tl + NTHR * k; if (k < 7 || p < 5 * 16 * 48) { const int t = p / 768, rem = p - t * 768, tok = rem / 48, pc = rem - tok * 48; const int m = m0 + tok;
            const bf16_t* src = t == 0 ? F.A + (size_t)m * DM + 384 + pc * 8 : t == 1 ? F.Z + (size_t)m * ZP + YB_OFF + 384 + pc * 8
                              : F.PREP + (size_t)(t == 2 ? PR_R : t == 3 ? PR_K : PR_V) * PREP_STRIDE + (size_t)m * 384 + pc * 8;
            stg[k] = *(const u32x4*)src; } }
        {
            const int u = F.tid >> 2, sub = F.tid & 3, tok = u >> 3, hu = u & 7, m = m0 + tok; const bool gla = hu < 4;
            const int ycol = gla ? hu * 96 : 768 + (hu - 4) * 64, gcol = gla ? GLA_OFF + 768 + hu * 96 : RET_OFF + 768 + (hu - 4) * 64, npc = gla ? 3 : 2;
            const float* gain = gla ? F.ap->in[I_GNG] + l * 384 + hu * 96 : F.ap->in[I_RETNG] + l * 256 + (hu - 4) * 64;
            bf16_t* ar = F.A + (size_t)m * DM + ycol; const bf16_t* zb = F.Z + (size_t)m * ZP + YB_OFF + ycol; const bf16_t* zg = F.Z + (size_t)m * ZP + gcol;
            u32x4 ya[3], yb2[3], gz[3];
#pragma unroll
            for (int i = 0; i < 3; ++i) if (i < npc) { const int pc = sub + 4 * i; ya[i] = *(const u32x4*)(ar + pc * 8); yb2[i] = *(const u32x4*)(zb + pc * 8); gz[i] = *(const u32x4*)(zg + pc * 8); }
            float yv[3][8]; float ssq = 0.f;
#pragma unroll
            for (int i = 0; i < 3; ++i) if (i < npc) { float b8[8]; unpack8(ya[i], yv[i]); unpack8(yb2[i], b8);
#pragma unroll
                for (int e = 0; e < 8; ++e) { yv[i][e] += b8[e]; ssq += yv[i][e] * yv[i][e]; } }
            ssq += dpp_mov<0xB1>(ssq); ssq += dpp_mov<0x4E>(ssq);
            const float rn = rsqrtf(ssq / (gla ? 96.f : 64.f) + 1e-6f);
#pragma unroll
            for (int i = 0; i < 3; ++i) if (i < npc) { const int pc = sub + 4 * i; float g[8]; unpack8(gz[i], g);
                const f32x4 g0 = *(const f32x4*)(gain + pc * 8), g1 = *(const f32x4*)(gain + pc * 8 + 4); const float gg[8] = {g0.x, g0.y, g0.z, g0.w, g1.x, g1.y, g1.z, g1.w};
#pragma unroll
                for (int e = 0; e < 8; ++e) yv[i][e] = siluf_(g[e]) * yv[i][e] * rn * gg[e];
                *(u32x4*)(ar + pc * 8) = pack8u(yv[i]); }
        }
        asm volatile("" : "+v"(tl));
#pragma unroll
        for (int k = 0; k < 8; ++k) { const int p = tl + NTHR * k; if (k < 7 || p < 5 * 16 * 48) { const int t = p / 768, rem = p - t * 768, tok = rem / 48, pc = rem - tok * 48;
            *(LAS u32x4*)(in5 + (t * 16 + tok) * OSP + pc * 8) = stg[k]; } }
        if (F.tid < 128) { const int tok = F.tid >> 3, gi = F.tid & 7, m = m0 + tok; const ZNb nbv = znb(m); float o[8], mu8[8];
#pragma unroll
            for (int e = 0; e < 8; ++e) mu8[e] = mu[gi * 8 + e];
            shift8(F.Z + (size_t)m * ZP + RW_OFF + 1248 + gi * 8, nbv, mu8, o);
#pragma unroll
            for (int e = 0; e < 8; ++e) o[e] = sigmoidf_(o[e]);
            *(LAS u32x4*)(sgs + tok * SGP + gi * 8) = pack8u(o); }
        __syncthreads();
        if (h < 6) {
            const bf16x8 a0 = *(const LAS bf16x8*)(sgs + lr * SGP + 8 * lq), a1 = *(const LAS bf16x8*)(sgs + lr * SGP + 32 + 8 * lq);
            float yv[4][4], gt[4][4], vv4[4][4]; float s1 = 0.f, s2 = 0.f, s3 = 0.f;
#pragma unroll
            for (int nt = 0; nt < 4; ++nt) { f32x4 g4 = {0.f, 0.f, 0.f, 0.f};
                g4 = __builtin_amdgcn_mfma_f32_16x16x32_bf16(Bg[nt][0], a0, g4, 0, 0, 0); g4 = __builtin_amdgcn_mfma_f32_16x16x32_bf16(Bg[nt][1], a1, g4, 0, 0, 0);
                const int cl = h * 64 + 16 * nt + 4 * lq;
                const u32x2 q0 = *(const LAS u32x2*)(in5 + (0 * 16 + lr) * OSP + cl), q1 = *(const LAS u32x2*)(in5 + (1 * 16 + lr) * OSP + cl), q2 = *(const LAS u32x2*)(in5 + (2 * 16 + lr) * OSP + cl);
                const u32x2 q3 = *(const LAS u32x2*)(in5 + (3 * 16 + lr) * OSP + cl), q4 = *(const LAS u32x2*)(in5 + (4 * 16 + lr) * OSP + cl);
                const f32x2 f0a = ce::up2(q0.x), f0b = ce::up2(q0.y), f1a = ce::up2(q1.x), f1b = ce::up2(q1.y), f2a = uph2(q2.x), f2b = uph2(q2.y), f3a = uph2(q3.x), f3b = uph2(q3.y), f4a = uph2(q4.x), f4b = uph2(q4.y);
                const float yf[4] = {f0a.x, f0a.y, f0b.x, f0b.y}, yb_[4] = {f1a.x, f1a.y, f1b.x, f1b.y}, rr[4] = {f2a.x, f2a.y, f2b.x, f2b.y}, kp[4] = {f3a.x, f3a.y, f3b.x, f3b.y}, vv[4] = {f4a.x, f4a.y, f4b.x, f4b.y};
#pragma unroll
                for (int r = 0; r < 4; ++r) { const float y = yf[r] + yb_[r]; yv[nt][r] = y; gt[nt][r] = g4[r]; vv4[nt][r] = vv[r]; s1 += y; s2 += y * y; s3 += rr[r] * kp[r] * rk[nt][r]; } }
#define PP_SUM4(x) do { auto r1_ = __builtin_amdgcn_permlane16_swap(__float_as_uint(x), __float_as_uint(x), false, false); x = __uint_as_float(r1_[0]) + __uint_as_float(r1_[1]); \
                        auto r2_ = __builtin_amdgcn_permlane32_swap(__float_as_uint(x), __float_as_uint(x), false, false); x = __uint_as_float(r2_[0]) + __uint_as_float(r2_[1]); } while (0)
            PP_SUM4(s1); PP_SUM4(s2); PP_SUM4(s3);
#undef PP_SUM4
            const float mean = s1 * (1.f / 64.f); const float rstd = rsqrtf(fmaxf(s2 * (1.f / 64.f) - mean * mean, 0.f) + 64e-5f);
            bf16_t* orow = F.A + (size_t)(m0 + lr) * DM + 384;
#pragma unroll
            for (int nt = 0; nt < 4; ++nt) { const int cl = h * 64 + 16 * nt + 4 * lq; float o[4];
#pragma unroll
                for (int r = 0; r < 4; ++r) { const float yn = (yv[nt][r] - mean) * rstd * lng[nt][r] + lnb[nt][r]; o[r] = (yn + s3 * vv4[nt][r]) * gt[nt][r]; }
                *(u32x2*)(orow + cl) = (u32x2){pk2(o[0], o[1]), pk2(o[2], o[3])}; }
        }
        __syncthreads();
      }
    }
}
}
using pp::phase_prep;
using pp::phase_post;
constexpr int PH_PER_LAYER = 9, N_PHASES = 1 + DEPTH * PH_PER_LAYER + 1;
#define PHASE_ENTER() \
    CArgs ap = (CArgs)__builtin_amdgcn_kernarg_segment_ptr(); asm volatile("" : "+s"(ap)); \
    int tid = threadIdx.x; asm volatile("" : "+v"(tid)); \
    Frame F; F.lds = lds; F.ap = ap; F.tid = tid; F.lane = tid & 63; F.wave = __builtin_amdgcn_readfirstlane(tid >> 6); F.bid = blockIdx.x; F.G = gridDim.x; \
    unsigned char* ws = ap->ws; F.out = ap->out; F.ws = ws; \
    F.mod = (float*)(ws + WS_MOD); F.Win_t = (bf16_t*)(ws + WS_WIN); F.Wout_t = (bf16_t*)(ws + WS_WOUT); F.W1_t = (bf16_t*)(ws + WS_W1); F.W2_t = (bf16_t*)(ws + ((L & 1) ? WS_W2B : WS_W2)); \
    F.xc = (float*)(ws + WS_XC); F.A = (bf16_t*)(ws + WS_ABUF); F.Z = (bf16_t*)(ws + WS_Z); F.PREP = (bf16_t*)(ws + WS_PREP); F.H = (bf16_t*)(ws + WS_H); \
    const float* modl = F.mod + (size_t)L * 5 * 6144; (void)modl; \
    bf16_t* XB = (bf16_t*)F.out; bf16_t* XCB = (bf16_t*)F.xc; bf16_t* XB2 = (bf16_t*)(ws + WS_XB2); unsigned* XSL = (unsigned*)(ws + WS_CTL + 262144); unsigned* XCNT = (unsigned*)(ws + WS_CTL + 65536); (void)XB; (void)XCB; (void)XB2; (void)XSL; (void)XCNT;     \
    const void* xl_in = L == 0 ? (const void*)F.ap->in[I_X] : (const void*)XB; const void* xc_in = L == 0 ? (const void*)F.ap->in[I_CTX] : (const void*)XCB; (void)xl_in; (void)xc_in;

#ifndef PROBE_T
#define PROBE_T 0
#endif
#define PB_SCAN (PROBE_T == 13 || PROBE_T == 14 || PROBE_T == 17)
#define PB_BLK (PROBE_T == 13 || PROBE_T == 18 ? 192 : PROBE_T == 14 ? 224 : 0)
#define STAGGER(ticks) do { if ((blockIdx.x >> 3) & 1) { const unsigned long long t0_ = __builtin_amdgcn_s_memrealtime(); while (__builtin_amdgcn_s_memrealtime() - t0_ < (unsigned long long)(ticks)) __builtin_amdgcn_s_sleep(16); } } while (0)
#ifndef STG_OUT
#define STG_OUT 0
#endif
#ifndef STG_DOWN
#define STG_DOWN 0
#endif
#define IN(k) (lo <= (k) && (k) < hi)
#define SEAM(k) do { if (IN(k) && IN((k) + 1)) { if ((k) == 0 && gridDim.x != 256) grid.sync(); else xcd_barrier(bar); } } while (0)
#define T_PREV (*(volatile LAS unsigned long long*)(lds + LDS_BYTES - 128))
#define T_ACC (*(volatile LAS unsigned long long*)(lds + LDS_BYTES - 120))
#define STAMP(id) do { if (PROBE_T == (id) && blockIdx.x == 0 && threadIdx.x == 0) { const unsigned long long now_ = __builtin_amdgcn_s_memrealtime(); T_ACC = T_ACC + (now_ - T_PREV); } \
                       if (PROBE_T && PROBE_T == (id) + 1 && blockIdx.x == 0 && threadIdx.x == 0) T_PREV = __builtin_amdgcn_s_memrealtime(); } while (0)
template <int L> __device__ __forceinline__ void run_layer(int lo, int hi, LAS unsigned char* lds, cg::grid_group& grid, const XcdBarrier& bar) {
    constexpr int p0 = 1 + L * PH_PER_LAYER; constexpr bool last = (L == DEPTH - 1); constexpr int Mo = last ? ML : MT;
    if (PROBE_T == 2 && blockIdx.x == 0 && threadIdx.x == 0) T_PREV = __builtin_amdgcn_s_memrealtime();
    if (L == 0) { if (IN(p0 + 0)) { PHASE_ENTER(); phase_wconv(F, L, 3); phase_norm<false>(F, xl_in, xc_in, F.ap->in[I_N1G] + L * DM, modl, 0, 1, MT); } SEAM(p0 + 0); }
    STAMP(2);
    if (IN(p0 + 1)) { PHASE_ENTER(); pg8::Gemm g{F.A, F.Win_t, MT, ZP, DM}; pg8::StaticOrder S; S.init(MT, ZP, F.G, F.bid); pg8::EpiBf16<0> E{F.Z, ZP};
        pg8::gemm_phase<pg8::EpiBf16<0>, pg8::StaticOrder, false, true>(F.lds, g, S, E, tid); } SEAM(p0 + 1); STAMP(3);
    if (IN(p0 + 2)) { PHASE_ENTER(); phase_prep(F, L); if (F.G != 256) { xcd_barrier(bar); gla_gate_units(F, L, F.bid, F.G); } } SEAM(p0 + 2); STAMP(4); STAMP(5);
    { if (PB_SCAN && blockIdx.x == PB_BLK && threadIdx.x == 0) T_PREV = __builtin_amdgcn_s_memrealtime();
      if (IN(p0 + 3)) { PHASE_ENTER(); phase_scan(F, L); }
      if (PB_SCAN && blockIdx.x == PB_BLK && threadIdx.x == 0) T_ACC = T_ACC + (__builtin_amdgcn_s_memrealtime() - T_PREV); }
    SEAM(p0 + 3); STAMP(6);
    if (IN(p0 + 4)) { PHASE_ENTER(); phase_post(F, L, Mo); } SEAM(p0 + 4); STAMP(7);
    if (IN(p0 + 5)) { { PHASE_ENTER(); if (STG_OUT) STAGGER(STG_OUT); pg8::Gemm g{F.A, F.Wout_t, ML, DM, DM}; pg8::StaticOrder S; S.init(ML, DM, F.G, F.bid);
          pg8::EpiResNorm<L != 0, 0> E{xl_in, xc_in, last ? XB2 : XB, XCB, modl + 2 * 1024, 0, F.ap->in[I_N2G] + L * DM, modl, 3, 4, F.A, nullptr, XSL, XCNT + (2 * L) * 132 * 16, F.lds + 131072};
          pg8::gemm_phase<pg8::EpiResNorm<L != 0, 0>, pg8::StaticOrder, true, true>(F.lds, g, S, E, tid); }
      if (!last) { PHASE_ENTER(); if (F.bid < 16) { pg8::Gemm g{F.A + (size_t)ML * DM, F.Wout_t, MC, DM, DM}; pg8::StaticOrder S; S.init(MC, DM, 16, F.bid);
          pg8::EpiResNorm<L != 0, 0> E{xl_in, xc_in, XB, XCB, modl + 2 * 1024, ML / 256, F.ap->in[I_N2G] + L * DM, modl, 3, 4, F.A, nullptr, XSL, XCNT + (2 * L) * 132 * 16, F.lds + 131072};
          pg8::gemm_phase<pg8::EpiResNorm<L != 0, 0>, pg8::StaticOrder, true, true>(F.lds, g, S, E, tid); } } } SEAM(p0 + 5); STAMP(8);
    STAMP(9);
    if (IN(p0 + 7)) { PHASE_ENTER(); pg8::Gemm g{F.A, F.W1_t, Mo, DFF, DM}; pg8::StaticOrder S; S.init(Mo, DFF, F.G, F.bid); pg8::EpiBf16<2> E{F.H, DFF};
        pg8::gemm_phase<pg8::EpiBf16<2>, pg8::StaticOrder, false, true>(F.lds, g, S, E, tid); } SEAM(p0 + 7); STAMP(10);
    if (IN(p0 + 8)) {
      if (last) { PHASE_ENTER(); pg8::Gemm g{F.H, F.W2_t, ML, DM, DFF}; pg8::StaticOrder S; S.init(ML, DM, F.G, F.bid);
          pg8::EpiResNorm<true, 1> E{XB2, XCB, nullptr, nullptr, modl + 5 * 1024, 0, F.ap->in[I_FNG], modl, 0, 0, nullptr, F.out, XSL, XCNT + (2 * L + 1) * 132 * 16, F.lds + 131072};
          pg8::gemm_phase<pg8::EpiResNorm<true, 1>, pg8::StaticOrder, true, true>(F.lds, g, S, E, tid); }
      else { { PHASE_ENTER(); const float* modn = F.mod + (size_t)(L + 1) * 5 * 6144;
          pg8::Gemm g{F.H, F.W2_t, ML, DM, DFF}; pg8::StaticOrder S; S.init(ML, DM, F.G, F.bid);
          pg8::EpiResNorm<true, 0> E{XB, XCB, XB, XCB, modl + 5 * 1024, 0, F.ap->in[I_N1G] + (L + 1) * DM, modn, 0, 1, F.A, nullptr, XSL, XCNT + (2 * L + 1) * 132 * 16, F.lds + 131072};
          pg8::gemm_phase<pg8::EpiResNorm<true, 0>, pg8::StaticOrder, true, true>(F.lds, g, S, E, tid); }
        xcd_barrier(bar);
        { PHASE_ENTER(); if (F.bid < 64) { const int kc = F.bid & 3; pg8::Gemm g{F.H + (size_t)ML * DFF + kc * (DFF / 4), F.W2_t + kc * (DFF / 4), MC, DM, DFF / 4, DFF}; pg8::StaticOrder S; S.init(MC, DM, 16, F.bid >> 2);
              pg8::EpiPart E{(float*)(ws + WS_XB2) + (size_t)kc * MC * DM};
              pg8::gemm_phase<pg8::EpiPart, pg8::StaticOrder, true, true>(F.lds, g, S, E, tid);
              __builtin_amdgcn_fence(__ATOMIC_RELEASE, "agent");
              group_arrive((unsigned*)(ws + WS_CTL) + 8192 + 1024 + L * 64, 64u, true);
              const float* modn = F.mod + (size_t)(L + 1) * 5 * 6144;
              phase_norm_ctxsum(F, XCB, (const float*)(ws + WS_XB2), modl + 5 * 1024 + (size_t)4 * 6144, F.ap->in[I_N1G] + (L + 1) * DM, modn, 0, 1, 64); }
          else phase_wconv(F, L + 1, 3, 64, F.G - 64); } } } SEAM(p0 + 8); STAMP(11);
}
__global__ void __launch_bounds__(NTHR, 2) mega_fwd(Args args) {
    extern __shared__ __attribute__((aligned(16))) unsigned char lds_raw[];
    LAS unsigned char* lds = (LAS unsigned char*)lds_raw;
    const int lo = args.ph_lo, hi = args.ph_hi;
    cg::grid_group grid = cg::this_grid();
    volatile LAS unsigned* misc = (volatile LAS unsigned*)(lds + LDS_BYTES - 256);
    if (threadIdx.x < 4) misc[threadIdx.x] = 0u;
    __syncthreads();
    const XcdBarrier bar = xcd_barrier_post((unsigned*)(args.ws + WS_CTL) + 1024, misc);
    if (PROBE_T && threadIdx.x == 0) { T_PREV = 0ull; T_ACC = 0ull; }
    if (PROBE_T == 1 && blockIdx.x == 0 && threadIdx.x == 0) T_PREV = __builtin_amdgcn_s_memrealtime();
    { constexpr int L = 0; if (IN(0)) { PHASE_ENTER(); phase_mod(F); } SEAM(0); }
    if (PROBE_T == 1 && blockIdx.x == 0 && threadIdx.x == 0) T_ACC = T_ACC + (__builtin_amdgcn_s_memrealtime() - T_PREV);
    run_layer<0>(lo, hi, lds, grid, bar);
    run_layer<1>(lo, hi, lds, grid, bar);
    if (PROBE_T == 12 && blockIdx.x == 0 && threadIdx.x == 0) T_PREV = __builtin_amdgcn_s_memrealtime();
    if (PROBE_T == 12) { xcd_barrier(bar); if (blockIdx.x == 0 && threadIdx.x == 0) T_ACC = T_ACC + (__builtin_amdgcn_s_memrealtime() - T_PREV); }
    if ((PROBE_T == 15 || PROBE_T == 16) && blockIdx.x == 0 && threadIdx.x == (PROBE_T == 15 ? 0 : 256)) { const unsigned long long t_acc = g_probe_acc; g_probe_acc = 0ull; const unsigned long long t0 = __builtin_amdgcn_s_memrealtime(); while (__builtin_amdgcn_s_memrealtime() - t0 < 16ull * t_acc) __builtin_amdgcn_s_sleep(32); }
    else if (PROBE_T && (PROBE_T < 15 || PROBE_T >= 17) && blockIdx.x == PB_BLK && threadIdx.x == 0) { const unsigned long long t_acc = T_ACC; const unsigned long long t0 = __builtin_amdgcn_s_memrealtime(); while (__builtin_amdgcn_s_memrealtime() - t0 < 16ull * t_acc) __builtin_amdgcn_s_sleep(32); }
}
#undef IN
#undef SEAM
#undef STAMP

extern "C" void kernel_launch(void* const* d_in, const int* in_sizes, int n_in, void* d_out, int out_size, void* d_ws, size_t ws_size, hipStream_t stream) {
    static int grid = 0;
    if (grid == 0) {
        int dev = 0, cus = 0, per_cu = 0;
        hipGetDevice(&dev); hipDeviceGetAttribute(&cus, hipDeviceAttributeMultiprocessorCount, dev);
        hipFuncSetAttribute((const void*)mega_fwd, hipFuncAttributeMaxDynamicSharedMemorySize, LDS_BYTES);
        hipOccupancyMaxActiveBlocksPerMultiprocessor(&per_cu, (const void*)mega_fwd, NTHR, LDS_BYTES);
        if (per_cu < 1) { fprintf(stderr, "kernel_launch: occupancy query says %d blocks per CU\n", per_cu); per_cu = 1; }
        (void)hipGetLastError();
        grid = cus * per_cu;
        if (n_in != 29 || ws_size < WS_END) fprintf(stderr, "kernel_launch: unexpected n_in %d / ws_size %zu (need %zu)\n", n_in, ws_size, (size_t)WS_END);
    }
    Args a{};
    for (int i = 0; i < 29; ++i) a.in[i] = (const float*)d_in[i];
    a.out = (float*)d_out; a.ws = (unsigned char*)d_ws;
#if MK_ONE_LAUNCH
    (void)hipMemsetAsync((char*)d_ws + WS_CTL, 0, 131072, stream);
    a.ph_lo = 0; a.ph_hi = N_PHASES;
    void* kargs[] = {&a};
    hipError_t e = hipLaunchCooperativeKernel((const void*)mega_fwd, dim3(grid), dim3(NTHR), kargs, LDS_BYTES, stream);
    if (e != hipSuccess) fprintf(stderr, "cooperative launch failed: %s (grid %d)\n", hipGetErrorString(e), grid);
#else
    for (int ph = 0; ph < N_PHASES; ++ph) { a.ph_lo = ph; a.ph_hi = ph + 1;
        hipLaunchKernelGGL(mega_fwd, dim3(grid), dim3(NTHR), LDS_BYTES, stream, a); }
#endif
}
```
